# Optimizing an MI355X kernel written in HIP

```python
import math
import jax, jax.numpy as jnp
from jax import lax
import numpy as np

D_MODEL = 2048
BATCH = 2
SEQ = 8192
DEPTH = 1

HEAD_DIM = 128
MIX_WIDTH = D_MODEL
RET_WIDTH = MIX_WIDTH // 2
ATTN_WIDTH = MIX_WIDTH - RET_WIDTH
RET_HEADS = RET_WIDTH // HEAD_DIM
ATTN_HEADS = ATTN_WIDTH // HEAD_DIM
ATTN_KV_HEADS = ATTN_HEADS // 4
KV_WIDTH = ATTN_KV_HEADS * HEAD_DIM
IN_WIDTH = 4 * RET_WIDTH + ATTN_WIDTH + 2 * KV_WIDTH
RET_CHUNK = 128
Q_BLOCK = 128
GRID_W = 64
AXIS_DIM = HEAD_DIM // 2
ROPE_THETA = 10000.0
MEM_TOKENS = 256
CROSS_HEADS = 4
CROSS_HEAD_DIM = 128
CROSS_WIDTH = CROSS_HEADS * CROSS_HEAD_DIM
D_FF = 4 * D_MODEL
NORM_EPS = 1e-6

kernel_name = "hybrid_retention_gqa_encoder_block"


def rms_norm(x, w):
    xf = x.astype(jnp.float32)
    y = xf * lax.rsqrt(jnp.mean(xf * xf, axis=-1, keepdims=True) + NORM_EPS)
    return (y * w.astype(jnp.float32)).astype(x.dtype)


def axial_rope_tables(seq_len):
    rows = seq_len // GRID_W
    row = jnp.repeat(jnp.arange(rows, dtype=jnp.float32), GRID_W)
    col = jnp.tile(jnp.arange(GRID_W, dtype=jnp.float32), rows)
    inv_freq = 1.0 / (ROPE_THETA ** (jnp.arange(0, AXIS_DIM, 2, dtype=jnp.float32) / AXIS_DIM))
    ang_r = row[:, None] * inv_freq[None, :]
    ang_c = col[:, None] * inv_freq[None, :]
    return (jnp.cos(ang_r), jnp.sin(ang_r), jnp.cos(ang_c), jnp.sin(ang_c))


def _rope_half(x, cos, sin):
    x1, x2 = jnp.split(x, 2, axis=-1)
    cos = cos.astype(x.dtype)
    sin = sin.astype(x.dtype)
    return jnp.concatenate([x1 * cos - x2 * sin, x2 * cos + x1 * sin], axis=-1)


def apply_axial_rope(x, rope):
    cos_r, sin_r, cos_c, sin_c = rope
    xr, xc = jnp.split(x, 2, axis=-1)
    return jnp.concatenate([_rope_half(xr, cos_r, sin_r), _rope_half(xc, cos_c, sin_c)], axis=-1)


def retention_one_direction(q, k, v, log_gamma, strict):
    B, H, S, dk = q.shape
    dv = v.shape[-1]
    n_chunks = S // RET_CHUNK

    def to_chunks(t):
        return t.reshape(B, H, n_chunks, RET_CHUNK, t.shape[-1]).transpose(2, 0, 1, 3, 4)

    qc, kc, vc = to_chunks(q), to_chunks(k), to_chunks(v)
    idx = jnp.arange(RET_CHUNK, dtype=jnp.float32)
    rel = idx[:, None] - idx[None, :]
    mask = rel > 0 if strict else rel >= 0
    lg = log_gamma[:, None, None]
    decay_inner = jnp.where(mask[None], jnp.exp(lg * jnp.where(mask, rel, 0.0)[None]), 0.0)
    decay_query = jnp.exp(log_gamma[:, None] * (idx + 1.0)[None, :])[..., None]
    decay_key = jnp.exp(log_gamma[:, None] * (RET_CHUNK - 1.0 - idx)[None, :])[..., None]
    decay_chunk = jnp.exp(log_gamma * RET_CHUNK)[:, None, None]

    def step(state, inp):
        q_i, k_i, v_i = inp
        scores = jnp.einsum('bhnd,bhmd->bhnm', q_i, k_i) * decay_inner
        out = jnp.einsum('bhnm,bhmv->bhnv', scores, v_i)
        out = out + jnp.einsum('bhnd,bhdv->bhnv', q_i, state) * decay_query
        state = state * decay_chunk + jnp.einsum('bhmd,bhmv->bhdv', k_i * decay_key, v_i)
        return state, out

    state0 = jnp.zeros((B, H, dk, dv), jnp.float32)
    _, out = lax.scan(step, state0, (qc, kc, vc))
    return out.transpose(1, 2, 0, 3, 4).reshape(B, H, S, dv)


def bidirectional_retention(q, k, v, log_gamma_fwd, log_gamma_bwd):
    fwd = retention_one_direction(q, k, v, log_gamma_fwd, strict=False)
    flip = lambda t: jnp.flip(t, axis=2)
    bwd = flip(retention_one_direction(flip(q), flip(k), flip(v), log_gamma_bwd, strict=True))
    return fwd + bwd


def block_gqa_attention(q, k, v):
    B, H, S, d = q.shape
    kvh = k.shape[1]
    groups = H // kvh
    n_blocks = S // Q_BLOCK
    scale = d ** -0.5
    qb = q.reshape(B, kvh, groups, n_blocks, Q_BLOCK, d).transpose(3, 0, 1, 2, 4, 5)

    def one_block(q_blk):
        s = jnp.einsum('bkgqd,bksd->bkgqs', q_blk, k).astype(jnp.float32) * scale
        p = jax.nn.softmax(s, axis=-1)
        return jnp.einsum('bkgqs,bksd->bkgqd', p.astype(v.dtype), v)

    o = lax.map(one_block, qb)
    return o.transpose(1, 0, 4, 2, 3, 5).reshape(B, S, H * d)


def hybrid_mixer(h, w_in, ret_decay_fwd, ret_decay_bwd, ret_gn_w, ret_gn_b,
                 attn_q_norm_w, attn_k_norm_w, w_out, rope):
    B, S, _ = h.shape
    proj = h @ w_in
    c1 = RET_WIDTH
    c2 = 2 * RET_WIDTH
    c3 = 3 * RET_WIDTH
    c4 = 4 * RET_WIDTH
    c5 = c4 + ATTN_WIDTH
    c6 = c5 + KV_WIDTH
    rq, rk, rv, rg, aq, ak, av = jnp.split(proj, [c1, c2, c3, c4, c5, c6], axis=-1)

    def heads(t, n):
        return t.reshape(B, S, n, HEAD_DIM).transpose(0, 2, 1, 3)

    rq = apply_axial_rope(heads(rq, RET_HEADS), rope).astype(jnp.float32)
    rk = (apply_axial_rope(heads(rk, RET_HEADS), rope).astype(jnp.float32)) * (HEAD_DIM ** -0.5)
    rv = heads(rv, RET_HEADS).astype(jnp.float32)
    log_g_f = -jnp.exp(ret_decay_fwd.astype(jnp.float32))
    log_g_b = -jnp.exp(ret_decay_bwd.astype(jnp.float32))
    y = bidirectional_retention(rq, rk, rv, log_g_f, log_g_b)
    mu = jnp.mean(y, axis=-1, keepdims=True)
    var = jnp.mean(jnp.square(y - mu), axis=-1, keepdims=True)
    y = ((y - mu) * lax.rsqrt(var + NORM_EPS)).transpose(0, 2, 1, 3).reshape(B, S, RET_WIDTH)
    y = y * ret_gn_w.astype(jnp.float32) + ret_gn_b.astype(jnp.float32)
    y_ret = (jax.nn.silu(rg.astype(jnp.float32)) * y).astype(h.dtype)

    aq = apply_axial_rope(rms_norm(heads(aq, ATTN_HEADS), attn_q_norm_w), rope)
    ak = apply_axial_rope(rms_norm(heads(ak, ATTN_KV_HEADS), attn_k_norm_w), rope)
    av = heads(av, ATTN_KV_HEADS)
    y_attn = block_gqa_attention(aq, ak, av)

    return jnp.concatenate([y_ret, y_attn], axis=-1) @ w_out


def memory_cross_attention(h, m, wq, wk, wv, wo):
    B, S, _ = h.shape
    M = m.shape[1]
    q = (h @ wq).reshape(B, S, CROSS_HEADS, CROSS_HEAD_DIM)
    k = (m @ wk).reshape(B, M, CROSS_HEADS, CROSS_HEAD_DIM)
    v = (m @ wv).reshape(B, M, CROSS_HEADS, CROSS_HEAD_DIM)
    s = jnp.einsum('bshd,bmhd->bhsm', q, k).astype(jnp.float32) * (CROSS_HEAD_DIM ** -0.5)
    p = jax.nn.softmax(s, axis=-1)
    o = jnp.einsum('bhsm,bmhd->bshd', p.astype(v.dtype), v).reshape(B, S, CROSS_WIDTH)
    return o @ wo


def setup_inputs(seed: int = 0) -> dict:
    key = jax.random.key(seed)
    ks = jax.random.split(key, 24)

    def w(k, shape, fan_in):
        return jax.random.normal(k, shape, jnp.float32) * (fan_in ** -0.5)

    def gain(k, shape):
        return 1.0 + 0.02 * jax.random.normal(k, shape, jnp.float32)

    base = jnp.log(-jnp.log1p(-(2.0 ** (-(5.0 + jnp.arange(RET_HEADS, dtype=jnp.float32))))))
    return {
        "x": jax.random.normal(ks[0], (BATCH, SEQ, D_MODEL), jnp.float32),
        "mem": jax.random.normal(ks[1], (BATCH, MEM_TOKENS, D_MODEL), jnp.float32),
        "norm_mix_w": gain(ks[2], (DEPTH, D_MODEL)),
        "w_in": w(ks[3], (DEPTH, D_MODEL, IN_WIDTH), D_MODEL),
        "ret_decay_fwd": base[None, :] + 0.05 * jax.random.normal(ks[4], (DEPTH, RET_HEADS), jnp.float32),
        "ret_decay_bwd": base[None, :] + 0.05 * jax.random.normal(ks[5], (DEPTH, RET_HEADS), jnp.float32),
        "ret_gn_w": gain(ks[6], (DEPTH, RET_WIDTH)),
        "ret_gn_b": 0.02 * jax.random.normal(ks[7], (DEPTH, RET_WIDTH), jnp.float32),
        "attn_q_norm_w": gain(ks[8], (DEPTH, HEAD_DIM)),
        "attn_k_norm_w": gain(ks[9], (DEPTH, HEAD_DIM)),
        "w_out": w(ks[10], (DEPTH, MIX_WIDTH, D_MODEL), MIX_WIDTH),
        "norm_cross_w": gain(ks[11], (DEPTH, D_MODEL)),
        "norm_mem_w": gain(ks[12], (DEPTH, D_MODEL)),
        "w_cross_q": w(ks[13], (DEPTH, D_MODEL, CROSS_WIDTH), D_MODEL),
        "w_cross_k": w(ks[14], (DEPTH, D_MODEL, CROSS_WIDTH), D_MODEL),
        "w_cross_v": w(ks[15], (DEPTH, D_MODEL, CROSS_WIDTH), D_MODEL),
        "w_cross_o": w(ks[16], (DEPTH, CROSS_WIDTH, D_MODEL), CROSS_WIDTH),
        "norm_mlp_w": gain(ks[17], (DEPTH, D_MODEL)),
        "w_mlp_up": w(ks[18], (DEPTH, D_MODEL, D_FF), D_MODEL),
        "w_mlp_down": w(ks[19], (DEPTH, D_FF, D_MODEL), D_FF),
        "norm_final_w": gain(ks[20], (D_MODEL,)),
    }


def reference(x, mem, norm_mix_w, w_in, ret_decay_fwd, ret_decay_bwd, ret_gn_w, ret_gn_b,
              attn_q_norm_w, attn_k_norm_w, w_out, norm_cross_w, norm_mem_w,
              w_cross_q, w_cross_k, w_cross_v, w_cross_o, norm_mlp_w,
              w_mlp_up, w_mlp_down, norm_final_w):
    rope = axial_rope_tables(x.shape[1])
    for l in range(DEPTH):
        h = rms_norm(x, norm_mix_w[l])
        x = x + hybrid_mixer(h, w_in[l], ret_decay_fwd[l], ret_decay_bwd[l], ret_gn_w[l], ret_gn_b[l],
                             attn_q_norm_w[l], attn_k_norm_w[l], w_out[l], rope)
        h = rms_norm(x, norm_cross_w[l])
        m = rms_norm(mem, norm_mem_w[l])
        x = x + memory_cross_attention(h, m, w_cross_q[l], w_cross_k[l], w_cross_v[l], w_cross_o[l])
        h = rms_norm(x, norm_mlp_w[l])
        x = x + jnp.square(jax.nn.relu(h @ w_mlp_up[l])) @ w_mlp_down[l]
    return rms_norm(x, norm_final_w)
```

```cpp
#include <hip/hip_runtime.h>
#include <hip/hip_bf16.h>
#include <hip/hip_cooperative_groups.h>
#include <cstdio>
#include <cstdint>
namespace cg = cooperative_groups;
namespace pg8 {
#define PG8_LAS __attribute__((address_space(3)))
typedef unsigned short bf16_t;
typedef short bf16x8 __attribute__((ext_vector_type(8)));
typedef float f32x4 __attribute__((ext_vector_type(4)));
typedef unsigned u32x4 __attribute__((ext_vector_type(4)));
constexpr int BM = 256, BK = 64, HALF = 128, HTB = HALF * BK * 2  , STAGE_BYTES = 8 * HTB, NXCD = 8, WGM = 8;

__host__ __device__ __forceinline__ int lds_byte(int r, int c) { const int st = (r >> 4) * 2 + (c >> 5), rr = r & 15, cc = c & 31, ob = rr * 64 + cc * 2; return st * 1024 + (ob ^ (((ob >> 9) & 1) << 5)); }
__host__ __device__ __forceinline__ void stage_rc(int b, int& R, int& C) { const int st = b / 1024, sb = b % 1024, swz = sb ^ (((sb >> 9) & 1) << 5); R = (st >> 1) * 16 + swz / 64; C = (st & 1) * 32 + (swz % 64) / 2; }
__host__ __device__ __forceinline__ int perm32(int rho) { const int n = rho >> 4, i = rho & 15; return 8 * (i >> 2) + 4 * n + (i & 3); }

struct Unit { int pm, pn; };
struct Gemm { const bf16_t* A; const bf16_t* Bt; int M, N, K, lda; };

struct StaticOrder {
    int nM, nN, nwg, G, c;
    __host__ __device__ void init(int M, int N, int G_, int c_) { nM = M / BM; nN = N / BM; nwg = nM * nN; G = G_; c = c_; }
    __host__ __device__ bool next(int i, Unit& u) const {
        const long L = (long)i * G + c; if (L >= nwg) return false;
        int wgid = (int)L; { const int q = nwg / NXCD, r = nwg % NXCD, xcd = wgid % NXCD, off = wgid / NXCD; wgid = (xcd < r ? xcd * (q + 1) : r * (q + 1) + (xcd - r) * q) + off; }
        const int nig = WGM * nN, gid = wgid / nig, fm = gid * WGM, gsz = (nM - fm) < WGM ? (nM - fm) : WGM;
        u.pm = fm + ((wgid % nig) % gsz); u.pn = (wgid % nig) / gsz; return true;
    }
    __device__ __forceinline__ void a_ready(const Unit&) const {}
    __device__ __forceinline__ void done(const Unit&) const {}
};

__device__ __forceinline__ unsigned cvt_pk_bf16(float lo, float hi) { unsigned r; asm volatile("v_cvt_pk_bf16_f32 %0, %1, %2" : "=v"(r) : "v"(lo), "v"(hi)); return r; }
__device__ __forceinline__ float row_rs(const float* ss, int row, int fq) {
    const f32x4 a = *(const f32x4*)(ss + (size_t)row * 32 + fq * 8), b = *(const f32x4*)(ss + (size_t)row * 32 + fq * 8 + 4);
    float s = ((a[0] + a[1]) + (a[2] + a[3])) + ((b[0] + b[1]) + (b[2] + b[3]));
    s += __shfl_xor(s, 16); s += __shfl_xor(s, 32);
    return 1.0f / sqrtf(s * (1.0f / 2048.0f) + 1e-6f);
}
template <int MODE> struct EpiBf {
    static constexpr bool PERM = true, AFTER_DRAIN = false;
    bf16_t* O; int ldc; const float* ss;
    __device__ __forceinline__ void operator()(const f32x4 (&acc)[2][2][4][2], const Unit& u, int wr, int wc, int fr, int fq) const {
        const int row0 = u.pm * BM + wr * 64 + fr, col0 = u.pn * BM + wc * 32 + 8 * fq;
#pragma unroll
        for (int ai = 0; ai < 2; ++ai)
#pragma unroll
            for (int m = 0; m < 4; ++m) { const int row = row0 + ai * HALF + m * 16; bf16_t* rowp = O + (size_t)row * ldc + col0;
                float sc = 1.f; if (MODE != 0) sc = row_rs(ss, row, fq);
#pragma unroll
                for (int bj = 0; bj < 2; ++bj) { f32x4 v0 = acc[ai][bj][m][0] * sc, v1 = acc[ai][bj][m][1] * sc;
                    if (MODE == 2) {
#pragma unroll
                        for (int j = 0; j < 4; ++j) { const float a = fmaxf(v0[j], 0.f), b = fmaxf(v1[j], 0.f); v0[j] = a * a; v1[j] = b * b; } }
                    u32x4 w; w.x = cvt_pk_bf16(v0[0], v0[1]); w.y = cvt_pk_bf16(v0[2], v0[3]); w.z = cvt_pk_bf16(v1[0], v1[1]); w.w = cvt_pk_bf16(v1[2], v1[3]);
                    *(u32x4*)(rowp + bj * HALF) = w; } }
    }
};
struct EpiResid {
    static constexpr bool PERM = false, AFTER_DRAIN = false;
    const float* base; float* out; bf16_t* xb; float* ss;
    __device__ __forceinline__ void operator()(const f32x4 (&acc)[2][2][4][2], const Unit& u, int wr, int wc, int fr, int fq) const {
        typedef unsigned u32x2v __attribute__((ext_vector_type(2)));
        const int col0 = u.pn * BM + wc * 32 + 4 * fq;
#pragma unroll
        for (int ai = 0; ai < 2; ++ai)
#pragma unroll
            for (int m = 0; m < 4; ++m) { const int row = u.pm * BM + ai * HALF + wr * 64 + m * 16 + fr; const size_t off = (size_t)row * 2048 + col0; float sq = 0.f;
#pragma unroll
                for (int bj = 0; bj < 2; ++bj)
#pragma unroll
                    for (int n = 0; n < 2; ++n) { const f32x4 bs = *(const f32x4*)(base + off + bj * HALF + n * 16); const f32x4 x = bs + acc[ai][bj][m][n];
                        *(f32x4*)(out + off + bj * HALF + n * 16) = x; sq += (x[0] * x[0] + x[1] * x[1]) + (x[2] * x[2] + x[3] * x[3]);
                        if (xb) { u32x2v w; w.x = cvt_pk_bf16(x[0], x[1]); w.y = cvt_pk_bf16(x[2], x[3]); *(u32x2v*)(xb + off + bj * HALF + n * 16) = w; } }
                sq += __shfl_xor(sq, 16); sq += __shfl_xor(sq, 32);
                if (fq == 0) ss[(size_t)row * 32 + u.pn * 4 + wc] = sq;
                asm volatile("" ::: "memory"); }
    }
};

template <class Epi, class Sched, bool ALIGN_EPI = false, bool SP2 = false>
__device__ __forceinline__ void gemm_phase(PG8_LAS unsigned char* lds, const Gemm g, const Sched& S, const Epi& E) {
    const int tid = threadIdx.x, wid = __builtin_amdgcn_readfirstlane(tid >> 6), lane = tid & 63, wr = wid >> 2, wc = wid & 3, fr = lane & 15, fq = lane >> 4;
    const int K = g.K, nt = K / BK;
    unsigned voffA[2], voffB[2];
#pragma unroll
    for (int i = 0; i < 2; ++i) { int R, C; stage_rc(tid * 16 + i * 8192, R, C); const int Rb = Epi::PERM ? ((R & ~31) + perm32(R & 31)) : R;
        voffA[i] = (unsigned)(R * g.lda + C) * 2u; voffB[i] = (unsigned)(Rb * K + C) * 2u; }
    const size_t kstep = (size_t)(BK * 2);
    const size_t hstep = (size_t)HALF * K * 2;
    const size_t tstep = 2 * hstep; const size_t hstepA = (size_t)HALF * g.lda * 2, tstepA = 2 * hstepA;
    const unsigned ldsw = (unsigned)wid * 1024u;
    const int aoff = lds_byte(wr * 64 + fr, fq * 8), boff = lds_byte(wc * 32 + fr, fq * 8);
#define PG8_SA(b, h) (((b) * 2 + (h)) * HTB)
#define PG8_SB(b, h) ((4 + (b) * 2 + (h)) * HTB)
#define PG8_STAGE(bufoff, gbase, voff) do { _Pragma("unroll") for (int _i = 0; _i < 2; ++_i) \
        __builtin_amdgcn_global_load_lds((const unsigned*)((const char*)(gbase) + (voff)[_i]), (PG8_LAS unsigned*)(lds + (bufoff) + ldsw + _i * 8192), 16, 0, 0); } while (0)
#define PG8_LDA(dst, b, h) do { _Pragma("unroll") for (int m = 0; m < 4; ++m) _Pragma("unroll") for (int k = 0; k < 2; ++k) dst[m][k] = *(const PG8_LAS bf16x8*)(lds + PG8_SA(b, h) + aoff + m * 2048 + k * 1024); } while (0)
#define PG8_LDB(dst, b, h) do { _Pragma("unroll") for (int n = 0; n < 2; ++n) _Pragma("unroll") for (int k = 0; k < 2; ++k) dst[n][k] = *(const PG8_LAS bf16x8*)(lds + PG8_SB(b, h) + boff + n * 2048 + k * 1024); } while (0)
#define PG8_MMA(ai, bj, At, Bt) do { __builtin_amdgcn_s_setprio(1); _Pragma("unroll") for (int m = 0; m < 4; ++m) _Pragma("unroll") for (int n = 0; n < 2; ++n) _Pragma("unroll") for (int k = 0; k < 2; ++k) \
        acc[ai][bj][m][n] = __builtin_amdgcn_mfma_f32_16x16x32_bf16(Bt[n][k], At[m][k], acc[ai][bj][m][n], 0, 0, 0); __builtin_amdgcn_s_setprio(0); } while (0)
#define PG8_WAIT_V(n) asm volatile("s_waitcnt vmcnt(" #n ")" ::: "memory")
#define PG8_WAIT_L(n) asm volatile("s_waitcnt lgkmcnt(" #n ")" ::: "memory")
#define PG8_BAR __builtin_amdgcn_s_barrier()
#define PG8_SCHED __builtin_amdgcn_sched_barrier(0)
    Unit cur, nxt; int ui = 0;
    if (!S.next(0, cur)) return;
    f32x4 acc[2][2][4][2];
#pragma unroll
    for (int a = 0; a < 2; ++a)
#pragma unroll
        for (int b = 0; b < 2; ++b)
#pragma unroll
            for (int m = 0; m < 4; ++m)
#pragma unroll
                for (int n = 0; n < 2; ++n) acc[a][b][m][n] = (f32x4){0.f, 0.f, 0.f, 0.f};
    bf16x8 At[4][2], B0[2][2], B1[2][2];
    const char* cA = (const char*)g.A + (size_t)cur.pm * tstepA; const char* cB = (const char*)g.Bt + (size_t)cur.pn * tstep;
    S.a_ready(cur);
    if constexpr (SP2) {
        PG8_STAGE(PG8_SB(0, 0), cB, voffB); PG8_STAGE(PG8_SB(0, 1), cB + hstep, voffB); PG8_STAGE(PG8_SA(0, 0), cA, voffA); PG8_STAGE(PG8_SA(0, 1), cA + hstepA, voffA);
        if (wr == 1) PG8_BAR;
        PG8_WAIT_V(2); PG8_BAR;
        PG8_STAGE(PG8_SB(1, 0), cB + kstep, voffB); PG8_STAGE(PG8_SA(1, 0), cA + kstep, voffA); PG8_STAGE(PG8_SB(1, 1), cB + hstep + kstep, voffB);
        PG8_WAIT_V(6); PG8_BAR;
    } else {
        PG8_STAGE(PG8_SB(0, 0), cB, voffB); PG8_STAGE(PG8_SA(0, 0), cA, voffA); PG8_STAGE(PG8_SB(0, 1), cB + hstep, voffB); PG8_STAGE(PG8_SA(0, 1), cA + hstepA, voffA);
        if (wr == 1) PG8_BAR;
        PG8_WAIT_V(4); PG8_BAR;
        PG8_STAGE(PG8_SB(1, 0), cB + kstep, voffB); PG8_STAGE(PG8_SA(1, 0), cA + kstep, voffA); PG8_STAGE(PG8_SB(1, 1), cB + hstep + kstep, voffB);
        PG8_WAIT_V(6); PG8_BAR;
    }
    for (;;) {
        const bool has_next = S.next(ui + 1, nxt);
        const char* nA = has_next ? (const char*)g.A + (size_t)nxt.pm * tstepA : cA; const char* nB = has_next ? (const char*)g.Bt + (size_t)nxt.pn * tstep : cB;
        for (int t = 0; t < nt; t += 2) {
            const bool last = (t == nt - 2);
            const char* a1 = cA + (size_t)(t + 1) * kstep;
            const char* a2 = last ? nA : cA + (size_t)(t + 2) * kstep; const char* b2 = last ? nB : cB + (size_t)(t + 2) * kstep;
            const char* a3 = a2 + kstep; const char* b3 = b2 + kstep;
            if (last && has_next) S.a_ready(nxt);
            if constexpr (SP2) {
            PG8_LDB(B0, 0, 0); PG8_LDB(B1, 0, 1); PG8_SCHED; PG8_LDA(At, 0, 0); PG8_STAGE(PG8_SA(1, 1), a1 + hstepA, voffA);
            PG8_WAIT_V(8); PG8_WAIT_L(0); PG8_BAR; PG8_MMA(0, 0, At, B0); PG8_MMA(0, 1, At, B1); PG8_BAR; PG8_SCHED;
            PG8_LDA(At, 0, 1); PG8_STAGE(PG8_SB(0, 0), b2, voffB); PG8_STAGE(PG8_SB(0, 1), b2 + hstep, voffB); PG8_STAGE(PG8_SA(0, 0), a2, voffA);
            PG8_WAIT_V(8); PG8_WAIT_L(0); PG8_BAR; PG8_MMA(1, 0, At, B0); PG8_MMA(1, 1, At, B1); PG8_BAR; PG8_SCHED;
            PG8_LDB(B0, 1, 0); PG8_LDB(B1, 1, 1); PG8_SCHED; PG8_LDA(At, 1, 0); PG8_STAGE(PG8_SA(0, 1), a2 + hstepA, voffA);
            PG8_WAIT_V(8); PG8_WAIT_L(0); PG8_BAR; PG8_MMA(0, 0, At, B0); PG8_MMA(0, 1, At, B1); PG8_BAR; PG8_SCHED;
            PG8_LDA(At, 1, 1); PG8_STAGE(PG8_SB(1, 0), b3, voffB); PG8_STAGE(PG8_SB(1, 1), b3 + hstep, voffB); PG8_STAGE(PG8_SA(1, 0), a3, voffA);
            PG8_WAIT_V(8); PG8_WAIT_L(0); PG8_BAR; PG8_MMA(1, 0, At, B0); PG8_MMA(1, 1, At, B1); PG8_BAR; PG8_SCHED;
            } else {
            PG8_LDB(B0, 0, 0); PG8_SCHED; PG8_LDA(At, 0, 0); PG8_STAGE(PG8_SA(1, 1), a1 + hstepA, voffA);
            PG8_WAIT_L(8); PG8_BAR; PG8_WAIT_L(0); PG8_MMA(0, 0, At, B0); PG8_BAR; PG8_SCHED;
            PG8_LDB(B1, 0, 1); PG8_STAGE(PG8_SB(0, 0), b2, voffB);
            PG8_BAR; PG8_WAIT_L(0); PG8_MMA(0, 1, At, B1); PG8_BAR;
            PG8_LDA(At, 0, 1); PG8_STAGE(PG8_SA(0, 0), a2, voffA);
            PG8_BAR; PG8_WAIT_L(0); PG8_MMA(1, 0, At, B0); PG8_BAR; PG8_SCHED;
            PG8_STAGE(PG8_SB(0, 1), b2 + hstep, voffB);
            PG8_WAIT_V(6); PG8_BAR; PG8_MMA(1, 1, At, B1); PG8_BAR;
            PG8_LDB(B0, 1, 0); PG8_SCHED; PG8_LDA(At, 1, 0); PG8_STAGE(PG8_SA(0, 1), a2 + hstepA, voffA);
            PG8_WAIT_L(8); PG8_BAR; PG8_WAIT_L(0); PG8_MMA(0, 0, At, B0); PG8_BAR; PG8_SCHED;
            PG8_LDB(B1, 1, 1); PG8_STAGE(PG8_SB(1, 0), b3, voffB);
            PG8_BAR; PG8_WAIT_L(0); PG8_MMA(0, 1, At, B1); PG8_BAR;
            PG8_LDA(At, 1, 1); PG8_STAGE(PG8_SA(1, 0), a3, voffA);
            PG8_BAR; PG8_WAIT_L(0); PG8_MMA(1, 0, At, B0); PG8_BAR; PG8_SCHED;
            PG8_STAGE(PG8_SB(1, 1), b3 + hstep, voffB);
            PG8_WAIT_V(6); PG8_BAR; PG8_MMA(1, 1, At, B1); PG8_BAR;
            }
        }
        if constexpr (ALIGN_EPI) { if (wr == 0) PG8_BAR; }
        if constexpr (!Epi::AFTER_DRAIN) { E(acc, cur, wr, wc, fr, fq); S.done(cur); }
        if (!has_next) break;
#pragma unroll
        for (int a = 0; a < 2; ++a)
#pragma unroll
            for (int b = 0; b < 2; ++b)
#pragma unroll
                for (int m = 0; m < 4; ++m)
#pragma unroll
                    for (int n = 0; n < 2; ++n) acc[a][b][m][n] = (f32x4){0.f, 0.f, 0.f, 0.f};
        cur = nxt; cA = nA; cB = nB; ++ui;
        if constexpr (ALIGN_EPI) { if (wr == 1) PG8_BAR; }
    }
    PG8_WAIT_V(0);
    if constexpr (!ALIGN_EPI) { if (wr == 0) PG8_BAR; }
    PG8_BAR;
    if constexpr (Epi::AFTER_DRAIN) { E.fused(acc, cur, wr, wc, fr, fq, lds, wid, lane); S.done(cur); }
#undef PG8_SA
#undef PG8_SB
#undef PG8_STAGE
#undef PG8_LDA
#undef PG8_LDB
#undef PG8_MMA
#undef PG8_WAIT_V
#undef PG8_WAIT_L
#undef PG8_BAR
#undef PG8_SCHED
}
}
namespace att {
using bf16 = __hip_bfloat16;
constexpr int   D = 128, NW = 8, QBLK = 32, KVBLK = 64;
constexpr float SCALE = 0.088388347648318440f;
constexpr float THR = 8.f;
constexpr int SDEPTH = 2;
constexpr size_t SHM_V = KVBLK * D * 2, SHM_K = KVBLK * D * 2, SHM_ATTN = 2 * SHM_V + 2 * SHM_K + NW * 64 * 4;
using bf16x8 = __attribute__((ext_vector_type(8))) short;
using s16x4  = __attribute__((ext_vector_type(4))) short;
using f32x16 = __attribute__((ext_vector_type(16))) float;
using f32x8  = __attribute__((ext_vector_type(8))) float;
using u32x4  = __attribute__((ext_vector_type(4))) unsigned;
#define KSWZ(row, colB) ((row) * 256 + ((colB) ^ (((row) & 7) << 4)))
#define SBAR() __builtin_amdgcn_sched_barrier(0)
__device__ __forceinline__ int crow(int r, int hi) { return (r & 3) + 8 * (r >> 2) + 4 * hi; }
__device__ __forceinline__ unsigned cvtpk(float lo, float hi) {
  unsigned r; asm volatile("v_cvt_pk_bf16_f32 %0, %1, %2" : "=v"(r) : "v"(lo), "v"(hi)); return r;
}
struct StageB { using T = bf16x8;
  __device__ static __forceinline__ T ld8(const bf16* p) { return *reinterpret_cast<const bf16x8*>(p); }
  __device__ static __forceinline__ bf16x8 tobf(T x) { return x; } };

__device__ __forceinline__ void partialSM(f32x16& p0, f32x16& p1, float& m_reg, float& mn, float& alpha) {
  constexpr float C = SCALE * 1.4426950408889634f;
  float pmax = p0[0]; for (int r = 1; r < 16; ++r) pmax = fmaxf(pmax, p0[r]); for (int r = 0; r < 16; ++r) pmax = fmaxf(pmax, p1[r]);
  { auto rr = __builtin_amdgcn_permlane32_swap(__float_as_uint(pmax), __float_as_uint(pmax), false, false);
    pmax = fmaxf(__uint_as_float(rr[0]), __uint_as_float(rr[1])); }
  if (__builtin_expect(__all(pmax - m_reg <= THR / SCALE), 1)) { mn = m_reg; alpha = 1.f; }
  else { mn = fmaxf(m_reg, pmax); alpha = __builtin_amdgcn_exp2f((m_reg - mn) * C); m_reg = mn; }
  float mnC = -mn * C;
  for (int r = 0; r < 16; ++r) p0[r] = fmaf(p0[r], C, mnC); for (int r = 0; r < 16; ++r) p1[r] = fmaf(p1[r], C, mnC);
  for (int r = 0; r < 16; ++r) p0[r] = __builtin_amdgcn_exp2f(p0[r]);
}
__device__ __forceinline__ void finishSM(f32x16& p0, f32x16& p1, float alpha, float& l_reg, bf16x8& pa0, bf16x8& pa1, bf16x8& pa2, bf16x8& pa3) {
  for (int r = 0; r < 16; ++r) p1[r] = __builtin_amdgcn_exp2f(p1[r]);
  float ps = 0; for (int r = 0; r < 16; ++r) ps += p0[r]; for (int r = 0; r < 16; ++r) ps += p1[r];
  { auto rr = __builtin_amdgcn_permlane32_swap(__float_as_uint(ps), __float_as_uint(ps), false, false);
    ps = __uint_as_float(rr[0]) + __uint_as_float(rr[1]); }
  l_reg = l_reg * alpha + ps;
#define PK4(P, BASE, OUT) do { unsigned a0 = cvtpk(P[BASE + 0], P[BASE + 1]), a1 = cvtpk(P[BASE + 2], P[BASE + 3]);   \
    unsigned b0 = cvtpk(P[BASE + 4], P[BASE + 5]), b1 = cvtpk(P[BASE + 6], P[BASE + 7]);                              \
    auto r0 = __builtin_amdgcn_permlane32_swap(a0, b0, false, false); auto r1 = __builtin_amdgcn_permlane32_swap(a1, b1, false, false); \
    u32x4 w = {r0[0], r1[0], r0[1], r1[1]}; OUT = *reinterpret_cast<bf16x8*>(&w); } while (0)
  PK4(p0, 0, pa0); PK4(p0, 8, pa1); PK4(p1, 0, pa2); PK4(p1, 8, pa3);
#undef PK4
}
__device__ __forceinline__ void qkt(f32x16& p0, f32x16& p1, const bf16* Ks, const bf16x8* qr, int r32, int hi) {
  p0 = f32x16{}; p1 = f32x16{};
  for (int d0 = 0; d0 < 8; ++d0) { int cb = (d0 * 16 + hi * 8) * 2;
    bf16x8 b0 = *reinterpret_cast<const bf16x8*>((const char*)Ks + KSWZ(r32, cb));
    bf16x8 b1 = *reinterpret_cast<const bf16x8*>((const char*)Ks + KSWZ(32 + r32, cb));
    p0 = __builtin_amdgcn_mfma_f32_32x32x16_bf16(b0, qr[d0], p0, 0, 0, 0);
    p1 = __builtin_amdgcn_mfma_f32_32x32x16_bf16(b1, qr[d0], p1, 0, 0, 0); }
}
__device__ __forceinline__ int v_st(int k, int c) { const int kk = (k & ~0xC) | ((k & 4) << 1) | ((k & 8) >> 1); return ((kk >> 3) * 4 + (c >> 5)) * 512 + ((kk & 7) * 32 + (c & 31)) * 2; }
__device__ __forceinline__ int v_rd_base(int lane) { return ((lane & 3) << 3) | (((lane >> 2) & 3) << 6) | (((lane >> 4) & 1) << 5) | (((lane >> 5) & 1) << 8); }
constexpr int v_rd_off(int d0, int ks, int half) { return d0 * 512 + ks * 4096 + half * 2048; }
template <int OFF> __device__ __forceinline__ s16x4 tr_read(int vb) {
  s16x4 r; asm volatile("ds_read_b64_tr_b16 %0, %1 offset:%2" : "=&v"(r) : "v"(vb), "i"(OFF) : "memory"); return r;
}
template <int D0> __device__ __forceinline__ void pv_one(f32x16& od, int vb, bf16x8 pa0, bf16x8 pa1, bf16x8 pa2, bf16x8 pa3) {
  const s16x4 l0 = tr_read<v_rd_off(D0, 0, 0)>(vb), h0 = tr_read<v_rd_off(D0, 0, 1)>(vb), l1 = tr_read<v_rd_off(D0, 1, 0)>(vb), h1 = tr_read<v_rd_off(D0, 1, 1)>(vb);
  const s16x4 l2 = tr_read<v_rd_off(D0, 2, 0)>(vb), h2 = tr_read<v_rd_off(D0, 2, 1)>(vb), l3 = tr_read<v_rd_off(D0, 3, 0)>(vb), h3 = tr_read<v_rd_off(D0, 3, 1)>(vb);
  asm volatile("s_waitcnt lgkmcnt(0)" ::: "memory"); SBAR();
#define PK(L, H) (bf16x8){L[0], L[1], L[2], L[3], H[0], H[1], H[2], H[3]}
  od = __builtin_amdgcn_mfma_f32_32x32x16_bf16(pa0, PK(l0, h0), od, 0, 0, 0);
  od = __builtin_amdgcn_mfma_f32_32x32x16_bf16(pa1, PK(l1, h1), od, 0, 0, 0);
  od = __builtin_amdgcn_mfma_f32_32x32x16_bf16(pa2, PK(l2, h2), od, 0, 0, 0);
  od = __builtin_amdgcn_mfma_f32_32x32x16_bf16(pa3, PK(l3, h3), od, 0, 0, 0);
#undef PK
}
__device__ __forceinline__ void pv_d0(f32x16* o, int vb, bf16x8 pa0, bf16x8 pa1, bf16x8 pa2, bf16x8 pa3) {
  pv_one<0>(o[0], vb, pa0, pa1, pa2, pa3); pv_one<1>(o[1], vb, pa0, pa1, pa2, pa3); pv_one<2>(o[2], vb, pa0, pa1, pa2, pa3); pv_one<3>(o[3], vb, pa0, pa1, pa2, pa3);
}

template <int LDQ, int LDK, int LDO, int VOFF>
__device__ __forceinline__ void attn_dense_body(const bf16* Qb, const bf16* __restrict__ Kh,
                                                bf16* Ob, int seq, char* lds) {
  using St = StageB; using SQ = StageB;
  const int tid = threadIdx.x, wid = tid >> 6, lane = tid & 63, r32 = lane & 31, hi = lane >> 5;
  bf16* V_lds = (bf16*)lds; bf16* K_lds = (bf16*)(lds + 2 * SHM_V);
  float* ws = (float*)(lds + 2 * SHM_V + 2 * SHM_K) + wid * 64; float* li_l = ws; float* al_l = ws + 32;
  float m_reg = -1e30f, l_reg = 0; f32x16 o[4] = {}; bf16x8 qr[8];
  const bf16* Qw = Qb + (long)(wid * QBLK + r32) * LDQ + hi * 8;
#pragma unroll
  for (int d0 = 0; d0 < 8; ++d0) qr[d0] = SQ::tobf(SQ::ld8(Qw + d0 * 16));
  const int sr = tid >> 4, sc = (tid & 15) * 8, vst0 = v_st(sr, sc), vst1 = v_st(32 + sr, sc);
  const int vb0 = (int)(uintptr_t)V_lds + v_rd_base(lane);
  struct { typename St::T vs0, vs1, ks0, ks1; } sr_[SDEPTH];
  const unsigned kvo0 = (unsigned)(sr * LDK + sc) * 2u, kvo1 = kvo0 + 32u * LDK * 2u;
#define SLOAD(i, k0) do { const char* kb_ = (const char*)Kh + (size_t)(k0) * (LDK * 2); \
    sr_[i].vs0 = *(const bf16x8*)(kb_ + kvo0 + VOFF * 2); sr_[i].vs1 = *(const bf16x8*)(kb_ + kvo1 + VOFF * 2); \
    sr_[i].ks0 = *(const bf16x8*)(kb_ + kvo0); sr_[i].ks1 = *(const bf16x8*)(kb_ + kvo1); } while (0)
#define SWRITE(b, i) do { *(bf16x8*)((char*)V_lds + (b) * SHM_V + vst0) = St::tobf(sr_[i].vs0);          \
    *(bf16x8*)((char*)V_lds + (b) * SHM_V + vst1) = St::tobf(sr_[i].vs1); int kc = sc * 2;               \
    *(bf16x8*)((char*)K_lds + (b) * SHM_K + KSWZ(sr, kc)) = St::tobf(sr_[i].ks0);                       \
    *(bf16x8*)((char*)K_lds + (b) * SHM_K + KSWZ(32 + sr, kc)) = St::tobf(sr_[i].ks1); } while (0)
#define SWAIT() do { if constexpr (SDEPTH == 2) asm volatile("s_waitcnt vmcnt(4)" ::: "memory"); else asm volatile("s_waitcnt vmcnt(0)" ::: "memory"); } while (0)
#define RESC(a) do { if (__any((a) < 1.f)) { if (hi == 0) al_l[r32] = (a); asm volatile("s_waitcnt lgkmcnt(0)" ::: "memory"); \
    for (int d = 0; d < 4; ++d) for (int r = 0; r < 16; ++r) o[d][r] *= al_l[crow(r, hi)]; } } while (0)
  f32x16 pA0, pA1, pB0, pB1; float mnA, mnB, alA, alB; bf16x8 pa0, pa1, pa2, pa3; const int NT = seq / KVBLK;
  constexpr int SE = 0, SO = SDEPTH - 1;
  SLOAD(SE, 0); asm volatile("s_waitcnt vmcnt(0)" ::: "memory"); SWRITE(0, SE); __syncthreads();
  qkt(pA0, pA1, K_lds, qr, r32, hi); partialSM(pA0, pA1, m_reg, mnA, alA);
  SLOAD(SO, KVBLK); if constexpr (SDEPTH == 2) { if (2 < NT) SLOAD(SE, 2 * KVBLK); }
  SWAIT(); SWRITE(1, SO); __syncthreads();
  for (int j = 1; j + 1 < NT; j += 2) {
    SBAR(); qkt(pB0, pB1, (bf16*)((char*)K_lds + SHM_K), qr, r32, hi);
    finishSM(pA0, pA1, alA, l_reg, pa0, pa1, pa2, pa3); SBAR();
    SLOAD(SO, (j + SDEPTH) * KVBLK); SBAR();
    pv_d0(o, vb0, pa0, pa1, pa2, pa3); partialSM(pB0, pB1, m_reg, mnB, alB);
    __syncthreads(); SWAIT(); SWRITE(0, SE);
    RESC(alB); __syncthreads();
    SBAR(); qkt(pA0, pA1, K_lds, qr, r32, hi);
    finishSM(pB0, pB1, alB, l_reg, pa0, pa1, pa2, pa3); SBAR();
    if (SDEPTH == 1 || j + 3 < NT) SLOAD(SE, (j + 1 + SDEPTH) * KVBLK); SBAR();
    pv_d0(o, vb0 + (int)SHM_V, pa0, pa1, pa2, pa3); partialSM(pA0, pA1, m_reg, mnA, alA);
    __syncthreads(); SWAIT(); SWRITE(1, SO);
    RESC(alA); __syncthreads();
  }
  SBAR(); qkt(pB0, pB1, (bf16*)((char*)K_lds + SHM_K), qr, r32, hi);
  finishSM(pA0, pA1, alA, l_reg, pa0, pa1, pa2, pa3); SBAR();
  pv_d0(o, vb0, pa0, pa1, pa2, pa3); partialSM(pB0, pB1, m_reg, mnB, alB);
  __syncthreads(); RESC(alB);
  finishSM(pB0, pB1, alB, l_reg, pa0, pa1, pa2, pa3); SBAR();
  pv_d0(o, vb0 + (int)SHM_V, pa0, pa1, pa2, pa3);
  if (hi == 0) li_l[r32] = l_reg; asm volatile("s_waitcnt lgkmcnt(0)" ::: "memory");
  float rli[16];
#pragma unroll
  for (int r = 0; r < 16; ++r) rli[r] = __builtin_amdgcn_rcpf(li_l[crow(r, hi)]);
  unsigned short* Ow = (unsigned short*)Ob + (long)(wid * QBLK) * LDO;
  int hi_o = hi, r32_o = r32; asm volatile("" : "+v"(hi_o), "+v"(r32_o));
  const unsigned lane_off = (unsigned)(4 * hi_o * LDO + r32_o);
#pragma unroll
  for (int r = 0; r < 16; ++r) {
#pragma unroll
    for (int d0 = 0; d0 < 4; ++d0) Ow[lane_off + (unsigned)(((r & 3) + 8 * (r >> 2)) * LDO + d0 * 32)] = (unsigned short)(cvtpk(o[d0][r] * rli[r], 0.f) & 0xffffu); }
#undef SLOAD
#undef SWRITE
#undef SWAIT
#undef RESC
}

}
constexpr int BATCH = 2, SEQ = 8192, DM = 2048, M = BATCH * SEQ, INW = 5632, DFF = 8192, CWID = 512, MEMT = 256, MROWS = BATCH * MEMT;
constexpr int C_RQ = 0, C_RK = 1024, C_RV = 2048, C_RG = 3072, C_AQ = 4096, C_AK = 5120, C_AV = 5376;
constexpr int NCH = 64;
constexpr float EPS = 1e-6f;
constexpr int NWAVES = 8;
constexpr size_t MiB = 1u << 20;
constexpr size_t WS_ROPE = 0;
constexpr size_t WS_CTL = 512 * 1024, CTL_ZERO_BYTES = 16384;
constexpr size_t WS_SS1 = 1 * MiB, WS_SS2 = 3 * MiB, WS_SS3 = 5 * MiB;
constexpr size_t WS_KVC = 7 * MiB;
constexpr size_t WS_WIN = 8 * MiB, WS_WOUT = 30 * MiB, WS_WQ = 38 * MiB, WS_WKV = 40 * MiB, WS_WO = 44 * MiB, WS_WUP = 46 * MiB, WS_WDN = 78 * MiB;
constexpr size_t WS_XN = 110 * MiB;
constexpr size_t WS_MN = 174 * MiB;
constexpr size_t WS_PROJ = 176 * MiB;
constexpr size_t WS_VT = 352 * MiB;
constexpr size_t WS_ST = 384 * MiB;
constexpr size_t WS_QC = 448 * MiB;
constexpr size_t WS_U = 176 * MiB;
constexpr size_t WS_END = 464 * MiB;
static_assert(WS_U + (size_t)M * DFF * 2 <= WS_QC, "U overlay");
constexpr int LDS_BYTES = 147456;
constexpr int LDT = 136, TILE_B = 128 * LDT * 2;
constexpr int RED_OFF = 4 * TILE_B;
constexpr int MISC_OFF = LDS_BYTES - 64;
static_assert(MISC_OFF + 16 <= LDS_BYTES && RED_OFF + 4096 <= MISC_OFF && 7 * 18432 + 64 * 65 * 4 <= MISC_OFF, "LDS map");

#define LAS __attribute__((address_space(3)))
typedef unsigned short bf16;
typedef unsigned v4u __attribute__((ext_vector_type(4)));
typedef unsigned v2u __attribute__((ext_vector_type(2)));
typedef float f32x4 __attribute__((ext_vector_type(4)));
typedef float f32x2 __attribute__((ext_vector_type(2)));
typedef short bf16x8 __attribute__((ext_vector_type(8)));
#define LDS_WAIT() asm volatile("s_waitcnt lgkmcnt(0)" ::: "memory")
__device__ __forceinline__ unsigned f2bf(float f) { unsigned u = __builtin_bit_cast(unsigned, f); return (u + 0x7fffu + ((u >> 16) & 1u)) >> 16; }
__device__ __forceinline__ unsigned pk2(float lo, float hi) { return f2bf(lo) | (f2bf(hi) << 16); }
__device__ __forceinline__ float bflo(unsigned w) { return __uint_as_float(w << 16); }
__device__ __forceinline__ float bfhi(unsigned w) { return __uint_as_float(w & 0xffff0000u); }
__device__ __forceinline__ float bf1(unsigned short h) { return __uint_as_float((unsigned)h << 16); }
__device__ __forceinline__ float wave_sum(float v) {
#pragma unroll
    for (int o = 1; o < 64; o <<= 1) v += __shfl_xor(v, o);
    return v;
}

#define XB_TMO      128
#define XB_XCNT(j)  (256  + 64 * (j))
#define XB_XSUB(j)  (1280 + 64 * (j))
#define XB_XGEN(j)  (2304 + 64 * (j))
#define XB_TOP      3328
#define XB_TOPGEN   3392
#define XCD_BAR_WORDS 3456
#define XB_SPIN_CAP (1u << 18)

__device__ __forceinline__ unsigned xb_ld(unsigned* p)              { return __hip_atomic_load(p, __ATOMIC_RELAXED, __HIP_MEMORY_SCOPE_AGENT); }
__device__ __forceinline__ unsigned xb_add(unsigned* p, unsigned v) { return __hip_atomic_fetch_add(p, v, __ATOMIC_RELAXED, __HIP_MEMORY_SCOPE_AGENT); }
__device__ __forceinline__ unsigned xb_xcc_id() { return (unsigned)__builtin_amdgcn_s_getreg((3 << 11) | 20) & 0xFu; }
#define XB_SPIN(cond, bar) do { unsigned _sp = 0; while (cond) { __builtin_amdgcn_s_sleep(1); \
    if ((++_sp & 255u) == 0u) { if (xb_ld(&(bar)[XB_TMO])) break; if (_sp > XB_SPIN_CAP) { atomicAdd(&(bar)[XB_TMO], 1u); break; } } } } while (0)

struct XcdBarrier {
    unsigned* bar; unsigned x;
    volatile LAS unsigned* st;
};

__device__ __forceinline__ XcdBarrier xcd_barrier_post(unsigned* bar, volatile LAS unsigned* st) {
    XcdBarrier b; b.bar = bar; b.x = xb_xcc_id(); b.st = st;
    if (threadIdx.x == 0) (void)xb_add(&bar[XB_XCNT(b.x)], 1u);
    return b;
}
__device__ __forceinline__ void xcd_barrier_complete(unsigned* bar, unsigned x, unsigned& nloc, unsigned& nx) {
    const unsigned G = gridDim.x * gridDim.y * gridDim.z;
    unsigned sum, cnt, mine, sp = 0u;
    for (;;) {
        sum = 0u; cnt = 0u; mine = 0u;
#pragma unroll
        for (unsigned j = 0; j < 16; ++j) { const unsigned c = xb_ld(&bar[XB_XCNT(j)]); sum += c; cnt += (c > 0u) ? 1u : 0u; mine = (j == x) ? c : mine; }
        if (sum == G) break;
        __builtin_amdgcn_s_sleep(1);
        if ((++sp & 255u) == 0u) { if (xb_ld(&bar[XB_TMO])) break; if (sp > XB_SPIN_CAP) { atomicAdd(&bar[XB_TMO], 1u); break; } }
    }
    nloc = mine > 0u ? mine : 1u; nx = cnt > 0u ? cnt : 1u;
}

__device__ __forceinline__ void xcd_barrier(const XcdBarrier& b) {
    asm volatile("s_waitcnt vmcnt(0)" ::: "memory");
    __syncthreads();
    if (threadIdx.x == 0) {
        unsigned* bar = b.bar;
        __builtin_amdgcn_s_waitcnt(0);
        unsigned nloc = b.st[0], nx = b.st[1];
        if (nloc == 0u) { xcd_barrier_complete(bar, b.x, nloc, nx); b.st[0] = nloc; b.st[1] = nx; }
        const unsigned old = xb_add(&bar[XB_XSUB(b.x)], 1u);
        const unsigned gen = old / nloc;
        if (old + 1u == (gen + 1u) * nloc) {
            __builtin_amdgcn_fence(__ATOMIC_RELEASE, "agent");
            asm volatile("s_waitcnt vmcnt(0)" ::: "memory");
            const unsigned og = xb_add(&bar[XB_TOP], 1u);
            const unsigned tg = og / nx;
            if (og + 1u == (tg + 1u) * nx) xb_add(&bar[XB_TOPGEN], 1u);
            else XB_SPIN(xb_ld(&bar[XB_TOPGEN]) == tg, bar);
            __builtin_amdgcn_fence(__ATOMIC_ACQUIRE, "agent");
            xb_add(&bar[XB_XGEN(b.x)], 1u);
            asm volatile("s_waitcnt vmcnt(0)" ::: "memory");
        } else {
            XB_SPIN(xb_ld(&bar[XB_XGEN(b.x)]) == gen, bar);
            __builtin_amdgcn_fence(__ATOMIC_ACQUIRE, "agent");
            asm volatile("s_waitcnt vmcnt(0)" ::: "memory");
        }
    }
    __syncthreads();
}

struct Args { const float* in[21]; float* out; unsigned char* ws; int ph_lo, ph_hi, coop, pad; };

struct Frame {
    LAS unsigned char* lds; char* ldsg;
    int tid, lane, wave, vcu, G;
};

__device__ __forceinline__ void p0_transpose_item(const float* W, int K, int N, bf16* WT, int row_off, const float* gain, LAS float* scr, int item, int lane) {
    const int nblk = N / 64, kb = item / nblk, nb = item - kb * nblk, k0 = 64 * kb, n0 = 64 * nb;
    const int r4 = lane >> 4, c4 = (lane & 15) * 4;
    f32x4 v[16];
#pragma unroll
    for (int i = 0; i < 16; ++i) v[i] = *(const f32x4*)(W + (size_t)(k0 + 4 * i + r4) * N + n0 + c4);
    if (gain) {
#pragma unroll
        for (int i = 0; i < 16; ++i) v[i] = v[i] * gain[k0 + 4 * i + r4]; }
#pragma unroll
    for (int i = 0; i < 16; ++i) { LAS float* d = scr + (4 * i + r4) * 65 + c4; d[0] = v[i][0]; d[1] = v[i][1]; d[2] = v[i][2]; d[3] = v[i][3]; }
    LDS_WAIT(); asm volatile("" ::: "memory");
    const int c = lane & 7, nl = lane >> 3;
#pragma unroll
    for (int j = 0; j < 8; ++j) { const int n = nl + 8 * j; const LAS float* s = scr + (8 * c) * 65 + n;
        v4u o; o.x = pk2(s[0 * 65], s[1 * 65]); o.y = pk2(s[2 * 65], s[3 * 65]); o.z = pk2(s[4 * 65], s[5 * 65]); o.w = pk2(s[6 * 65], s[7 * 65]);
        *(v4u*)(WT + (size_t)(row_off + n0 + n) * K + k0 + 8 * c) = o; }
    LDS_WAIT(); asm volatile("" ::: "memory");
}
__device__ __forceinline__ void rms_row_to_bf16(const float* xrow, const float* w, bf16* orow, int lane) {
    const f32x4* xr = (const f32x4*)xrow + lane; const f32x4* wr = (const f32x4*)w + lane;
    f32x4 v[8]; float s = 0.f;
#pragma unroll
    for (int j = 0; j < 8; ++j) { v[j] = xr[64 * j]; s += (v[j].x * v[j].x + v[j].y * v[j].y) + (v[j].z * v[j].z + v[j].w * v[j].w); }
    const float rs = 1.0f / sqrtf(wave_sum(s) * (1.0f / 2048.0f) + EPS);
    v2u* o8 = (v2u*)orow + lane;
#pragma unroll
    for (int j = 0; j < 8; ++j) { const f32x4 g = wr[64 * j]; v2u o; o.x = pk2(v[j].x * rs * g.x, v[j].y * rs * g.y); o.y = pk2(v[j].z * rs * g.z, v[j].w * rs * g.w); o8[64 * j] = o; }
}

__device__ __forceinline__ void lds_mma128(f32x4 (&acc)[4][2], const LAS unsigned char* A, const LAS unsigned char* Bt, int wr, int wc, int fr, int fq) {
#pragma unroll
    for (int k0 = 0; k0 < 4; ++k0) {
        bf16x8 a[4], b[2];
#pragma unroll
        for (int m = 0; m < 4; ++m) a[m] = *(const LAS bf16x8*)(A + ((wr * 64 + m * 16 + fr) * LDT + k0 * 32 + fq * 8) * 2);
#pragma unroll
        for (int n = 0; n < 2; ++n) b[n] = *(const LAS bf16x8*)(Bt + ((wc * 32 + n * 16 + fr) * LDT + k0 * 32 + fq * 8) * 2);
#pragma unroll
        for (int m = 0; m < 4; ++m)
#pragma unroll
            for (int n = 0; n < 2; ++n) acc[m][n] = __builtin_amdgcn_mfma_f32_16x16x32_bf16(b[n], a[m], acc[m][n], 0, 0, 0);
    }
}
__device__ __forceinline__ void zero_acc(f32x4 (&acc)[4][2]) {
#pragma unroll
    for (int m = 0; m < 4; ++m)
#pragma unroll
        for (int n = 0; n < 2; ++n) acc[m][n] = (f32x4){0.f, 0.f, 0.f, 0.f};
}
__device__ __forceinline__ void tile_g2l(const bf16* g, size_t ld, LAS unsigned char* dst, int tid) {
    const int row = tid >> 2, seg = (tid & 3) * 32; const v4u* p = (const v4u*)(g + (size_t)row * ld + seg);
    v4u a = p[0], b = p[1], c = p[2], d = p[3];
    LAS v4u* q = (LAS v4u*)(dst + (row * LDT + seg) * 2);
    q[0] = a; q[1] = b; q[2] = c; q[3] = d;
}

__device__ __forceinline__ void ret_prep_task(const Frame& F, int task, bf16* PROJ, const f32x2* ROPE, bf16* VT, float* L, float lgf, float lgb, bool wb = true) {
    int tid = F.tid; asm volatile("" : "+v"(tid));
    const int b = task >> 9, h = (task >> 6) & 7, c = task & 63;
    const int r = tid >> 2, q = tid & 3, half = q >> 1, sub = q & 1;
    const int t = c * 128 + r, pos = half ? (t & 63) : (t >> 6);
    const f32x4* rp = (const f32x4*)(ROPE + pos * 32 + sub * 16);
    const int d1 = half * 64 + sub * 16, d2 = d1 + 32;
    const size_t tok = (size_t)b * SEQ + t;
    LAS unsigned char* B0 = F.lds; LAS unsigned char* B1 = F.lds + TILE_B; LAS unsigned char* B2 = F.lds + 2 * TILE_B;
    f32x4 cs[8];
#pragma unroll
    for (int i = 0; i < 8; ++i) cs[i] = rp[i];
    {
        bf16* row = PROJ + tok * INW + C_RQ + h * 128;
        v4u a0 = *(const v4u*)(row + d1), a1 = *(const v4u*)(row + d1 + 8), b0 = *(const v4u*)(row + d2), b1 = *(const v4u*)(row + d2 + 8);
        v4u o1[2], o2[2];
#pragma unroll
        for (int i = 0; i < 8; ++i) {
            const unsigned wa = (i < 4) ? a0[i & 3] : a1[i & 3], wb = (i < 4) ? b0[i & 3] : b1[i & 3];
            const float x1l = bflo(wa), x1h = bfhi(wa), x2l = bflo(wb), x2h = bfhi(wb);
            const float cl = cs[i][0], sl = cs[i][1], ch = cs[i][2], sh = cs[i][3];
            const float y1l = x1l * cl - x2l * sl, y2l = x2l * cl + x1l * sl, y1h = x1h * ch - x2h * sh, y2h = x2h * ch + x1h * sh;
            o1[i >> 2][i & 3] = pk2(y1l, y1h); o2[i >> 2][i & 3] = pk2(y2l, y2h);
        }
        if (wb) { *(v4u*)(row + d1) = o1[0]; *(v4u*)(row + d1 + 8) = o1[1]; *(v4u*)(row + d2) = o2[0]; *(v4u*)(row + d2 + 8) = o2[1]; }
        else if (o1[0][0] == 0x12345678u && o2[1][3] == 0x9abcdef0u) row[0] = 0;
    }
    {
        bf16* row = PROJ + tok * INW + C_RK + h * 128;
        v4u a0 = *(const v4u*)(row + d1), a1 = *(const v4u*)(row + d1 + 8), b0 = *(const v4u*)(row + d2), b1 = *(const v4u*)(row + d2 + 8);
        const float wf = __expf(lgf * (float)(127 - r)), wb_ = __expf(lgb * (float)r);
        v4u o1[2], o2[2];
#pragma unroll
        for (int i = 0; i < 8; ++i) {
            const unsigned wa = (i < 4) ? a0[i & 3] : a1[i & 3], wb = (i < 4) ? b0[i & 3] : b1[i & 3];
            const float x1l = bflo(wa), x1h = bfhi(wa), x2l = bflo(wb), x2h = bfhi(wb);
            const float cl = cs[i][0], sl = cs[i][1], ch = cs[i][2], sh = cs[i][3];
            const float sc = 0.08838834764831845f;
            const float y1l = (x1l * cl - x2l * sl) * sc, y2l = (x2l * cl + x1l * sl) * sc, y1h = (x1h * ch - x2h * sh) * sc, y2h = (x2h * ch + x1h * sh) * sc;
            o1[i >> 2][i & 3] = pk2(y1l, y1h); o2[i >> 2][i & 3] = pk2(y2l, y2h);
            const int e = 2 * i;
            *(LAS unsigned short*)(B0 + ((d1 + e) * LDT + r) * 2) = (unsigned short)f2bf(y1l * wf);
            *(LAS unsigned short*)(B0 + ((d1 + e + 1) * LDT + r) * 2) = (unsigned short)f2bf(y1h * wf);
            *(LAS unsigned short*)(B0 + ((d2 + e) * LDT + r) * 2) = (unsigned short)f2bf(y2l * wf);
            *(LAS unsigned short*)(B0 + ((d2 + e + 1) * LDT + r) * 2) = (unsigned short)f2bf(y2h * wf);
            *(LAS unsigned short*)(B1 + ((d1 + e) * LDT + r) * 2) = (unsigned short)f2bf(y1l * wb_);
            *(LAS unsigned short*)(B1 + ((d1 + e + 1) * LDT + r) * 2) = (unsigned short)f2bf(y1h * wb_);
            *(LAS unsigned short*)(B1 + ((d2 + e) * LDT + r) * 2) = (unsigned short)f2bf(y2l * wb_);
            *(LAS unsigned short*)(B1 + ((d2 + e + 1) * LDT + r) * 2) = (unsigned short)f2bf(y2h * wb_);
        }
        if (wb) { *(v4u*)(row + d1) = o1[0]; *(v4u*)(row + d1 + 8) = o1[1]; *(v4u*)(row + d2) = o2[0]; *(v4u*)(row + d2 + 8) = o2[1]; }
    }
    {
        const bf16* row = PROJ + tok * INW + C_RV + h * 128 + q * 32;
        v4u vv[4];
#pragma unroll
        for (int i = 0; i < 4; ++i) vv[i] = *(const v4u*)(row + 8 * i);
#pragma unroll
        for (int i = 0; i < 16; ++i) { const unsigned w = vv[i >> 2][i & 3]; const int dv = q * 32 + 2 * i;
            *(LAS unsigned short*)(B2 + (dv * LDT + r) * 2) = (unsigned short)(w & 0xffffu);
            *(LAS unsigned short*)(B2 + ((dv + 1) * LDT + r) * 2) = (unsigned short)(w >> 16); }
    }
    __syncthreads();
    {
        const int dv = tid >> 2, seg = (tid & 3) * 32; const LAS v4u* s = (const LAS v4u*)(B2 + (dv * LDT + seg) * 2);
        v4u* g = (v4u*)(VT + ((size_t)(b * 8 + h) * 128 + dv) * SEQ + c * 128 + seg);
        v4u x0 = s[0], x1 = s[1], x2 = s[2], x3 = s[3]; g[0] = x0; g[1] = x1; g[2] = x2; g[3] = x3;
    }
    const int wid = __builtin_amdgcn_readfirstlane(tid >> 6), lane = tid & 63, wr = wid >> 2, wc = wid & 3, fr = lane & 15, fq = lane >> 4;
#pragma unroll
    for (int dir = 0; dir < 2; ++dir) {
        f32x4 acc[4][2]; zero_acc(acc);
        lds_mma128(acc, B2, dir ? B1 : B0, wr, wc, fr, fq);
        float* Lp = L + ((size_t)(((b * 8 + h) * 2 + dir) * NCH + c)) * 16384;
#pragma unroll
        for (int m = 0; m < 4; ++m)
#pragma unroll
            for (int n = 0; n < 2; ++n) *(f32x4*)(Lp + (wr * 64 + m * 16 + fr) * 128 + wc * 32 + n * 16 + fq * 4) = acc[m][n];
    }
    __syncthreads();
}


__device__ __forceinline__ void qknorm_task(const Frame& F, int task, bf16* PROJ, const f32x2* ROPE, const float* qnw, const float* knw, bf16* scratch = nullptr) {
    int tid = F.tid; asm volatile("" : "+v"(tid));
    const int tile = task / 10, hh = task - tile * 10;
    const int r = tid >> 2, q = tid & 3, half = q >> 1, sub = q & 1;
    const int tokg = tile * 128 + r, t = tokg & (SEQ - 1), pos = half ? (t & 63) : (t >> 6);
    const int col0 = hh < 8 ? C_AQ + hh * 128 : C_AK + (hh - 8) * 128; const float* w = hh < 8 ? qnw : knw;
    const int d1 = half * 64 + sub * 16, d2 = d1 + 32;
    bf16* row = PROJ + (size_t)tokg * INW + col0;
    const v4u a0 = *(const v4u*)(row + d1), a1 = *(const v4u*)(row + d1 + 8), b0 = *(const v4u*)(row + d2), b1 = *(const v4u*)(row + d2 + 8);
    const f32x4* rp = (const f32x4*)(ROPE + pos * 32 + sub * 16);
    f32x4 cs[8], w1[4], w2[4];
#pragma unroll
    for (int i = 0; i < 8; ++i) cs[i] = rp[i];
#pragma unroll
    for (int i = 0; i < 4; ++i) { w1[i] = *(const f32x4*)(w + d1 + 4 * i); w2[i] = *(const f32x4*)(w + d2 + 4 * i); }
    float x1[16], x2[16]; float ss = 0.f;
#pragma unroll
    for (int i = 0; i < 8; ++i) { const unsigned wa = (i < 4) ? a0[i & 3] : a1[i & 3], wb = (i < 4) ? b0[i & 3] : b1[i & 3];
        x1[2 * i] = bflo(wa); x1[2 * i + 1] = bfhi(wa); x2[2 * i] = bflo(wb); x2[2 * i + 1] = bfhi(wb);
        ss += (x1[2 * i] * x1[2 * i] + x1[2 * i + 1] * x1[2 * i + 1]) + (x2[2 * i] * x2[2 * i] + x2[2 * i + 1] * x2[2 * i + 1]); }
    ss += __shfl_xor(ss, 1); ss += __shfl_xor(ss, 2);
    const float rs = 1.0f / sqrtf(ss * (1.0f / 128.0f) + EPS);
    v4u o1[2], o2[2];
#pragma unroll
    for (int i = 0; i < 8; ++i) {
        const float x1l = x1[2 * i] * rs * w1[i >> 1][(2 * i) & 3], x1h = x1[2 * i + 1] * rs * w1[i >> 1][(2 * i + 1) & 3];
        const float x2l = x2[2 * i] * rs * w2[i >> 1][(2 * i) & 3], x2h = x2[2 * i + 1] * rs * w2[i >> 1][(2 * i + 1) & 3];
        const float cl = cs[i][0], sl = cs[i][1], ch = cs[i][2], sh = cs[i][3];
        o1[i >> 2][i & 3] = pk2(x1l * cl - x2l * sl, x1h * ch - x2h * sh); o2[i >> 2][i & 3] = pk2(x2l * cl + x1l * sl, x2h * ch + x1h * sh);
    }
    bf16* drow = scratch ? scratch + (size_t)(task & 255) * 16384 + r * 128 : row;
    *(v4u*)(drow + d1) = o1[0]; *(v4u*)(drow + d1 + 8) = o1[1]; *(v4u*)(drow + d2) = o2[0]; *(v4u*)(drow + d2 + 8) = o2[1];
}

__device__ __forceinline__ void ret_out_task(const Frame& F, int task, bf16* PROJ, const bf16* VT, const bf16* ST, const float* gnw, const float* gnb, float lgf, float lgb, bf16* scratch = nullptr) {
    int tid = F.tid; asm volatile("" : "+v"(tid));
    const int b = task >> 9, h = (task >> 6) & 7, c = task & 63;
    const size_t tok0 = (size_t)b * SEQ + (size_t)c * 128;
    LAS unsigned char* B0 = F.lds; LAS unsigned char* B1 = F.lds + TILE_B; LAS unsigned char* B2 = F.lds + 2 * TILE_B; LAS unsigned char* B3 = F.lds + 3 * TILE_B;
    LAS float* red1 = (LAS float*)(F.lds + RED_OFF); LAS float* red2 = red1 + 512;
    const size_t sf = ((size_t)(((b * 8 + h) * 2 + 0) * NCH + c)) * 16384, sb = ((size_t)(((b * 8 + h) * 2 + 1) * NCH + c)) * 16384;
    tile_g2l(PROJ + tok0 * INW + C_RQ + h * 128, INW, B0, tid);
    tile_g2l(PROJ + tok0 * INW + C_RK + h * 128, INW, B1, tid);
    tile_g2l(VT + (size_t)(b * 8 + h) * 128 * SEQ + c * 128, SEQ, B2, tid);
    tile_g2l(ST + sf, 128, B3, tid);
    __syncthreads();
    const int wid = __builtin_amdgcn_readfirstlane(tid >> 6), lane = tid & 63, wr = wid >> 2, wc = wid & 3, fr = lane & 15, fq = lane >> 4;
    f32x4 accS[4][2], accO[4][2];
    zero_acc(accS); zero_acc(accO);
    lds_mma128(accS, B0, B1, wr, wc, fr, fq);
    lds_mma128(accO, B0, B3, wr, wc, fr, fq);
    __syncthreads();
#pragma unroll
    for (int m = 0; m < 4; ++m) { const int nrow = wr * 64 + m * 16 + fr; const float df = __expf(lgf * (float)(nrow + 1));
#pragma unroll
        for (int n = 0; n < 2; ++n) { const int mc0 = wc * 32 + n * 16 + fq * 4; float p[4];
#pragma unroll
            for (int j = 0; j < 4; ++j) { const int d = nrow - (mc0 + j); const float dec = __expf((float)d * (d >= 0 ? lgf : -lgb)); p[j] = accS[m][n][j] * dec; }
            v2u w; w.x = pk2(p[0], p[1]); w.y = pk2(p[2], p[3]);
            *(LAS v2u*)(B1 + (nrow * LDT + mc0) * 2) = w;
            accO[m][n] = accO[m][n] * df; } }
    tile_g2l(ST + sb, 128, B3, tid);
    __syncthreads();
    lds_mma128(accO, B1, B2, wr, wc, fr, fq);
    zero_acc(accS);
    lds_mma128(accS, B0, B3, wr, wc, fr, fq);
    float mean[4], rstd[4];
#pragma unroll
    for (int m = 0; m < 4; ++m) { const int nrow = wr * 64 + m * 16 + fr; const float db = __expf(lgb * (float)(128 - nrow)); float s = 0.f;
#pragma unroll
        for (int n = 0; n < 2; ++n) { accO[m][n] = accO[m][n] + accS[m][n] * db; s += (accO[m][n][0] + accO[m][n][1]) + (accO[m][n][2] + accO[m][n][3]); }
        s += __shfl_xor(s, 16); s += __shfl_xor(s, 32);
        if (fq == 0) red1[nrow * 4 + wc] = s; }
    __syncthreads();
#pragma unroll
    for (int m = 0; m < 4; ++m) { const int nrow = wr * 64 + m * 16 + fr; const f32x4 pr = *(const LAS f32x4*)(red1 + nrow * 4);
        mean[m] = ((pr[0] + pr[1]) + (pr[2] + pr[3])) * (1.0f / 128.0f); float s = 0.f;
#pragma unroll
        for (int n = 0; n < 2; ++n) { const f32x4 d = accO[m][n] - mean[m]; s += (d[0] * d[0] + d[1] * d[1]) + (d[2] * d[2] + d[3] * d[3]); }
        s += __shfl_xor(s, 16); s += __shfl_xor(s, 32);
        if (fq == 0) red2[nrow * 4 + wc] = s; }
    __syncthreads();
#pragma unroll
    for (int m = 0; m < 4; ++m) { const int nrow = wr * 64 + m * 16 + fr; const f32x4 pr = *(const LAS f32x4*)(red2 + nrow * 4);
        rstd[m] = 1.0f / sqrtf(((pr[0] + pr[1]) + (pr[2] + pr[3])) * (1.0f / 128.0f) + EPS);
        bf16* grow = PROJ + (tok0 + nrow) * INW + C_RG + h * 128;
#pragma unroll
        for (int n = 0; n < 2; ++n) { const int col = wc * 32 + n * 16 + fq * 4;
            const f32x4 gw = *(const f32x4*)(gnw + h * 128 + col), gb = *(const f32x4*)(gnb + h * 128 + col);
            const v2u gv = *(const v2u*)(grow + col);
            const float g0 = bflo(gv.x), g1 = bfhi(gv.x), g2 = bflo(gv.y), g3 = bfhi(gv.y);
            const f32x4 y = (accO[m][n] - mean[m]) * rstd[m] * gw + gb;
            const float o0 = y[0] * g0 / (1.0f + __expf(-g0)), o1 = y[1] * g1 / (1.0f + __expf(-g1)), o2 = y[2] * g2 / (1.0f + __expf(-g2)), o3 = y[3] * g3 / (1.0f + __expf(-g3));
            v2u w; w.x = pk2(o0, o1); w.y = pk2(o2, o3); bf16* dst = scratch ? scratch + (size_t)(task & 255) * 16384 + nrow * 128 : grow; *(v2u*)(dst + col) = w; } }
    __syncthreads();
}

__global__ void __launch_bounds__(NWAVES * 64, 2) mega_fwd(Args args) {
    extern __shared__ __attribute__((aligned(16))) unsigned char lds[];
    cg::grid_group grid = cg::this_grid();
    Frame F;
    F.lds = (LAS unsigned char*)lds; F.ldsg = (char*)lds;
    F.tid = threadIdx.x; F.lane = F.tid & 63; F.wave = __builtin_amdgcn_readfirstlane(F.tid >> 6);
    F.G = gridDim.x; { const int bx = blockIdx.x; F.vcu = (F.G % 8 == 0) ? (bx % 8) * (F.G / 8) + bx / 8 : bx; }
    unsigned char* ws = args.ws;
    const float* x = args.in[0]; const float* mem = args.in[1]; const float* norm_mix_w = args.in[2]; const float* w_in = args.in[3];
    const float* dec_f = args.in[4]; const float* dec_b = args.in[5]; const float* gnw = args.in[6]; const float* gnb = args.in[7];
    const float* qnw = args.in[8]; const float* knw = args.in[9]; const float* w_out = args.in[10]; const float* norm_cross_w = args.in[11];
    const float* norm_mem_w = args.in[12]; const float* wcq = args.in[13]; const float* wck = args.in[14]; const float* wcv = args.in[15];
    const float* wco = args.in[16]; const float* norm_mlp_w = args.in[17]; const float* w_up = args.in[18]; const float* w_dn = args.in[19];
    const float* norm_final_w = args.in[20];
    float* out = args.out;
    f32x2* ROPE = (f32x2*)(ws + WS_ROPE);
    float* SS1 = (float*)(ws + WS_SS1); float* SS2 = (float*)(ws + WS_SS2); float* SS3 = (float*)(ws + WS_SS3);
    bf16* KVC = (bf16*)(ws + WS_KVC);
    bf16* WIN = (bf16*)(ws + WS_WIN); bf16* WOUT = (bf16*)(ws + WS_WOUT); bf16* WQ = (bf16*)(ws + WS_WQ); bf16* WKV = (bf16*)(ws + WS_WKV);
    bf16* WO = (bf16*)(ws + WS_WO); bf16* WUP = (bf16*)(ws + WS_WUP); bf16* WDN = (bf16*)(ws + WS_WDN);
    bf16* XN = (bf16*)(ws + WS_XN); bf16* MN = (bf16*)(ws + WS_MN); bf16* PROJ = (bf16*)(ws + WS_PROJ); bf16* VT = (bf16*)(ws + WS_VT);
    bf16* ST = (bf16*)(ws + WS_ST); bf16* QC = (bf16*)(ws + WS_QC); bf16* U = (bf16*)(ws + WS_U);
    float* L = out;
    const int lo = args.ph_lo, hi = args.ph_hi;
    volatile LAS unsigned* misc = (volatile LAS unsigned*)(F.lds + MISC_OFF);
    if (F.tid < 4) misc[F.tid] = 0u;
    __syncthreads();
    XcdBarrier xbar; xbar.bar = (unsigned*)(ws + WS_CTL); xbar.x = 0; xbar.st = nullptr;
    if (args.coop == 1) xbar = xcd_barrier_post((unsigned*)(ws + WS_CTL), misc);
#ifndef PH_MASK
#define PH_MASK 0xfff
#endif
#define IN(k) ((((PH_MASK) >> (k)) & 1) && lo <= (k) && (k) < hi)
#ifndef REPS
#define REPS 1
#endif
#define SEAM(k) do { if (IN(k) && IN((k) + 1)) { if (args.coop == 1) { for (int rs_ = 0; rs_ < REPS; ++rs_) xcd_barrier(xbar); } else if (args.coop == 2) grid.sync(); } } while (0)
    const int gw = F.vcu * NWAVES + F.wave, NGW = F.G * NWAVES;
    const int bid = blockIdx.x, G = F.G;

#ifndef REP0
#define REP0 1
#endif
    if (IN(0)) for (int rep_ = 0; rep_ < REP0; ++rep_) {
        __syncthreads();
        LAS float* scr = (LAS float*)(F.lds + F.wave * 18432);
        constexpr int I_IN = (DM / 64) * (INW / 64), I_C = (DM / 64) * (CWID / 64);
        constexpr int NITEMS = I_IN + 2 * I_C;
        for (int it = gw; it < NITEMS; it += NGW) {
            int r = it;
            if (r < I_IN) { p0_transpose_item(w_in, DM, INW, WIN, 0, nullptr, scr, r, F.lane); continue; } r -= I_IN;
            if (r < I_C) { p0_transpose_item(wck, DM, CWID, WKV, 0, nullptr, scr, r, F.lane); continue; } r -= I_C;
            p0_transpose_item(wcv, DM, CWID, WKV, CWID, nullptr, scr, r, F.lane);
        }
        if (G != 256) {
            constexpr int I_OUT = (DM / 64) * (DM / 64), I_CO = (CWID / 64) * (DM / 64), I_UP = (DM / 64) * (DFF / 64), I_DN = (DFF / 64) * (DM / 64);
            for (int it = gw; it < I_OUT + I_C + I_CO + I_UP + I_DN; it += NGW) {
                int r = it;
                if (r < I_OUT) { p0_transpose_item(w_out, DM, DM, WOUT, 0, nullptr, scr, r, F.lane); continue; } r -= I_OUT;
                if (r < I_C) { p0_transpose_item(wcq, DM, CWID, WQ, 0, norm_cross_w, scr, r, F.lane); continue; } r -= I_C;
                if (r < I_CO) { p0_transpose_item(wco, CWID, DM, WO, 0, nullptr, scr, r, F.lane); continue; } r -= I_CO;
                if (r < I_UP) { p0_transpose_item(w_up, DM, DFF, WUP, 0, norm_mlp_w, scr, r, F.lane); continue; } r -= I_UP;
                p0_transpose_item(w_dn, DFF, DM, WDN, 0, nullptr, scr, r, F.lane);
            }
        }
        for (int m = gw; m < M + MROWS; m += NGW) {
            if (m < M) rms_row_to_bf16(x + (size_t)m * DM, norm_mix_w, XN + (size_t)m * DM, F.lane);
            else rms_row_to_bf16(mem + (size_t)(m - M) * DM, norm_mem_w, MN + (size_t)(m - M) * DM, F.lane);
        }
        for (int e = bid * 512 + F.tid; e < 128 * 32; e += G * 512) {
            const int pos = e >> 5, i = e & 31;
            double f = 1.0; for (int k = 0; k < i; ++k) f *= 0.7498942093324559;
            const float invf = (float)f; const float angf = (float)pos * invf; const double a = (double)angf;
            const double kk = __builtin_rint(a * 0.15915494309189535); const double r = a - kk * 6.283185307179586477;
            const double r2 = r * r; double tc = 1.0, cc = 1.0, ts = r, sn = r;
            for (int n = 1; n <= 16; ++n) { tc *= -r2 / (double)((2 * n - 1) * (2 * n)); cc += tc; ts *= -r2 / (double)((2 * n) * (2 * n + 1)); sn += ts; }
            ROPE[e] = (f32x2){(float)cc, (float)sn};
        }
    }
    SEAM(0);

    if (IN(1)) {
        { pg8::Gemm g{XN, WIN, M, INW, DM, DM}; pg8::StaticOrder S; S.init(M, INW, G, bid);
          pg8::EpiBf<0> E{PROJ, INW, nullptr};
          pg8::gemm_phase<pg8::EpiBf<0>, pg8::StaticOrder, true, true>(F.lds, g, S, E); }
        { pg8::Gemm g{MN, WKV, MROWS, 2 * CWID, DM, DM}; pg8::StaticOrder S; S.init(MROWS, 2 * CWID, G, (bid + G / 2) % G);
          pg8::EpiBf<0> E{KVC, 2 * CWID, nullptr};
          pg8::gemm_phase<pg8::EpiBf<0>, pg8::StaticOrder, true, true>(F.lds, g, S, E); }
        const int nfull = ((M / 256) * (INW / 256)) % G, nkv = (MROWS / 256) * (2 * CWID / 256);
        if (G == 256 && bid >= G / 2 + nkv) {
            __syncthreads();
            LAS float* scr = (LAS float*)(F.lds + F.wave * 18432);
            const int w0 = (bid - (G / 2 + nkv)) * NWAVES + F.wave, nw = (G - (G / 2 + nkv)) * NWAVES;
            constexpr int I_OUT = (DM / 64) * (DM / 64), I_C = (DM / 64) * (CWID / 64), I_CO = (CWID / 64) * (DM / 64), I_UP = (DM / 64) * (DFF / 64);
            for (int it = w0; it < I_OUT + I_C + I_CO + I_UP; it += nw) {
                int r = it;
                if (r < I_OUT) { p0_transpose_item(w_out, DM, DM, WOUT, 0, nullptr, scr, r, F.lane); continue; } r -= I_OUT;
                if (r < I_C) { p0_transpose_item(wcq, DM, CWID, WQ, 0, norm_cross_w, scr, r, F.lane); continue; } r -= I_C;
                if (r < I_CO) { p0_transpose_item(wco, CWID, DM, WO, 0, nullptr, scr, r, F.lane); continue; } r -= I_CO;
                p0_transpose_item(w_up, DM, DFF, WUP, 0, norm_mlp_w, scr, r, F.lane);
            }
        }
        (void)nfull;
    }
    SEAM(1);

    if (IN(2)) {
#ifdef PROBE_P2A
        for (int task = bid; task < BATCH * 8 * NCH; task += G) {
            const int h = (task >> 6) & 7;
            const float lgf = -expf(dec_f[h]), lgb = -expf(dec_b[h]);
            ret_prep_task(F, task, PROJ, ROPE, VT, L, lgf, lgb, false);
        }
#endif
#ifdef PROBE_P2B
        for (int task = bid; task < (M / 128) * 10; task += G) qknorm_task(F, task, PROJ, ROPE, qnw, knw, QC);
#endif
        for (int task = bid; task < BATCH * 8 * NCH; task += G) {
            const int h = (task >> 6) & 7;
            const float lgf = -expf(dec_f[h]), lgb = -expf(dec_b[h]);
            ret_prep_task(F, task, PROJ, ROPE, VT, L, lgf, lgb);
        }
        for (int task = bid; task < (M / 128) * 10; task += G) qknorm_task(F, task, PROJ, ROPE, qnw, knw);
    }
    SEAM(2);

#ifndef REP3
#define REP3 1
#endif
    if (IN(3)) for (int rep_ = 0; rep_ < REP3; ++rep_) {
        for (int e = bid * 512 + F.tid; e < 32 * 4096; e += G * 512) {
            const int series = e >> 12, off4 = e & 4095, dir = series & 1, h = (series >> 1) & 7;
            const float lg = -expf(dir ? dec_b[h] : dec_f[h]); const float g128 = expf(lg * 128.0f);
            const f32x4* Lp = (const f32x4*)(L + (size_t)series * NCH * 16384) + off4; v2u* Sp = (v2u*)(ST + (size_t)series * NCH * 16384) + off4;
            f32x4 s = (f32x4){0.f, 0.f, 0.f, 0.f};
            if (dir == 0) {
                for (int c0 = 0; c0 < NCH; c0 += 8) { f32x4 l[8];
#pragma unroll
                    for (int i = 0; i < 8; ++i) l[i] = Lp[(size_t)(c0 + i) * 4096];
#pragma unroll
                    for (int i = 0; i < 8; ++i) { v2u w; w.x = pk2(s[0], s[1]); w.y = pk2(s[2], s[3]); Sp[(size_t)(c0 + i) * 4096] = w; s = s * g128 + l[i]; } }
            } else {
                for (int c0 = NCH - 8; c0 >= 0; c0 -= 8) { f32x4 l[8];
#pragma unroll
                    for (int i = 0; i < 8; ++i) l[i] = Lp[(size_t)(c0 + i) * 4096];
#pragma unroll
                    for (int i = 7; i >= 0; --i) { v2u w; w.x = pk2(s[0], s[1]); w.y = pk2(s[2], s[3]); Sp[(size_t)(c0 + i) * 4096] = w; s = s * g128 + l[i]; } }
            }
        }
    }
    SEAM(3);

    if (IN(4)) {
#ifdef PROBE_P4A
        for (int u = bid; u < 512; u += G) {
            const int bk = u >> 7, b = bk >> 1, kvh = bk & 1, g = (u >> 5) & 3, qb = u & 31, h = kvh * 4 + g;
            bf16* Qb = PROJ + ((size_t)b * SEQ + (size_t)qb * 256) * INW + C_AQ + h * 128;
            const bf16* Kh = PROJ + (size_t)b * SEQ * INW + C_AK + kvh * 128;
            bf16* Od = (bf16*)out + ((size_t)b * SEQ + (size_t)qb * 256) * 1024 + h * 128;
            att::attn_dense_body<INW, INW, 1024, C_AV - C_AK>((const att::bf16*)Qb, (const att::bf16*)Kh, (att::bf16*)Od, SEQ, F.ldsg);
            __syncthreads();
        }
#endif
#ifdef PROBE_P4B
        for (int task = bid; task < BATCH * 8 * NCH; task += G) {
            const int h = (task >> 6) & 7;
            const float lgf = -expf(dec_f[h]), lgb = -expf(dec_b[h]);
            ret_out_task(F, task, PROJ, VT, ST, gnw, gnb, lgf, lgb, QC);
        }
#endif
#ifndef SKIP_ATT
        for (int u = bid; u < 512; u += G) {
            const int bk = u >> 7, b = bk >> 1, kvh = bk & 1, g = (u >> 5) & 3, qb = u & 31, h = kvh * 4 + g;
            bf16* Qb = PROJ + ((size_t)b * SEQ + (size_t)qb * 256) * INW + C_AQ + h * 128;
            const bf16* Kh = PROJ + (size_t)b * SEQ * INW + C_AK + kvh * 128;
            att::attn_dense_body<INW, INW, INW, C_AV - C_AK>((const att::bf16*)Qb, (const att::bf16*)Kh, (att::bf16*)Qb, SEQ, F.ldsg);
            __syncthreads();
        }
#endif
#ifndef SKIP_RET
        for (int task = bid; task < BATCH * 8 * NCH; task += G) {
            const int h = (task >> 6) & 7;
            const float lgf = -expf(dec_f[h]), lgb = -expf(dec_b[h]);
            ret_out_task(F, task, PROJ, VT, ST, gnw, gnb, lgf, lgb);
        }
#endif
    }
    SEAM(4);

    if (IN(5)) {
        pg8::Gemm g{PROJ + C_RG, WOUT, M, DM, DM, INW}; pg8::StaticOrder S; S.init(M, DM, G, bid);
        pg8::EpiResid E{x, out, XN, SS1};
        pg8::gemm_phase<pg8::EpiResid, pg8::StaticOrder, true, true>(F.lds, g, S, E);
    }
    SEAM(5);

    if (IN(6)) {
        pg8::Gemm g{XN, WQ, M, CWID, DM, DM}; pg8::StaticOrder S; S.init(M, CWID, G, bid);
        pg8::EpiBf<1> E{QC, CWID, SS1};
        pg8::gemm_phase<pg8::EpiBf<1>, pg8::StaticOrder, true, true>(F.lds, g, S, E);
        if (G == 256 && bid >= 128) {
            LAS float* scr = (LAS float*)(F.lds + F.wave * 18432);
            const int w0 = (bid - 128) * NWAVES + F.wave, nw = 128 * NWAVES;
            constexpr int I_DN = (DFF / 64) * (DM / 64);
            for (int it = w0; it < I_DN; it += nw) p0_transpose_item(w_dn, DFF, DM, WDN, 0, nullptr, scr, it, F.lane);
        }
    }
    SEAM(6);

    if (IN(7)) {
        for (int u = bid; u < BATCH * 4 * 32; u += G) {
            const int b = u >> 7, h = (u >> 5) & 3, qb = u & 31;
            bf16* Qb = QC + ((size_t)b * SEQ + (size_t)qb * 256) * CWID + h * 128;
            const bf16* Kh = KVC + (size_t)b * MEMT * (2 * CWID) + h * 128;
            att::attn_dense_body<CWID, 2 * CWID, CWID, CWID>((const att::bf16*)Qb, (const att::bf16*)Kh, (att::bf16*)Qb, MEMT, F.ldsg);
            __syncthreads();
        }
    }
    SEAM(7);

    if (IN(8)) {
        pg8::Gemm g{QC, WO, M, DM, CWID, CWID}; pg8::StaticOrder S; S.init(M, DM, G, bid);
        pg8::EpiResid E{out, out, XN, SS2};
        pg8::gemm_phase<pg8::EpiResid, pg8::StaticOrder, true, true>(F.lds, g, S, E);
    }
    SEAM(8);

    if (IN(9)) {
        pg8::Gemm g{XN, WUP, M, DFF, DM, DM}; pg8::StaticOrder S; S.init(M, DFF, G, bid);
        pg8::EpiBf<2> E{U, DFF, SS2};
        pg8::gemm_phase<pg8::EpiBf<2>, pg8::StaticOrder, true, true>(F.lds, g, S, E);
#ifdef PROBE_P9X2
        __syncthreads(); pg8::gemm_phase<pg8::EpiBf<2>, pg8::StaticOrder, true, true>(F.lds, g, S, E);
#endif
    }
    SEAM(9);

    if (IN(10)) {
        pg8::Gemm g{U, WDN, M, DM, DFF, DFF}; pg8::StaticOrder S; S.init(M, DM, G, bid);
        pg8::EpiResid E{out, out, nullptr, SS3};
        pg8::gemm_phase<pg8::EpiResid, pg8::StaticOrder, true, true>(F.lds, g, S, E);
    }
    SEAM(10);

    if (IN(11)) {
        for (int m = gw; m < M; m += NGW) {
            const float p = (F.lane < 32) ? SS3[(size_t)m * 32 + F.lane] : 0.f;
            const float rs = 1.0f / sqrtf(wave_sum(p) * (1.0f / 2048.0f) + EPS);
            f32x4* xr = (f32x4*)(out + (size_t)m * DM) + F.lane; const f32x4* wr = (const f32x4*)norm_final_w + F.lane;
#pragma unroll
            for (int j = 0; j < 8; ++j) { const f32x4 v = xr[64 * j], g = wr[64 * j]; xr[64 * j] = v * rs * g; }
        }
    }
#undef IN
#undef SEAM
}

#ifndef MK_PER_PHASE
#define MK_PER_PHASE 0
#endif
constexpr int NPHASE = 12;
extern "C" void kernel_launch(void* const* d_in, const int* in_sizes, int n_in, void* d_out, int out_size, void* d_ws, size_t ws_size, hipStream_t stream) {
    static int grid = 0;
    if (grid == 0) {
        if (n_in != 21 || in_sizes[0] != M * DM || out_size != M * DM || ws_size < WS_END) {
            fprintf(stderr, "kernel_launch: unexpected shapes: n_in %d in0 %d out %d ws %zu (need >= %zu); nothing launched\n", n_in, n_in > 0 ? in_sizes[0] : -1, out_size, ws_size, (size_t)WS_END);
            grid = -1; return; }
        int dev = 0, cus = 0, per_cu = 0;
        if (hipGetDevice(&dev) != hipSuccess || hipDeviceGetAttribute(&cus, hipDeviceAttributeMultiprocessorCount, dev) != hipSuccess) { grid = -1; return; }
        if (hipFuncSetAttribute((const void*)mega_fwd, hipFuncAttributeMaxDynamicSharedMemorySize, LDS_BYTES) != hipSuccess) { fprintf(stderr, "kernel_launch: hipFuncSetAttribute failed\n"); grid = -1; return; }
        if (hipOccupancyMaxActiveBlocksPerMultiprocessor(&per_cu, (const void*)mega_fwd, NWAVES * 64, LDS_BYTES) != hipSuccess || per_cu < 1) {
            fprintf(stderr, "kernel_launch: occupancy query says %d blocks per CU\n", per_cu); per_cu = 1; }
        (void)hipGetLastError();
        grid = cus;
    }
    if (grid < 0) return;
    Args a{};
    for (int i = 0; i < 21; ++i) a.in[i] = (const float*)d_in[i];
    a.out = (float*)d_out; a.ws = (unsigned char*)d_ws;
#if MK_PER_PHASE
    for (int p = 0; p < NPHASE; ++p) { a.ph_lo = p; a.ph_hi = p + 1; a.coop = 0; hipLaunchKernelGGL(mega_fwd, dim3(grid), dim3(NWAVES * 64), LDS_BYTES, stream, a); }
#else
    if (hipMemsetAsync((char*)d_ws + WS_CTL, 0, CTL_ZERO_BYTES, stream) != hipSuccess) { fprintf(stderr, "kernel_launch: memset failed\n"); return; }
    a.ph_lo = 0; a.ph_hi = NPHASE; a.coop = 1;
    void* kargs[] = {&a};
    const hipError_t e = hipLaunchCooperativeKernel((const void*)mega_fwd, dim3(grid), dim3(NWAVES * 64), kargs, LDS_BYTES, stream);
    if (e != hipSuccess) fprintf(stderr, "kernel_launch: cooperative launch failed: %s (grid %d)\n", hipGetErrorString(e), grid);
#endif
}
```

```cpp
#include <hip/hip_runtime.h>
#include <hip/hip_bf16.h>
#include <hip/hip_cooperative_groups.h>
#include <cstdio>
#include <cstdint>
namespace cg = cooperative_groups;
namespace pg8 {
#define PG8_LAS __attribute__((address_space(3)))
typedef unsigned short bf16_t;
typedef short bf16x8 __attribute__((ext_vector_type(8)));
typedef float f32x4 __attribute__((ext_vector_type(4)));
typedef unsigned u32x4 __attribute__((ext_vector_type(4)));
constexpr int BM = 256, BK = 64, HALF = 128, HTB = HALF * BK * 2  , STAGE_BYTES = 8 * HTB, NXCD = 8, WGM = 8;

__host__ __device__ __forceinline__ int lds_byte(int r, int c) { const int st = (r >> 4) * 2 + (c >> 5), rr = r & 15, cc = c & 31, ob = rr * 64 + cc * 2; return st * 1024 + (ob ^ (((ob >> 9) & 1) << 5)); }
__host__ __device__ __forceinline__ void stage_rc(int b, int& R, int& C) { const int st = b / 1024, sb = b % 1024, swz = sb ^ (((sb >> 9) & 1) << 5); R = (st >> 1) * 16 + swz / 64; C = (st & 1) * 32 + (swz % 64) / 2; }
__host__ __device__ __forceinline__ int perm32(int rho) { const int n = rho >> 4, i = rho & 15; return 8 * (i >> 2) + 4 * n + (i & 3); }

struct Unit { int pm, pn; };
struct Gemm { const bf16_t* A; const bf16_t* Bt; int M, N, K, lda; };

struct StaticOrder {
    int nM, nN, nwg, G, c;
    __host__ __device__ void init(int M, int N, int G_, int c_) { nM = M / BM; nN = N / BM; nwg = nM * nN; G = G_; c = c_; }
    __host__ __device__ bool next(int i, Unit& u) const {
        const long L = (long)i * G + c; if (L >= nwg) return false;
        int wgid = (int)L; { const int q = nwg / NXCD, r = nwg % NXCD, xcd = wgid % NXCD, off = wgid / NXCD; wgid = (xcd < r ? xcd * (q + 1) : r * (q + 1) + (xcd - r) * q) + off; }
        const int nig = WGM * nN, gid = wgid / nig, fm = gid * WGM, gsz = (nM - fm) < WGM ? (nM - fm) : WGM;
        u.pm = fm + ((wgid % nig) % gsz); u.pn = (wgid % nig) / gsz; return true;
    }
    __device__ __forceinline__ void a_ready(const Unit&) const {}
    __device__ __forceinline__ void done(const Unit&) const {}
};

__device__ __forceinline__ unsigned cvt_pk_bf16(float lo, float hi) { unsigned r; asm volatile("v_cvt_pk_bf16_f32 %0, %1, %2" : "=v"(r) : "v"(lo), "v"(hi)); return r; }
__device__ __forceinline__ float row_rs(const float* ss, int row, int fq) {
    const f32x4 a = *(const f32x4*)(ss + (size_t)row * 32 + fq * 8), b = *(const f32x4*)(ss + (size_t)row * 32 + fq * 8 + 4);
    float s = ((a[0] + a[1]) + (a[2] + a[3])) + ((b[0] + b[1]) + (b[2] + b[3]));
    s += __shfl_xor(s, 16); s += __shfl_xor(s, 32);
    return 1.0f / sqrtf(s * (1.0f / 2048.0f) + 1e-6f);
}
template <int MODE> struct EpiBf {
    static constexpr bool PERM = true, AFTER_DRAIN = false;
    bf16_t* O; int ldc; const float* ss;
    __device__ __forceinline__ void operator()(const f32x4 (&acc)[2][2][4][2], const Unit& u, int wr, int wc, int fr, int fq) const {
        const int row0 = u.pm * BM + wr * 64 + fr, col0 = u.pn * BM + wc * 32 + 8 * fq;
        float scv[2][4];
#pragma unroll
        for (int ai = 0; ai < 2; ++ai)
#pragma unroll
            for (int m = 0; m < 4; ++m) scv[ai][m] = (MODE != 0) ? row_rs(ss, row0 + ai * HALF + m * 16, fq) : 1.f;
#pragma unroll
        for (int ai = 0; ai < 2; ++ai)
#pragma unroll
            for (int m = 0; m < 4; ++m) { const int row = row0 + ai * HALF + m * 16; bf16_t* rowp = O + (size_t)row * ldc + col0;
                const float sc = scv[ai][m];
#pragma unroll
                for (int bj = 0; bj < 2; ++bj) { f32x4 v0 = acc[ai][bj][m][0] * sc, v1 = acc[ai][bj][m][1] * sc;
                    if (MODE == 2) {
#pragma unroll
                        for (int j = 0; j < 4; ++j) { const float a = fmaxf(v0[j], 0.f), b = fmaxf(v1[j], 0.f); v0[j] = a * a; v1[j] = b * b; } }
                    u32x4 w; w.x = cvt_pk_bf16(v0[0], v0[1]); w.y = cvt_pk_bf16(v0[2], v0[3]); w.z = cvt_pk_bf16(v1[0], v1[1]); w.w = cvt_pk_bf16(v1[2], v1[3]);
                    *(u32x4*)(rowp + bj * HALF) = w; } }
    }
};
struct EpiNull {
    static constexpr bool PERM = true, AFTER_DRAIN = false;
    bf16_t* O;
    __device__ __forceinline__ void operator()(const f32x4 (&acc)[2][2][4][2], const Unit& u, int wr, int wc, int fr, int fq) const {
        float s = 0.f;
#pragma unroll
        for (int ai = 0; ai < 2; ++ai)
#pragma unroll
            for (int bj = 0; bj < 2; ++bj)
#pragma unroll
                for (int m = 0; m < 4; ++m)
#pragma unroll
                    for (int n = 0; n < 2; ++n) s += (acc[ai][bj][m][n][0] + acc[ai][bj][m][n][1]) + (acc[ai][bj][m][n][2] + acc[ai][bj][m][n][3]);
        if (s == 1.2345e30f) O[u.pm + u.pn] = 1;
    }
};
struct EpiResid {
    static constexpr bool PERM = false, AFTER_DRAIN = false;
    const float* base; float* out; bf16_t* xb; float* ss;
    __device__ __forceinline__ void operator()(const f32x4 (&acc)[2][2][4][2], const Unit& u, int wr, int wc, int fr, int fq) const {
        typedef unsigned u32x2v __attribute__((ext_vector_type(2)));
        const int col0 = u.pn * BM + wc * 32 + 4 * fq;
#pragma unroll
        for (int ai = 0; ai < 2; ++ai) {
            f32x4 bs[4][2][2];
#pragma unroll
            for (int m = 0; m < 4; ++m) { const size_t off = (size_t)(u.pm * BM + ai * HALF + wr * 64 + m * 16 + fr) * 2048 + col0;
#pragma unroll
                for (int bj = 0; bj < 2; ++bj)
#pragma unroll
                    for (int n = 0; n < 2; ++n) bs[m][bj][n] = *(const f32x4*)(base + off + bj * HALF + n * 16); }
#pragma unroll
            for (int m = 0; m < 4; ++m) { const int row = u.pm * BM + ai * HALF + wr * 64 + m * 16 + fr; const size_t off = (size_t)row * 2048 + col0; float sq = 0.f;
#pragma unroll
                for (int bj = 0; bj < 2; ++bj)
#pragma unroll
                    for (int n = 0; n < 2; ++n) { const f32x4 x = bs[m][bj][n] + acc[ai][bj][m][n];
                        *(f32x4*)(out + off + bj * HALF + n * 16) = x; sq += (x[0] * x[0] + x[1] * x[1]) + (x[2] * x[2] + x[3] * x[3]);
                        if (xb) { u32x2v w; w.x = cvt_pk_bf16(x[0], x[1]); w.y = cvt_pk_bf16(x[2], x[3]); *(u32x2v*)(xb + off + bj * HALF + n * 16) = w; } }
                sq += __shfl_xor(sq, 16); sq += __shfl_xor(sq, 32);
                if (fq == 0) ss[(size_t)row * 32 + u.pn * 4 + wc] = sq; }
            asm volatile("" ::: "memory");
        }
    }
};

template <class Epi, class Sched, bool ALIGN_EPI = false, bool SP2 = false>
__device__ __forceinline__ void gemm_phase(PG8_LAS unsigned char* lds, const Gemm g, const Sched& S, const Epi& E) {
    const int tid = threadIdx.x, wid = __builtin_amdgcn_readfirstlane(tid >> 6), lane = tid & 63, wr = wid >> 2, wc = wid & 3, fr = lane & 15, fq = lane >> 4;
    const int K = g.K, nt = K / BK;
    unsigned voffA[2], voffB[2];
#pragma unroll
    for (int i = 0; i < 2; ++i) { int R, C; stage_rc(tid * 16 + i * 8192, R, C); const int Rb = Epi::PERM ? ((R & ~31) + perm32(R & 31)) : R;
        voffA[i] = (unsigned)(R * g.lda + C) * 2u; voffB[i] = (unsigned)(Rb * K + C) * 2u; }
    const size_t kstep = (size_t)(BK * 2);
    const size_t hstep = (size_t)HALF * K * 2;
    const size_t tstep = 2 * hstep; const size_t hstepA = (size_t)HALF * g.lda * 2, tstepA = 2 * hstepA;
    const unsigned ldsw = (unsigned)wid * 1024u;
    const int aoff = lds_byte(wr * 64 + fr, fq * 8), boff = lds_byte(wc * 32 + fr, fq * 8);
#define PG8_SA(b, h) (((b) * 2 + (h)) * HTB)
#define PG8_SB(b, h) ((4 + (b) * 2 + (h)) * HTB)
#define PG8_STAGE(bufoff, gbase, voff) do { _Pragma("unroll") for (int _i = 0; _i < 2; ++_i) \
        __builtin_amdgcn_global_load_lds((const unsigned*)((const char*)(gbase) + (voff)[_i]), (PG8_LAS unsigned*)(lds + (bufoff) + ldsw + _i * 8192), 16, 0, 0); } while (0)
#define PG8_LDA(dst, b, h) do { _Pragma("unroll") for (int m = 0; m < 4; ++m) _Pragma("unroll") for (int k = 0; k < 2; ++k) dst[m][k] = *(const PG8_LAS bf16x8*)(lds + PG8_SA(b, h) + aoff + m * 2048 + k * 1024); } while (0)
#define PG8_LDB(dst, b, h) do { _Pragma("unroll") for (int n = 0; n < 2; ++n) _Pragma("unroll") for (int k = 0; k < 2; ++k) dst[n][k] = *(const PG8_LAS bf16x8*)(lds + PG8_SB(b, h) + boff + n * 2048 + k * 1024); } while (0)
#define PG8_MMA(ai, bj, At, Bt) do { __builtin_amdgcn_s_setprio(1); _Pragma("unroll") for (int m = 0; m < 4; ++m) _Pragma("unroll") for (int n = 0; n < 2; ++n) _Pragma("unroll") for (int k = 0; k < 2; ++k) \
        acc[ai][bj][m][n] = __builtin_amdgcn_mfma_f32_16x16x32_bf16(Bt[n][k], At[m][k], acc[ai][bj][m][n], 0, 0, 0); __builtin_amdgcn_s_setprio(0); } while (0)
#define PG8_WAIT_V(n) asm volatile("s_waitcnt vmcnt(" #n ")" ::: "memory")
#define PG8_WAIT_L(n) asm volatile("s_waitcnt lgkmcnt(" #n ")" ::: "memory")
#define PG8_BAR __builtin_amdgcn_s_barrier()
#define PG8_SCHED __builtin_amdgcn_sched_barrier(0)
    Unit cur, nxt; int ui = 0;
    if (!S.next(0, cur)) return;
    f32x4 acc[2][2][4][2];
#pragma unroll
    for (int a = 0; a < 2; ++a)
#pragma unroll
        for (int b = 0; b < 2; ++b)
#pragma unroll
            for (int m = 0; m < 4; ++m)
#pragma unroll
                for (int n = 0; n < 2; ++n) acc[a][b][m][n] = (f32x4){0.f, 0.f, 0.f, 0.f};
    bf16x8 At[4][2], B0[2][2], B1[2][2];
    const char* cA = (const char*)g.A + (size_t)cur.pm * tstepA; const char* cB = (const char*)g.Bt + (size_t)cur.pn * tstep;
    S.a_ready(cur);
    if constexpr (SP2) {
        PG8_STAGE(PG8_SB(0, 0), cB, voffB); PG8_STAGE(PG8_SB(0, 1), cB + hstep, voffB); PG8_STAGE(PG8_SA(0, 0), cA, voffA); PG8_STAGE(PG8_SA(0, 1), cA + hstepA, voffA);
        if (wr == 1) PG8_BAR;
        PG8_WAIT_V(2); PG8_BAR;
        PG8_STAGE(PG8_SB(1, 0), cB + kstep, voffB); PG8_STAGE(PG8_SA(1, 0), cA + kstep, voffA); PG8_STAGE(PG8_SB(1, 1), cB + hstep + kstep, voffB);
        PG8_WAIT_V(6); PG8_BAR;
    } else {
        PG8_STAGE(PG8_SB(0, 0), cB, voffB); PG8_STAGE(PG8_SA(0, 0), cA, voffA); PG8_STAGE(PG8_SB(0, 1), cB + hstep, voffB); PG8_STAGE(PG8_SA(0, 1), cA + hstepA, voffA);
        if (wr == 1) PG8_BAR;
        PG8_WAIT_V(4); PG8_BAR;
        PG8_STAGE(PG8_SB(1, 0), cB + kstep, voffB); PG8_STAGE(PG8_SA(1, 0), cA + kstep, voffA); PG8_STAGE(PG8_SB(1, 1), cB + hstep + kstep, voffB);
        PG8_WAIT_V(6); PG8_BAR;
    }
    for (;;) {
        const bool has_next = S.next(ui + 1, nxt);
        const char* nA = has_next ? (const char*)g.A + (size_t)nxt.pm * tstepA : cA; const char* nB = has_next ? (const char*)g.Bt + (size_t)nxt.pn * tstep : cB;
        for (int t = 0; t < nt; t += 2) {
            const bool last = (t == nt - 2);
            const char* a1 = cA + (size_t)(t + 1) * kstep;
            const char* a2 = last ? nA : cA + (size_t)(t + 2) * kstep; const char* b2 = last ? nB : cB + (size_t)(t + 2) * kstep;
            const char* a3 = a2 + kstep; const char* b3 = b2 + kstep;
            if (last && has_next) S.a_ready(nxt);
            if constexpr (SP2) {
            PG8_LDB(B0, 0, 0); PG8_LDB(B1, 0, 1); PG8_SCHED; PG8_LDA(At, 0, 0); PG8_STAGE(PG8_SA(1, 1), a1 + hstepA, voffA);
            PG8_WAIT_V(8); PG8_WAIT_L(0); PG8_BAR; PG8_MMA(0, 0, At, B0); PG8_MMA(0, 1, At, B1); PG8_BAR; PG8_SCHED;
            PG8_LDA(At, 0, 1); PG8_STAGE(PG8_SB(0, 0), b2, voffB); PG8_STAGE(PG8_SB(0, 1), b2 + hstep, voffB); PG8_STAGE(PG8_SA(0, 0), a2, voffA);
            PG8_WAIT_V(8); PG8_WAIT_L(0); PG8_BAR; PG8_MMA(1, 0, At, B0); PG8_MMA(1, 1, At, B1); PG8_BAR; PG8_SCHED;
            PG8_LDB(B0, 1, 0); PG8_LDB(B1, 1, 1); PG8_SCHED; PG8_LDA(At, 1, 0); PG8_STAGE(PG8_SA(0, 1), a2 + hstepA, voffA);
            PG8_WAIT_V(8); PG8_WAIT_L(0); PG8_BAR; PG8_MMA(0, 0, At, B0); PG8_MMA(0, 1, At, B1); PG8_BAR; PG8_SCHED;
            PG8_LDA(At, 1, 1); PG8_STAGE(PG8_SB(1, 0), b3, voffB); PG8_STAGE(PG8_SB(1, 1), b3 + hstep, voffB); PG8_STAGE(PG8_SA(1, 0), a3, voffA);
            PG8_WAIT_V(8); PG8_WAIT_L(0); PG8_BAR; PG8_MMA(1, 0, At, B0); PG8_MMA(1, 1, At, B1); PG8_BAR; PG8_SCHED;
            } else {
            PG8_LDB(B0, 0, 0); PG8_SCHED; PG8_LDA(At, 0, 0); PG8_STAGE(PG8_SA(1, 1), a1 + hstepA, voffA);
            PG8_WAIT_L(8); PG8_BAR; PG8_WAIT_L(0); PG8_MMA(0, 0, At, B0); PG8_BAR; PG8_SCHED;
            PG8_LDB(B1, 0, 1); PG8_STAGE(PG8_SB(0, 0), b2, voffB);
            PG8_BAR; PG8_WAIT_L(0); PG8_MMA(0, 1, At, B1); PG8_BAR;
            PG8_LDA(At, 0, 1); PG8_STAGE(PG8_SA(0, 0), a2, voffA);
            PG8_BAR; PG8_WAIT_L(0); PG8_MMA(1, 0, At, B0); PG8_BAR; PG8_SCHED;
            PG8_STAGE(PG8_SB(0, 1), b2 + hstep, voffB);
            PG8_WAIT_V(6); PG8_BAR; PG8_MMA(1, 1, At, B1); PG8_BAR;
            PG8_LDB(B0, 1, 0); PG8_SCHED; PG8_LDA(At, 1, 0); PG8_STAGE(PG8_SA(0, 1), a2 + hstepA, voffA);
            PG8_WAIT_L(8); PG8_BAR; PG8_WAIT_L(0); PG8_MMA(0, 0, At, B0); PG8_BAR; PG8_SCHED;
            PG8_LDB(B1, 1, 1); PG8_STAGE(PG8_SB(1, 0), b3, voffB);
            PG8_BAR; PG8_WAIT_L(0); PG8_MMA(0, 1, At, B1); PG8_BAR;
            PG8_LDA(At, 1, 1); PG8_STAGE(PG8_SA(1, 0), a3, voffA);
            PG8_BAR; PG8_WAIT_L(0); PG8_MMA(1, 0, At, B0); PG8_BAR; PG8_SCHED;
            PG8_STAGE(PG8_SB(1, 1), b3 + hstep, voffB);
            PG8_WAIT_V(6); PG8_BAR; PG8_MMA(1, 1, At, B1); PG8_BAR;
            }
        }
        if constexpr (ALIGN_EPI) { if (wr == 0) PG8_BAR; }
        if constexpr (!Epi::AFTER_DRAIN) { E(acc, cur, wr, wc, fr, fq); S.done(cur); }
        if (!has_next) break;
#pragma unroll
        for (int a = 0; a < 2; ++a)
#pragma unroll
            for (int b = 0; b < 2; ++b)
#pragma unroll
                for (int m = 0; m < 4; ++m)
#pragma unroll
                    for (int n = 0; n < 2; ++n) acc[a][b][m][n] = (f32x4){0.f, 0.f, 0.f, 0.f};
        cur = nxt; cA = nA; cB = nB; ++ui;
        if constexpr (ALIGN_EPI) { if (wr == 1) PG8_BAR; }
    }
    PG8_WAIT_V(0);
    if constexpr (!ALIGN_EPI) { if (wr == 0) PG8_BAR; }
    PG8_BAR;
    if constexpr (Epi::AFTER_DRAIN) { E.fused(acc, cur, wr, wc, fr, fq, lds, wid, lane); S.done(cur); }
#undef PG8_SA
#undef PG8_SB
#undef PG8_STAGE
#undef PG8_LDA
#undef PG8_LDB
#undef PG8_MMA
#undef PG8_WAIT_V
#undef PG8_WAIT_L
#undef PG8_BAR
#undef PG8_SCHED
}
}
namespace att {
using bf16 = __hip_bfloat16;
constexpr int   D = 128, NW = 8, QBLK = 32, KVBLK = 64;
constexpr float SCALE = 0.088388347648318440f;
constexpr float THR = 8.f;
constexpr int SDEPTH = 2;
constexpr size_t SHM_V = KVBLK * D * 2, SHM_K = KVBLK * D * 2, SHM_ATTN = 2 * SHM_V + 2 * SHM_K + NW * 64 * 4;
using bf16x8 = __attribute__((ext_vector_type(8))) short;
using s16x4  = __attribute__((ext_vector_type(4))) short;
using f32x16 = __attribute__((ext_vector_type(16))) float;
using f32x8  = __attribute__((ext_vector_type(8))) float;
using u32x4  = __attribute__((ext_vector_type(4))) unsigned;
#define KSWZ(row, colB) ((row) * 256 + ((colB) ^ (((row) & 7) << 4)))
#define SBAR() __builtin_amdgcn_sched_barrier(0)
__device__ __forceinline__ int crow(int r, int hi) { return (r & 3) + 8 * (r >> 2) + 4 * hi; }
__device__ __forceinline__ unsigned cvtpk(float lo, float hi) {
  unsigned r; asm volatile("v_cvt_pk_bf16_f32 %0, %1, %2" : "=v"(r) : "v"(lo), "v"(hi)); return r;
}
struct StageB { using T = bf16x8;
  __device__ static __forceinline__ T ld8(const bf16* p) { return *reinterpret_cast<const bf16x8*>(p); }
  __device__ static __forceinline__ bf16x8 tobf(T x) { return x; } };

__device__ __forceinline__ void partialSM(f32x16& p0, f32x16& p1, float& m_reg, float& mn, float& alpha) {
  constexpr float C = SCALE * 1.4426950408889634f;
  float pmax = p0[0]; for (int r = 1; r < 16; ++r) pmax = fmaxf(pmax, p0[r]); for (int r = 0; r < 16; ++r) pmax = fmaxf(pmax, p1[r]);
  { auto rr = __builtin_amdgcn_permlane32_swap(__float_as_uint(pmax), __float_as_uint(pmax), false, false);
    pmax = fmaxf(__uint_as_float(rr[0]), __uint_as_float(rr[1])); }
  if (__builtin_expect(__all(pmax - m_reg <= THR / SCALE), 1)) { mn = m_reg; alpha = 1.f; }
  else { mn = fmaxf(m_reg, pmax); alpha = __builtin_amdgcn_exp2f((m_reg - mn) * C); m_reg = mn; }
  float mnC = -mn * C;
  for (int r = 0; r < 16; ++r) p0[r] = fmaf(p0[r], C, mnC); for (int r = 0; r < 16; ++r) p1[r] = fmaf(p1[r], C, mnC);
  for (int r = 0; r < 16; ++r) p0[r] = __builtin_amdgcn_exp2f(p0[r]);
}
__device__ __forceinline__ void finishSM(f32x16& p0, f32x16& p1, float alpha, float& l_reg, bf16x8& pa0, bf16x8& pa1, bf16x8& pa2, bf16x8& pa3) {
  for (int r = 0; r < 16; ++r) p1[r] = __builtin_amdgcn_exp2f(p1[r]);
  float ps = 0; for (int r = 0; r < 16; ++r) ps += p0[r]; for (int r = 0; r < 16; ++r) ps += p1[r];
  { auto rr = __builtin_amdgcn_permlane32_swap(__float_as_uint(ps), __float_as_uint(ps), false, false);
    ps = __uint_as_float(rr[0]) + __uint_as_float(rr[1]); }
  l_reg = l_reg * alpha + ps;
#define PK4(P, BASE, OUT) do { unsigned a0 = cvtpk(P[BASE + 0], P[BASE + 1]), a1 = cvtpk(P[BASE + 2], P[BASE + 3]);   \
    unsigned b0 = cvtpk(P[BASE + 4], P[BASE + 5]), b1 = cvtpk(P[BASE + 6], P[BASE + 7]);                              \
    auto r0 = __builtin_amdgcn_permlane32_swap(a0, b0, false, false); auto r1 = __builtin_amdgcn_permlane32_swap(a1, b1, false, false); \
    u32x4 w = {r0[0], r1[0], r0[1], r1[1]}; OUT = *reinterpret_cast<bf16x8*>(&w); } while (0)
  PK4(p0, 0, pa0); PK4(p0, 8, pa1); PK4(p1, 0, pa2); PK4(p1, 8, pa3);
#undef PK4
}
__device__ __forceinline__ void qkt(f32x16& p0, f32x16& p1, const bf16* Ks, const bf16x8* qr, int r32, int hi) {
  p0 = f32x16{}; p1 = f32x16{};
  for (int d0 = 0; d0 < 8; ++d0) { int cb = (d0 * 16 + hi * 8) * 2;
    bf16x8 b0 = *reinterpret_cast<const bf16x8*>((const char*)Ks + KSWZ(r32, cb));
    bf16x8 b1 = *reinterpret_cast<const bf16x8*>((const char*)Ks + KSWZ(32 + r32, cb));
    p0 = __builtin_amdgcn_mfma_f32_32x32x16_bf16(b0, qr[d0], p0, 0, 0, 0);
    p1 = __builtin_amdgcn_mfma_f32_32x32x16_bf16(b1, qr[d0], p1, 0, 0, 0); }
}
__device__ __forceinline__ int v_st(int k, int c) { const int kk = (k & ~0xC) | ((k & 4) << 1) | ((k & 8) >> 1); return ((kk >> 3) * 4 + (c >> 5)) * 512 + ((kk & 7) * 32 + (c & 31)) * 2; }
__device__ __forceinline__ int v_rd_base(int lane) { return ((lane & 3) << 3) | (((lane >> 2) & 3) << 6) | (((lane >> 4) & 1) << 5) | (((lane >> 5) & 1) << 8); }
constexpr int v_rd_off(int d0, int ks, int half) { return d0 * 512 + ks * 4096 + half * 2048; }
template <int OFF> __device__ __forceinline__ s16x4 tr_read(int vb) {
  s16x4 r; asm volatile("ds_read_b64_tr_b16 %0, %1 offset:%2" : "=&v"(r) : "v"(vb), "i"(OFF) : "memory"); return r;
}
template <int D0> __device__ __forceinline__ void pv_one(f32x16& od, int vb, bf16x8 pa0, bf16x8 pa1, bf16x8 pa2, bf16x8 pa3) {
  const s16x4 l0 = tr_read<v_rd_off(D0, 0, 0)>(vb), h0 = tr_read<v_rd_off(D0, 0, 1)>(vb), l1 = tr_read<v_rd_off(D0, 1, 0)>(vb), h1 = tr_read<v_rd_off(D0, 1, 1)>(vb);
  const s16x4 l2 = tr_read<v_rd_off(D0, 2, 0)>(vb), h2 = tr_read<v_rd_off(D0, 2, 1)>(vb), l3 = tr_read<v_rd_off(D0, 3, 0)>(vb), h3 = tr_read<v_rd_off(D0, 3, 1)>(vb);
  asm volatile("s_waitcnt lgkmcnt(0)" ::: "memory"); SBAR();
#define PK(L, H) (bf16x8){L[0], L[1], L[2], L[3], H[0], H[1], H[2], H[3]}
  od = __builtin_amdgcn_mfma_f32_32x32x16_bf16(pa0, PK(l0, h0), od, 0, 0, 0);
  od = __builtin_amdgcn_mfma_f32_32x32x16_bf16(pa1, PK(l1, h1), od, 0, 0, 0);
  od = __builtin_amdgcn_mfma_f32_32x32x16_bf16(pa2, PK(l2, h2), od, 0, 0, 0);
  od = __builtin_amdgcn_mfma_f32_32x32x16_bf16(pa3, PK(l3, h3), od, 0, 0, 0);
#undef PK
}
__device__ __forceinline__ void pv_d0(f32x16* o, int vb, bf16x8 pa0, bf16x8 pa1, bf16x8 pa2, bf16x8 pa3) {
  pv_one<0>(o[0], vb, pa0, pa1, pa2, pa3); pv_one<1>(o[1], vb, pa0, pa1, pa2, pa3); pv_one<2>(o[2], vb, pa0, pa1, pa2, pa3); pv_one<3>(o[3], vb, pa0, pa1, pa2, pa3);
}

template <int LDQ, int LDK, int LDO, int VOFF>
__device__ __forceinline__ void attn_dense_body(const bf16* Qb, const bf16* __restrict__ Kh,
                                                bf16* Ob, int seq, char* lds) {
  using St = StageB; using SQ = StageB;
  const int tid = threadIdx.x, wid = tid >> 6, lane = tid & 63, r32 = lane & 31, hi = lane >> 5;
  bf16* V_lds = (bf16*)lds; bf16* K_lds = (bf16*)(lds + 2 * SHM_V);
  float* ws = (float*)(lds + 2 * SHM_V + 2 * SHM_K) + wid * 64; float* li_l = ws; float* al_l = ws + 32;
  float m_reg = -1e30f, l_reg = 0; f32x16 o[4] = {}; bf16x8 qr[8];
  const bf16* Qw = Qb + (long)(wid * QBLK + r32) * LDQ + hi * 8;
#pragma unroll
  for (int d0 = 0; d0 < 8; ++d0) qr[d0] = SQ::tobf(SQ::ld8(Qw + d0 * 16));
  const int sr = tid >> 4, sc = (tid & 15) * 8, vst0 = v_st(sr, sc), vst1 = v_st(32 + sr, sc);
  const int vb0 = (int)(uintptr_t)V_lds + v_rd_base(lane);
  struct { typename St::T vs0, vs1, ks0, ks1; } sr_[SDEPTH];
  const unsigned kvo0 = (unsigned)(sr * LDK + sc) * 2u, kvo1 = kvo0 + 32u * LDK * 2u;
#define SLOAD(i, k0) do { const char* kb_ = (const char*)Kh + (size_t)(k0) * (LDK * 2); \
    sr_[i].vs0 = *(const bf16x8*)(kb_ + kvo0 + VOFF * 2); sr_[i].vs1 = *(const bf16x8*)(kb_ + kvo1 + VOFF * 2); \
    sr_[i].ks0 = *(const bf16x8*)(kb_ + kvo0); sr_[i].ks1 = *(const bf16x8*)(kb_ + kvo1); } while (0)
#define SWRITE(b, i) do { *(bf16x8*)((char*)V_lds + (b) * SHM_V + vst0) = St::tobf(sr_[i].vs0);          \
    *(bf16x8*)((char*)V_lds + (b) * SHM_V + vst1) = St::tobf(sr_[i].vs1); int kc = sc * 2;               \
    *(bf16x8*)((char*)K_lds + (b) * SHM_K + KSWZ(sr, kc)) = St::tobf(sr_[i].ks0);                       \
    *(bf16x8*)((char*)K_lds + (b) * SHM_K + KSWZ(32 + sr, kc)) = St::tobf(sr_[i].ks1); } while (0)
#define SWAIT() do { if constexpr (SDEPTH == 2) asm volatile("s_waitcnt vmcnt(4)" ::: "memory"); else asm volatile("s_waitcnt vmcnt(0)" ::: "memory"); } while (0)
#define RESC(a) do { if (__any((a) < 1.f)) { if (hi == 0) al_l[r32] = (a); asm volatile("s_waitcnt lgkmcnt(0)" ::: "memory"); \
    for (int d = 0; d < 4; ++d) for (int r = 0; r < 16; ++r) o[d][r] *= al_l[crow(r, hi)]; } } while (0)
  f32x16 pA0, pA1, pB0, pB1; float mnA, mnB, alA, alB; bf16x8 pa0, pa1, pa2, pa3; const int NT = seq / KVBLK;
  constexpr int SE = 0, SO = SDEPTH - 1;
  SLOAD(SE, 0); asm volatile("s_waitcnt vmcnt(0)" ::: "memory"); SWRITE(0, SE); __syncthreads();
  qkt(pA0, pA1, K_lds, qr, r32, hi); partialSM(pA0, pA1, m_reg, mnA, alA);
  SLOAD(SO, KVBLK); if constexpr (SDEPTH == 2) { if (2 < NT) SLOAD(SE, 2 * KVBLK); }
  SWAIT(); SWRITE(1, SO); __syncthreads();
  for (int j = 1; j + 1 < NT; j += 2) {
    SBAR(); qkt(pB0, pB1, (bf16*)((char*)K_lds + SHM_K), qr, r32, hi);
    finishSM(pA0, pA1, alA, l_reg, pa0, pa1, pa2, pa3); SBAR();
    SLOAD(SO, (j + SDEPTH) * KVBLK); SBAR();
    pv_d0(o, vb0, pa0, pa1, pa2, pa3); partialSM(pB0, pB1, m_reg, mnB, alB);
    __syncthreads(); SWAIT(); SWRITE(0, SE);
    RESC(alB); __syncthreads();
    SBAR(); qkt(pA0, pA1, K_lds, qr, r32, hi);
    finishSM(pB0, pB1, alB, l_reg, pa0, pa1, pa2, pa3); SBAR();
    if (SDEPTH == 1 || j + 3 < NT) SLOAD(SE, (j + 1 + SDEPTH) * KVBLK); SBAR();
    pv_d0(o, vb0 + (int)SHM_V, pa0, pa1, pa2, pa3); partialSM(pA0, pA1, m_reg, mnA, alA);
    __syncthreads(); SWAIT(); SWRITE(1, SO);
    RESC(alA); __syncthreads();
  }
  SBAR(); qkt(pB0, pB1, (bf16*)((char*)K_lds + SHM_K), qr, r32, hi);
  finishSM(pA0, pA1, alA, l_reg, pa0, pa1, pa2, pa3); SBAR();
  pv_d0(o, vb0, pa0, pa1, pa2, pa3); partialSM(pB0, pB1, m_reg, mnB, alB);
  __syncthreads(); RESC(alB);
  finishSM(pB0, pB1, alB, l_reg, pa0, pa1, pa2, pa3); SBAR();
  pv_d0(o, vb0 + (int)SHM_V, pa0, pa1, pa2, pa3);
  if (hi == 0) li_l[r32] = l_reg; asm volatile("s_waitcnt lgkmcnt(0)" ::: "memory");
  float rli[16];
#pragma unroll
  for (int r = 0; r < 16; ++r) rli[r] = __builtin_amdgcn_rcpf(li_l[crow(r, hi)]);
  unsigned short* Ow = (unsigned short*)Ob + (long)(wid * QBLK) * LDO;
  int hi_o = hi, r32_o = r32; asm volatile("" : "+v"(hi_o), "+v"(r32_o));
  const unsigned lane_off = (unsigned)(4 * hi_o * LDO + r32_o);
#pragma unroll
  for (int r = 0; r < 16; ++r) {
#pragma unroll
    for (int d0 = 0; d0 < 4; ++d0) Ow[lane_off + (unsigned)(((r & 3) + 8 * (r >> 2)) * LDO + d0 * 32)] = (unsigned short)(cvtpk(o[d0][r] * rli[r], 0.f) & 0xffffu); }
#undef SLOAD
#undef SWRITE
#undef SWAIT
#undef RESC
}

}
constexpr int BATCH = 2, SEQ = 8192, DM = 2048, M = BATCH * SEQ, INW = 5632, DFF = 8192, CWID = 512, MEMT = 256, MROWS = BATCH * MEMT;
constexpr int C_RQ = 0, C_RK = 1024, C_RV = 2048, C_RG = 3072, C_AQ = 4096, C_AK = 5120, C_AV = 5376;
constexpr int NCH = 64;
constexpr float EPS = 1e-6f;
constexpr int NWAVES = 8;
constexpr size_t MiB = 1u << 20;
constexpr size_t WS_ROPE = 0;
constexpr size_t WS_CTL = 512 * 1024, CTL_ZERO_BYTES = 16384;
constexpr size_t WS_SS1 = 1 * MiB, WS_SS2 = 3 * MiB, WS_SS3 = 5 * MiB;
constexpr size_t WS_KVC = 7 * MiB;
constexpr size_t WS_WIN = 8 * MiB, WS_WOUT = 30 * MiB, WS_WQ = 38 * MiB, WS_WKV = 40 * MiB, WS_WO = 44 * MiB, WS_WUP = 46 * MiB, WS_WDN = 78 * MiB;
constexpr size_t WS_XN = 110 * MiB;
constexpr size_t WS_MN = 174 * MiB;
constexpr size_t WS_PROJ = 176 * MiB;
constexpr size_t WS_VT = 352 * MiB;
constexpr size_t WS_ST = 384 * MiB;
constexpr size_t WS_QC = 448 * MiB;
constexpr size_t WS_U = 176 * MiB;
constexpr size_t WS_END = 464 * MiB;
static_assert(WS_U + (size_t)M * DFF * 2 <= WS_QC, "U overlay");
constexpr int LDS_BYTES = 147456;
constexpr int LDT = 136, TILE_B = 128 * LDT * 2;
constexpr int RED_OFF = 4 * TILE_B;
constexpr int MISC_OFF = LDS_BYTES - 64;
static_assert(MISC_OFF + 16 <= LDS_BYTES && RED_OFF + 4096 <= MISC_OFF && 7 * 18432 + 64 * 65 * 4 <= MISC_OFF, "LDS map");

#define LAS __attribute__((address_space(3)))
typedef unsigned short bf16;
typedef unsigned v4u __attribute__((ext_vector_type(4)));
typedef unsigned v2u __attribute__((ext_vector_type(2)));
typedef float f32x4 __attribute__((ext_vector_type(4)));
typedef float f32x2 __attribute__((ext_vector_type(2)));
typedef short bf16x8 __attribute__((ext_vector_type(8)));
#define LDS_WAIT() asm volatile("s_waitcnt lgkmcnt(0)" ::: "memory")
__device__ __forceinline__ unsigned f2bf(float f) { unsigned u = __builtin_bit_cast(unsigned, f); return (u + 0x7fffu + ((u >> 16) & 1u)) >> 16; }
__device__ __forceinline__ unsigned pk2(float lo, float hi) { return f2bf(lo) | (f2bf(hi) << 16); }
__device__ __forceinline__ float bflo(unsigned w) { return __uint_as_float(w << 16); }
__device__ __forceinline__ float bfhi(unsigned w) { return __uint_as_float(w & 0xffff0000u); }
__device__ __forceinline__ float bf1(unsigned short h) { return __uint_as_float((unsigned)h << 16); }
__device__ __forceinline__ float wave_sum(float v) {
#pragma unroll
    for (int o = 1; o < 64; o <<= 1) v += __shfl_xor(v, o);
    return v;
}

#define XB_TMO      128
#define XB_XCNT(j)  (256  + 64 * (j))
#define XB_XSUB(j)  (1280 + 64 * (j))
#define XB_XGEN(j)  (2304 + 64 * (j))
#define XB_TOP      3328
#define XB_TOPGEN   3392
#define XCD_BAR_WORDS 3456
#define XB_SPIN_CAP (1u << 18)

__device__ __forceinline__ unsigned xb_ld(unsigned* p)              { return __hip_atomic_load(p, __ATOMIC_RELAXED, __HIP_MEMORY_SCOPE_AGENT); }
__device__ __forceinline__ unsigned xb_add(unsigned* p, unsigned v) { return __hip_atomic_fetch_add(p, v, __ATOMIC_RELAXED, __HIP_MEMORY_SCOPE_AGENT); }
__device__ __forceinline__ unsigned xb_xcc_id() { return (unsigned)__builtin_amdgcn_s_getreg((3 << 11) | 20) & 0xFu; }
#define XB_SPIN(cond, bar) do { unsigned _sp = 0; while (cond) { __builtin_amdgcn_s_sleep(1); \
    if ((++_sp & 255u) == 0u) { if (xb_ld(&(bar)[XB_TMO])) break; if (_sp > XB_SPIN_CAP) { atomicAdd(&(bar)[XB_TMO], 1u); break; } } } } while (0)

struct XcdBarrier {
    unsigned* bar; unsigned x;
    volatile LAS unsigned* st;
};

__device__ __forceinline__ XcdBarrier xcd_barrier_post(unsigned* bar, volatile LAS unsigned* st) {
    XcdBarrier b; b.bar = bar; b.x = xb_xcc_id(); b.st = st;
    if (threadIdx.x == 0) (void)xb_add(&bar[XB_XCNT(b.x)], 1u);
    return b;
}
__device__ __forceinline__ void xcd_barrier_complete(unsigned* bar, unsigned x, unsigned& nloc, unsigned& nx) {
    const unsigned G = gridDim.x * gridDim.y * gridDim.z;
    unsigned sum, cnt, mine, sp = 0u;
    for (;;) {
        sum = 0u; cnt = 0u; mine = 0u;
#pragma unroll
        for (unsigned j = 0; j < 16; ++j) { const unsigned c = xb_ld(&bar[XB_XCNT(j)]); sum += c; cnt += (c > 0u) ? 1u : 0u; mine = (j == x) ? c : mine; }
        if (sum == G) break;
        __builtin_amdgcn_s_sleep(1);
        if ((++sp & 255u) == 0u) { if (xb_ld(&bar[XB_TMO])) break; if (sp > XB_SPIN_CAP) { atomicAdd(&bar[XB_TMO], 1u); break; } }
    }
    nloc = mine > 0u ? mine : 1u; nx = cnt > 0u ? cnt : 1u;
}

__device__ __forceinline__ void xcd_barrier(const XcdBarrier& b) {
    asm volatile("s_waitcnt vmcnt(0)" ::: "memory");
    __syncthreads();
    if (threadIdx.x == 0) {
        unsigned* bar = b.bar;
        __builtin_amdgcn_s_waitcnt(0);
        unsigned nloc = b.st[0], nx = b.st[1];
        if (nloc == 0u) { xcd_barrier_complete(bar, b.x, nloc, nx); b.st[0] = nloc; b.st[1] = nx; }
        const unsigned old = xb_add(&bar[XB_XSUB(b.x)], 1u);
        const unsigned gen = old / nloc;
        if (old + 1u == (gen + 1u) * nloc) {
            __builtin_amdgcn_fence(__ATOMIC_RELEASE, "agent");
            asm volatile("s_waitcnt vmcnt(0)" ::: "memory");
            const unsigned og = xb_add(&bar[XB_TOP], 1u);
            const unsigned tg = og / nx;
            if (og + 1u == (tg + 1u) * nx) xb_add(&bar[XB_TOPGEN], 1u);
            else XB_SPIN(xb_ld(&bar[XB_TOPGEN]) == tg, bar);
            __builtin_amdgcn_fence(__ATOMIC_ACQUIRE, "agent");
            xb_add(&bar[XB_XGEN(b.x)], 1u);
            asm volatile("s_waitcnt vmcnt(0)" ::: "memory");
        } else {
            XB_SPIN(xb_ld(&bar[XB_XGEN(b.x)]) == gen, bar);
            __builtin_amdgcn_fence(__ATOMIC_ACQUIRE, "agent");
            asm volatile("s_waitcnt vmcnt(0)" ::: "memory");
        }
    }
    __syncthreads();
}

struct Args { const float* in[21]; float* out; unsigned char* ws; int ph_lo, ph_hi, coop, pad; };

struct Frame {
    LAS unsigned char* lds; char* ldsg;
    int tid, lane, wave, vcu, G;
};

__device__ __forceinline__ void p0_transpose_item(const float* W, int K, int N, bf16* WT, int row_off, const float* gain, LAS float* scr, int item, int lane) {
    const int nblk = N / 64, kb = item / nblk, nb = item - kb * nblk, k0 = 64 * kb, n0 = 64 * nb;
    const int r4 = lane >> 4, c4 = (lane & 15) * 4;
    f32x4 v[16];
#pragma unroll
    for (int i = 0; i < 16; ++i) v[i] = *(const f32x4*)(W + (size_t)(k0 + 4 * i + r4) * N + n0 + c4);
    if (gain) {
#pragma unroll
        for (int i = 0; i < 16; ++i) v[i] = v[i] * gain[k0 + 4 * i + r4]; }
#pragma unroll
    for (int i = 0; i < 16; ++i) { LAS float* d = scr + (4 * i + r4) * 65 + c4; d[0] = v[i][0]; d[1] = v[i][1]; d[2] = v[i][2]; d[3] = v[i][3]; }
    LDS_WAIT(); asm volatile("" ::: "memory");
    const int c = lane & 7, nl = lane >> 3;
#pragma unroll
    for (int j = 0; j < 8; ++j) { const int n = nl + 8 * j; const LAS float* s = scr + (8 * c) * 65 + n;
        v4u o; o.x = pk2(s[0 * 65], s[1 * 65]); o.y = pk2(s[2 * 65], s[3 * 65]); o.z = pk2(s[4 * 65], s[5 * 65]); o.w = pk2(s[6 * 65], s[7 * 65]);
        *(v4u*)(WT + (size_t)(row_off + n0 + n) * K + k0 + 8 * c) = o; }
    LDS_WAIT(); asm volatile("" ::: "memory");
}
__device__ __forceinline__ void rms_row_to_bf16(const float* xrow, const float* w, bf16* orow, int lane) {
    const f32x4* xr = (const f32x4*)xrow + lane; const f32x4* wr = (const f32x4*)w + lane;
    f32x4 v[8]; float s = 0.f;
#pragma unroll
    for (int j = 0; j < 8; ++j) { v[j] = xr[64 * j]; s += (v[j].x * v[j].x + v[j].y * v[j].y) + (v[j].z * v[j].z + v[j].w * v[j].w); }
    const float rs = 1.0f / sqrtf(wave_sum(s) * (1.0f / 2048.0f) + EPS);
    v2u* o8 = (v2u*)orow + lane;
#pragma unroll
    for (int j = 0; j < 8; ++j) { const f32x4 g = wr[64 * j]; v2u o; o.x = pk2(v[j].x * rs * g.x, v[j].y * rs * g.y); o.y = pk2(v[j].z * rs * g.z, v[j].w * rs * g.w); o8[64 * j] = o; }
}

__device__ __forceinline__ void lds_mma128(f32x4 (&acc)[4][2], const LAS unsigned char* A, const LAS unsigned char* Bt, int wr, int wc, int fr, int fq) {
#pragma unroll
    for (int k0 = 0; k0 < 4; ++k0) {
        bf16x8 a[4], b[2];
#pragma unroll
        for (int m = 0; m < 4; ++m) a[m] = *(const LAS bf16x8*)(A + ((wr * 64 + m * 16 + fr) * LDT + k0 * 32 + fq * 8) * 2);
#pragma unroll
        for (int n = 0; n < 2; ++n) b[n] = *(const LAS bf16x8*)(Bt + ((wc * 32 + n * 16 + fr) * LDT + k0 * 32 + fq * 8) * 2);
#pragma unroll
        for (int m = 0; m < 4; ++m)
#pragma unroll
            for (int n = 0; n < 2; ++n) acc[m][n] = __builtin_amdgcn_mfma_f32_16x16x32_bf16(b[n], a[m], acc[m][n], 0, 0, 0);
    }
}
__device__ __forceinline__ void zero_acc(f32x4 (&acc)[4][2]) {
#pragma unroll
    for (int m = 0; m < 4; ++m)
#pragma unroll
        for (int n = 0; n < 2; ++n) acc[m][n] = (f32x4){0.f, 0.f, 0.f, 0.f};
}
__device__ __forceinline__ void tile_g2l(const bf16* g, size_t ld, LAS unsigned char* dst, int tid) {
    const int row = tid >> 2, seg = (tid & 3) * 32; const v4u* p = (const v4u*)(g + (size_t)row * ld + seg);
    v4u a = p[0], b = p[1], c = p[2], d = p[3];
    LAS v4u* q = (LAS v4u*)(dst + (row * LDT + seg) * 2);
    q[0] = a; q[1] = b; q[2] = c; q[3] = d;
}

__device__ __forceinline__ void ret_prep_task(const Frame& F, int task, bf16* PROJ, const f32x2* ROPE, bf16* VT, float* L, float lgf, float lgb, bool wb = true) {
    int tid = F.tid; asm volatile("" : "+v"(tid));
    const int b = task >> 9, h = (task >> 6) & 7, c = task & 63;
    const int r = tid >> 2, q = tid & 3, half = q >> 1, sub = q & 1;
    const int t = c * 128 + r, pos = half ? (t & 63) : (t >> 6);
    const f32x4* rp = (const f32x4*)(ROPE + pos * 32 + sub * 16);
    const int d1 = half * 64 + sub * 16, d2 = d1 + 32;
    const size_t tok = (size_t)b * SEQ + t;
    LAS unsigned char* B0 = F.lds; LAS unsigned char* B1 = F.lds + TILE_B; LAS unsigned char* B2 = F.lds + 2 * TILE_B;
    f32x4 cs[8];
#pragma unroll
    for (int i = 0; i < 8; ++i) cs[i] = rp[i];
    {
        bf16* row = PROJ + tok * INW + C_RQ + h * 128;
        v4u a0 = *(const v4u*)(row + d1), a1 = *(const v4u*)(row + d1 + 8), b0 = *(const v4u*)(row + d2), b1 = *(const v4u*)(row + d2 + 8);
        v4u o1[2], o2[2];
#pragma unroll
        for (int i = 0; i < 8; ++i) {
            const unsigned wa = (i < 4) ? a0[i & 3] : a1[i & 3], wb = (i < 4) ? b0[i & 3] : b1[i & 3];
            const float x1l = bflo(wa), x1h = bfhi(wa), x2l = bflo(wb), x2h = bfhi(wb);
            const float cl = cs[i][0], sl = cs[i][1], ch = cs[i][2], sh = cs[i][3];
            const float y1l = x1l * cl - x2l * sl, y2l = x2l * cl + x1l * sl, y1h = x1h * ch - x2h * sh, y2h = x2h * ch + x1h * sh;
            o1[i >> 2][i & 3] = pk2(y1l, y1h); o2[i >> 2][i & 3] = pk2(y2l, y2h);
        }
        if (wb) { *(v4u*)(row + d1) = o1[0]; *(v4u*)(row + d1 + 8) = o1[1]; *(v4u*)(row + d2) = o2[0]; *(v4u*)(row + d2 + 8) = o2[1]; }
        else if (o1[0][0] == 0x12345678u && o2[1][3] == 0x9abcdef0u) row[0] = 0;
    }
    {
        bf16* row = PROJ + tok * INW + C_RK + h * 128;
        v4u a0 = *(const v4u*)(row + d1), a1 = *(const v4u*)(row + d1 + 8), b0 = *(const v4u*)(row + d2), b1 = *(const v4u*)(row + d2 + 8);
        const float wf = __expf(lgf * (float)(127 - r)), wb_ = __expf(lgb * (float)r);
        v4u o1[2], o2[2];
#pragma unroll
        for (int i = 0; i < 8; ++i) {
            const unsigned wa = (i < 4) ? a0[i & 3] : a1[i & 3], wb = (i < 4) ? b0[i & 3] : b1[i & 3];
            const float x1l = bflo(wa), x1h = bfhi(wa), x2l = bflo(wb), x2h = bfhi(wb);
            const float cl = cs[i][0], sl = cs[i][1], ch = cs[i][2], sh = cs[i][3];
            const float sc = 0.08838834764831845f;
            const float y1l = (x1l * cl - x2l * sl) * sc, y2l = (x2l * cl + x1l * sl) * sc, y1h = (x1h * ch - x2h * sh) * sc, y2h = (x2h * ch + x1h * sh) * sc;
            o1[i >> 2][i & 3] = pk2(y1l, y1h); o2[i >> 2][i & 3] = pk2(y2l, y2h);
            const int e = 2 * i;
            *(LAS unsigned short*)(B0 + ((d1 + e) * LDT + r) * 2) = (unsigned short)f2bf(y1l * wf);
            *(LAS unsigned short*)(B0 + ((d1 + e + 1) * LDT + r) * 2) = (unsigned short)f2bf(y1h * wf);
            *(LAS unsigned short*)(B0 + ((d2 + e) * LDT + r) * 2) = (unsigned short)f2bf(y2l * wf);
            *(LAS unsigned short*)(B0 + ((d2 + e + 1) * LDT + r) * 2) = (unsigned short)f2bf(y2h * wf);
            *(LAS unsigned short*)(B1 + ((d1 + e) * LDT + r) * 2) = (unsigned short)f2bf(y1l * wb_);
            *(LAS unsigned short*)(B1 + ((d1 + e + 1) * LDT + r) * 2) = (unsigned short)f2bf(y1h * wb_);
            *(LAS unsigned short*)(B1 + ((d2 + e) * LDT + r) * 2) = (unsigned short)f2bf(y2l * wb_);
            *(LAS unsigned short*)(B1 + ((d2 + e + 1) * LDT + r) * 2) = (unsigned short)f2bf(y2h * wb_);
        }
        if (wb) { *(v4u*)(row + d1) = o1[0]; *(v4u*)(row + d1 + 8) = o1[1]; *(v4u*)(row + d2) = o2[0]; *(v4u*)(row + d2 + 8) = o2[1]; }
    }
    {
        const bf16* row = PROJ + tok * INW + C_RV + h * 128 + q * 32;
        v4u vv[4];
#pragma unroll
        for (int i = 0; i < 4; ++i) vv[i] = *(const v4u*)(row + 8 * i);
#pragma unroll
        for (int i = 0; i < 16; ++i) { const unsigned w = vv[i >> 2][i & 3]; const int dv = q * 32 + 2 * i;
            *(LAS unsigned short*)(B2 + (dv * LDT + r) * 2) = (unsigned short)(w & 0xffffu);
            *(LAS unsigned short*)(B2 + ((dv + 1) * LDT + r) * 2) = (unsigned short)(w >> 16); }
    }
    __syncthreads();
    {
        const int dv = tid >> 2, seg = (tid & 3) * 32; const LAS v4u* s = (const LAS v4u*)(B2 + (dv * LDT + seg) * 2);
        v4u* g = (v4u*)(VT + ((size_t)(b * 8 + h) * 128 + dv) * SEQ + c * 128 + seg);
        v4u x0 = s[0], x1 = s[1], x2 = s[2], x3 = s[3]; g[0] = x0; g[1] = x1; g[2] = x2; g[3] = x3;
    }
    const int wid = __builtin_amdgcn_readfirstlane(tid >> 6), lane = tid & 63, wr = wid >> 2, wc = wid & 3, fr = lane & 15, fq = lane >> 4;
#pragma unroll
    for (int dir = 0; dir < 2; ++dir) {
        f32x4 acc[4][2]; zero_acc(acc);
        lds_mma128(acc, B2, dir ? B1 : B0, wr, wc, fr, fq);
        float* Lp = L + ((size_t)(((b * 8 + h) * 2 + dir) * NCH + c)) * 16384;
#pragma unroll
        for (int m = 0; m < 4; ++m)
#pragma unroll
            for (int n = 0; n < 2; ++n) *(f32x4*)(Lp + (wr * 64 + m * 16 + fr) * 128 + wc * 32 + n * 16 + fq * 4) = acc[m][n];
    }
    __syncthreads();
}


__device__ __forceinline__ void qknorm_task(const Frame& F, int task, bf16* PROJ, const f32x2* ROPE, const float* qnw, const float* knw, bf16* scratch = nullptr) {
    int tid = F.tid; asm volatile("" : "+v"(tid));
    const int tile = task / 10, hh = task - tile * 10;
    const int r = tid >> 2, q = tid & 3, half = q >> 1, sub = q & 1;
    const int tokg = tile * 128 + r, t = tokg & (SEQ - 1), pos = half ? (t & 63) : (t >> 6);
    const int col0 = hh < 8 ? C_AQ + hh * 128 : C_AK + (hh - 8) * 128; const float* w = hh < 8 ? qnw : knw;
    const int d1 = half * 64 + sub * 16, d2 = d1 + 32;
    bf16* row = PROJ + (size_t)tokg * INW + col0;
    const v4u a0 = *(const v4u*)(row + d1), a1 = *(const v4u*)(row + d1 + 8), b0 = *(const v4u*)(row + d2), b1 = *(const v4u*)(row + d2 + 8);
    const f32x4* rp = (const f32x4*)(ROPE + pos * 32 + sub * 16);
    f32x4 cs[8], w1[4], w2[4];
#pragma unroll
    for (int i = 0; i < 8; ++i) cs[i] = rp[i];
#pragma unroll
    for (int i = 0; i < 4; ++i) { w1[i] = *(const f32x4*)(w + d1 + 4 * i); w2[i] = *(const f32x4*)(w + d2 + 4 * i); }
    float x1[16], x2[16]; float ss = 0.f;
#pragma unroll
    for (int i = 0; i < 8; ++i) { const unsigned wa = (i < 4) ? a0[i & 3] : a1[i & 3], wb = (i < 4) ? b0[i & 3] : b1[i & 3];
        x1[2 * i] = bflo(wa); x1[2 * i + 1] = bfhi(wa); x2[2 * i] = bflo(wb); x2[2 * i + 1] = bfhi(wb);
        ss += (x1[2 * i] * x1[2 * i] + x1[2 * i + 1] * x1[2 * i + 1]) + (x2[2 * i] * x2[2 * i] + x2[2 * i + 1] * x2[2 * i + 1]); }
    ss += __shfl_xor(ss, 1); ss += __shfl_xor(ss, 2);
    const float rs = 1.0f / sqrtf(ss * (1.0f / 128.0f) + EPS);
    v4u o1[2], o2[2];
#pragma unroll
    for (int i = 0; i < 8; ++i) {
        const float x1l = x1[2 * i] * rs * w1[i >> 1][(2 * i) & 3], x1h = x1[2 * i + 1] * rs * w1[i >> 1][(2 * i + 1) & 3];
        const float x2l = x2[2 * i] * rs * w2[i >> 1][(2 * i) & 3], x2h = x2[2 * i + 1] * rs * w2[i >> 1][(2 * i + 1) & 3];
        const float cl = cs[i][0], sl = cs[i][1], ch = cs[i][2], sh = cs[i][3];
        o1[i >> 2][i & 3] = pk2(x1l * cl - x2l * sl, x1h * ch - x2h * sh); o2[i >> 2][i & 3] = pk2(x2l * cl + x1l * sl, x2h * ch + x1h * sh);
    }
    bf16* drow = scratch ? scratch + (size_t)(task & 255) * 16384 + r * 128 : row;
    *(v4u*)(drow + d1) = o1[0]; *(v4u*)(drow + d1 + 8) = o1[1]; *(v4u*)(drow + d2) = o2[0]; *(v4u*)(drow + d2 + 8) = o2[1];
}

__device__ __forceinline__ void ret_out_task(const Frame& F, int task, bf16* PROJ, const bf16* VT, const bf16* ST, const float* gnw, const float* gnb, float lgf, float lgb, bf16* scratch = nullptr) {
    int tid = F.tid; asm volatile("" : "+v"(tid));
    const int b = task >> 9, h = (task >> 6) & 7, c = task & 63;
    const size_t tok0 = (size_t)b * SEQ + (size_t)c * 128;
    LAS unsigned char* B0 = F.lds; LAS unsigned char* B1 = F.lds + TILE_B; LAS unsigned char* B2 = F.lds + 2 * TILE_B; LAS unsigned char* B3 = F.lds + 3 * TILE_B;
    LAS float* red1 = (LAS float*)(F.lds + RED_OFF); LAS float* red2 = red1 + 512;
    const size_t sf = ((size_t)(((b * 8 + h) * 2 + 0) * NCH + c)) * 16384, sb = ((size_t)(((b * 8 + h) * 2 + 1) * NCH + c)) * 16384;
    tile_g2l(PROJ + tok0 * INW + C_RQ + h * 128, INW, B0, tid);
    tile_g2l(PROJ + tok0 * INW + C_RK + h * 128, INW, B1, tid);
    tile_g2l(VT + (size_t)(b * 8 + h) * 128 * SEQ + c * 128, SEQ, B2, tid);
    tile_g2l(ST + sf, 128, B3, tid);
    __syncthreads();
    const int wid = __builtin_amdgcn_readfirstlane(tid >> 6), lane = tid & 63, wr = wid >> 2, wc = wid & 3, fr = lane & 15, fq = lane >> 4;
    f32x4 accS[4][2], accO[4][2];
    zero_acc(accS); zero_acc(accO);
    lds_mma128(accS, B0, B1, wr, wc, fr, fq);
    lds_mma128(accO, B0, B3, wr, wc, fr, fq);
    __syncthreads();
#pragma unroll
    for (int m = 0; m < 4; ++m) { const int nrow = wr * 64 + m * 16 + fr; const float df = __expf(lgf * (float)(nrow + 1));
#pragma unroll
        for (int n = 0; n < 2; ++n) { const int mc0 = wc * 32 + n * 16 + fq * 4; float p[4];
#pragma unroll
            for (int j = 0; j < 4; ++j) { const int d = nrow - (mc0 + j); const float dec = __expf((float)d * (d >= 0 ? lgf : -lgb)); p[j] = accS[m][n][j] * dec; }
            v2u w; w.x = pk2(p[0], p[1]); w.y = pk2(p[2], p[3]);
            *(LAS v2u*)(B1 + (nrow * LDT + mc0) * 2) = w;
            accO[m][n] = accO[m][n] * df; } }
    tile_g2l(ST + sb, 128, B3, tid);
    __syncthreads();
    lds_mma128(accO, B1, B2, wr, wc, fr, fq);
    zero_acc(accS);
    lds_mma128(accS, B0, B3, wr, wc, fr, fq);
    float mean[4], rstd[4];
#pragma unroll
    for (int m = 0; m < 4; ++m) { const int nrow = wr * 64 + m * 16 + fr; const float db = __expf(lgb * (float)(128 - nrow)); float s = 0.f;
#pragma unroll
        for (int n = 0; n < 2; ++n) { accO[m][n] = accO[m][n] + accS[m][n] * db; s += (accO[m][n][0] + accO[m][n][1]) + (accO[m][n][2] + accO[m][n][3]); }
        s += __shfl_xor(s, 16); s += __shfl_xor(s, 32);
        if (fq == 0) red1[nrow * 4 + wc] = s; }
    __syncthreads();
#pragma unroll
    for (int m = 0; m < 4; ++m) { const int nrow = wr * 64 + m * 16 + fr; const f32x4 pr = *(const LAS f32x4*)(red1 + nrow * 4);
        mean[m] = ((pr[0] + pr[1]) + (pr[2] + pr[3])) * (1.0f / 128.0f); float s = 0.f;
#pragma unroll
        for (int n = 0; n < 2; ++n) { const f32x4 d = accO[m][n] - mean[m]; s += (d[0] * d[0] + d[1] * d[1]) + (d[2] * d[2] + d[3] * d[3]); }
        s += __shfl_xor(s, 16); s += __shfl_xor(s, 32);
        if (fq == 0) red2[nrow * 4 + wc] = s; }
    __syncthreads();
#pragma unroll
    for (int m = 0; m < 4; ++m) { const int nrow = wr * 64 + m * 16 + fr; const f32x4 pr = *(const LAS f32x4*)(red2 + nrow * 4);
        rstd[m] = 1.0f / sqrtf(((pr[0] + pr[1]) + (pr[2] + pr[3])) * (1.0f / 128.0f) + EPS);
        bf16* grow = PROJ + (tok0 + nrow) * INW + C_RG + h * 128;
#pragma unroll
        for (int n = 0; n < 2; ++n) { const int col = wc * 32 + n * 16 + fq * 4;
            const f32x4 gw = *(const f32x4*)(gnw + h * 128 + col), gb = *(const f32x4*)(gnb + h * 128 + col);
            const v2u gv = *(const v2u*)(grow + col);
            const float g0 = bflo(gv.x), g1 = bfhi(gv.x), g2 = bflo(gv.y), g3 = bfhi(gv.y);
            const f32x4 y = (accO[m][n] - mean[m]) * rstd[m] * gw + gb;
            const float o0 = y[0] * g0 / (1.0f + __expf(-g0)), o1 = y[1] * g1 / (1.0f + __expf(-g1)), o2 = y[2] * g2 / (1.0f + __expf(-g2)), o3 = y[3] * g3 / (1.0f + __expf(-g3));
            v2u w; w.x = pk2(o0, o1); w.y = pk2(o2, o3); bf16* dst = scratch ? scratch + (size_t)(task & 255) * 16384 + nrow * 128 : grow; *(v2u*)(dst + col) = w; } }
    __syncthreads();
}

__global__ void __launch_bounds__(NWAVES * 64, 2) mega_fwd(Args args) {
    extern __shared__ __attribute__((aligned(16))) unsigned char lds[];
    cg::grid_group grid = cg::this_grid();
    Frame F;
    F.lds = (LAS unsigned char*)lds; F.ldsg = (char*)lds;
    F.tid = threadIdx.x; F.lane = F.tid & 63; F.wave = __builtin_amdgcn_readfirstlane(F.tid >> 6);
    F.G = gridDim.x; { const int bx = blockIdx.x; F.vcu = (F.G % 8 == 0) ? (bx % 8) * (F.G / 8) + bx / 8 : bx; }
    unsigned char* ws = args.ws;
    const float* x = args.in[0]; const float* mem = args.in[1]; const float* norm_mix_w = args.in[2]; const float* w_in = args.in[3];
    const float* dec_f = args.in[4]; const float* dec_b = args.in[5]; const float* gnw = args.in[6]; const float* gnb = args.in[7];
    const float* qnw = args.in[8]; const float* knw = args.in[9]; const float* w_out = args.in[10]; const float* norm_cross_w = args.in[11];
    const float* norm_mem_w = args.in[12]; const float* wcq = args.in[13]; const float* wck = args.in[14]; const float* wcv = args.in[15];
    const float* wco = args.in[16]; const float* norm_mlp_w = args.in[17]; const float* w_up = args.in[18]; const float* w_dn = args.in[19];
    const float* norm_final_w = args.in[20];
    float* out = args.out;
    f32x2* ROPE = (f32x2*)(ws + WS_ROPE);
    float* SS1 = (float*)(ws + WS_SS1); float* SS2 = (float*)(ws + WS_SS2); float* SS3 = (float*)(ws + WS_SS3);
    bf16* KVC = (bf16*)(ws + WS_KVC);
    bf16* WIN = (bf16*)(ws + WS_WIN); bf16* WOUT = (bf16*)(ws + WS_WOUT); bf16* WQ = (bf16*)(ws + WS_WQ); bf16* WKV = (bf16*)(ws + WS_WKV);
    bf16* WO = (bf16*)(ws + WS_WO); bf16* WUP = (bf16*)(ws + WS_WUP); bf16* WDN = (bf16*)(ws + WS_WDN);
    bf16* XN = (bf16*)(ws + WS_XN); bf16* MN = (bf16*)(ws + WS_MN); bf16* PROJ = (bf16*)(ws + WS_PROJ); bf16* VT = (bf16*)(ws + WS_VT);
    bf16* ST = (bf16*)(ws + WS_ST); bf16* QC = (bf16*)(ws + WS_QC); bf16* U = (bf16*)(ws + WS_U);
    float* L = out;
    const int lo = args.ph_lo, hi = args.ph_hi;
    volatile LAS unsigned* misc = (volatile LAS unsigned*)(F.lds + MISC_OFF);
    if (F.tid < 4) misc[F.tid] = 0u;
    __syncthreads();
    XcdBarrier xbar; xbar.bar = (unsigned*)(ws + WS_CTL); xbar.x = 0; xbar.st = nullptr;
    if (args.coop == 1) xbar = xcd_barrier_post((unsigned*)(ws + WS_CTL), misc);
#ifndef PH_MASK
#define PH_MASK 0xfff
#endif
#define IN(k) ((((PH_MASK) >> (k)) & 1) && lo <= (k) && (k) < hi)
#ifndef REPS
#define REPS 1
#endif
#define SEAM(k) do { if (IN(k) && IN((k) + 1)) { if (args.coop == 1) { for (int rs_ = 0; rs_ < REPS; ++rs_) xcd_barrier(xbar); } else if (args.coop == 2) grid.sync(); } } while (0)
    const int gw = F.vcu * NWAVES + F.wave, NGW = F.G * NWAVES;
    const int bid = blockIdx.x, G = F.G;

#ifndef REP0
#define REP0 1
#endif
    if (IN(0)) for (int rep_ = 0; rep_ < REP0; ++rep_) {
        __syncthreads();
        LAS float* scr = (LAS float*)(F.lds + F.wave * 18432);
        constexpr int I_IN = (DM / 64) * (INW / 64), I_C = (DM / 64) * (CWID / 64);
        constexpr int NITEMS = I_IN + 2 * I_C;
        for (int it = gw; it < NITEMS; it += NGW) {
            int r = it;
            if (r < I_IN) { p0_transpose_item(w_in, DM, INW, WIN, 0, nullptr, scr, r, F.lane); continue; } r -= I_IN;
            if (r < I_C) { p0_transpose_item(wck, DM, CWID, WKV, 0, nullptr, scr, r, F.lane); continue; } r -= I_C;
            p0_transpose_item(wcv, DM, CWID, WKV, CWID, nullptr, scr, r, F.lane);
        }
        if (G != 256) {
            constexpr int I_OUT = (DM / 64) * (DM / 64), I_CO = (CWID / 64) * (DM / 64), I_UP = (DM / 64) * (DFF / 64), I_DN = (DFF / 64) * (DM / 64);
            for (int it = gw; it < I_OUT + I_C + I_CO + I_UP + I_DN; it += NGW) {
                int r = it;
                if (r < I_OUT) { p0_transpose_item(w_out, DM, DM, WOUT, 0, nullptr, scr, r, F.lane); continue; } r -= I_OUT;
                if (r < I_C) { p0_transpose_item(wcq, DM, CWID, WQ, 0, norm_cross_w, scr, r, F.lane); continue; } r -= I_C;
                if (r < I_CO) { p0_transpose_item(wco, CWID, DM, WO, 0, nullptr, scr, r, F.lane); continue; } r -= I_CO;
                if (r < I_UP) { p0_transpose_item(w_up, DM, DFF, WUP, 0, norm_mlp_w, scr, r, F.lane); continue; } r -= I_UP;
                p0_transpose_item(w_dn, DFF, DM, WDN, 0, nullptr, scr, r, F.lane);
            }
        }
        for (int m = gw; m < M + MROWS; m += NGW) {
            if (m < M) rms_row_to_bf16(x + (size_t)m * DM, norm_mix_w, XN + (size_t)m * DM, F.lane);
            else rms_row_to_bf16(mem + (size_t)(m - M) * DM, norm_mem_w, MN + (size_t)(m - M) * DM, F.lane);
        }
        for (int e = bid * 512 + F.tid; e < 128 * 32; e += G * 512) {
            const int pos = e >> 5, i = e & 31;
            double f = 1.0; for (int k = 0; k < i; ++k) f *= 0.7498942093324559;
            const float invf = (float)f; const float angf = (float)pos * invf; const double a = (double)angf;
            const double kk = __builtin_rint(a * 0.15915494309189535); const double r = a - kk * 6.283185307179586477;
            const double r2 = r * r; double tc = 1.0, cc = 1.0, ts = r, sn = r;
            for (int n = 1; n <= 16; ++n) { tc *= -r2 / (double)((2 * n - 1) * (2 * n)); cc += tc; ts *= -r2 / (double)((2 * n) * (2 * n + 1)); sn += ts; }
            ROPE[e] = (f32x2){(float)cc, (float)sn};
        }
    }
    SEAM(0);

    if (IN(1)) {
        { pg8::Gemm g{XN, WIN, M, INW, DM, DM}; pg8::StaticOrder S; S.init(M, INW, G, bid);
          pg8::EpiBf<0> E{PROJ, INW, nullptr};
          pg8::gemm_phase<pg8::EpiBf<0>, pg8::StaticOrder, true, true>(F.lds, g, S, E); }
        { pg8::Gemm g{MN, WKV, MROWS, 2 * CWID, DM, DM}; pg8::StaticOrder S; S.init(MROWS, 2 * CWID, G, (bid + G / 2) % G);
          pg8::EpiBf<0> E{KVC, 2 * CWID, nullptr};
          pg8::gemm_phase<pg8::EpiBf<0>, pg8::StaticOrder, true, true>(F.lds, g, S, E); }
        const int nfull = ((M / 256) * (INW / 256)) % G, nkv = (MROWS / 256) * (2 * CWID / 256);
        if (G == 256 && bid >= G / 2 + nkv) {
            __syncthreads();
            LAS float* scr = (LAS float*)(F.lds + F.wave * 18432);
            const int w0 = (bid - (G / 2 + nkv)) * NWAVES + F.wave, nw = (G - (G / 2 + nkv)) * NWAVES;
            constexpr int I_OUT = (DM / 64) * (DM / 64), I_C = (DM / 64) * (CWID / 64), I_CO = (CWID / 64) * (DM / 64), I_UP = (DM / 64) * (DFF / 64);
            for (int it = w0; it < I_OUT + I_C + I_CO + I_UP; it += nw) {
                int r = it;
                if (r < I_OUT) { p0_transpose_item(w_out, DM, DM, WOUT, 0, nullptr, scr, r, F.lane); continue; } r -= I_OUT;
                if (r < I_C) { p0_transpose_item(wcq, DM, CWID, WQ, 0, norm_cross_w, scr, r, F.lane); continue; } r -= I_C;
                if (r < I_CO) { p0_transpose_item(wco, CWID, DM, WO, 0, nullptr, scr, r, F.lane); continue; } r -= I_CO;
                p0_transpose_item(w_up, DM, DFF, WUP, 0, norm_mlp_w, scr, r, F.lane);
            }
        }
        (void)nfull;
    }
    SEAM(1);

    if (IN(2)) {
#ifdef PROBE_P2A
        for (int task = bid; task < BATCH * 8 * NCH; task += G) {
            const int h = (task >> 6) & 7;
            const float lgf = -expf(dec_f[h]), lgb = -expf(dec_b[h]);
            ret_prep_task(F, task, PROJ, ROPE, VT, L, lgf, lgb, false);
        }
#endif
#ifdef PROBE_P2B
        for (int task = bid; task < (M / 128) * 10; task += G) qknorm_task(F, task, PROJ, ROPE, qnw, knw, QC);
#endif
        for (int task = bid; task < BATCH * 8 * NCH; task += G) {
            const int h = (task >> 6) & 7;
            const float lgf = -expf(dec_f[h]), lgb = -expf(dec_b[h]);
            ret_prep_task(F, task, PROJ, ROPE, VT, L, lgf, lgb);
        }
        for (int task = bid; task < (M / 128) * 10; task += G) qknorm_task(F, task, PROJ, ROPE, qnw, knw);
    }
    SEAM(2);

#ifndef REP3
#define REP3 1
#endif
    if (IN(3)) for (int rep_ = 0; rep_ < REP3; ++rep_) {
        for (int e = bid * 512 + F.tid; e < 32 * 4096; e += G * 512) {
            const int series = e >> 12, off4 = e & 4095, dir = series & 1, h = (series >> 1) & 7;
            const float lg = -expf(dir ? dec_b[h] : dec_f[h]); const float g128 = expf(lg * 128.0f);
            const f32x4* Lp = (const f32x4*)(L + (size_t)series * NCH * 16384) + off4; v2u* Sp = (v2u*)(ST + (size_t)series * NCH * 16384) + off4;
            f32x4 s = (f32x4){0.f, 0.f, 0.f, 0.f};
            if (dir == 0) {
                for (int c0 = 0; c0 < NCH; c0 += 8) { f32x4 l[8];
#pragma unroll
                    for (int i = 0; i < 8; ++i) l[i] = Lp[(size_t)(c0 + i) * 4096];
#pragma unroll
                    for (int i = 0; i < 8; ++i) { v2u w; w.x = pk2(s[0], s[1]); w.y = pk2(s[2], s[3]); Sp[(size_t)(c0 + i) * 4096] = w; s = s * g128 + l[i]; } }
            } else {
                for (int c0 = NCH - 8; c0 >= 0; c0 -= 8) { f32x4 l[8];
#pragma unroll
                    for (int i = 0; i < 8; ++i) l[i] = Lp[(size_t)(c0 + i) * 4096];
#pragma unroll
                    for (int i = 7; i >= 0; --i) { v2u w; w.x = pk2(s[0], s[1]); w.y = pk2(s[2], s[3]); Sp[(size_t)(c0 + i) * 4096] = w; s = s * g128 + l[i]; } }
            }
        }
    }
    SEAM(3);

    if (IN(4)) {
#ifdef PROBE_P4A
        for (int u = bid; u < 512; u += G) {
            const int bk = u >> 7, b = bk >> 1, kvh = bk & 1, g = (u >> 5) & 3, qb = u & 31, h = kvh * 4 + g;
            bf16* Qb = PROJ + ((size_t)b * SEQ + (size_t)qb * 256) * INW + C_AQ + h * 128;
            const bf16* Kh = PROJ + (size_t)b * SEQ * INW + C_AK + kvh * 128;
            bf16* Od = (bf16*)out + ((size_t)b * SEQ + (size_t)qb * 256) * 1024 + h * 128;
            att::attn_dense_body<INW, INW, 1024, C_AV - C_AK>((const att::bf16*)Qb, (const att::bf16*)Kh, (att::bf16*)Od, SEQ, F.ldsg);
            __syncthreads();
        }
#endif
#ifdef PROBE_P4B
        for (int task = bid; task < BATCH * 8 * NCH; task += G) {
            const int h = (task >> 6) & 7;
            const float lgf = -expf(dec_f[h]), lgb = -expf(dec_b[h]);
            ret_out_task(F, task, PROJ, VT, ST, gnw, gnb, lgf, lgb, QC);
        }
#endif
#ifndef SKIP_ATT
        for (int u = bid; u < 512; u += G) {
            const int bk = u >> 7, b = bk >> 1, kvh = bk & 1, g = (u >> 5) & 3, qb = u & 31, h = kvh * 4 + g;
            bf16* Qb = PROJ + ((size_t)b * SEQ + (size_t)qb * 256) * INW + C_AQ + h * 128;
            const bf16* Kh = PROJ + (size_t)b * SEQ * INW + C_AK + kvh * 128;
            att::attn_dense_body<INW, INW, INW, C_AV - C_AK>((const att::bf16*)Qb, (const att::bf16*)Kh, (att::bf16*)Qb, SEQ, F.ldsg);
            __syncthreads();
        }
#endif
#ifndef SKIP_RET
        for (int task = bid; task < BATCH * 8 * NCH; task += G) {
            const int h = (task >> 6) & 7;
            const float lgf = -expf(dec_f[h]), lgb = -expf(dec_b[h]);
            ret_out_task(F, task, PROJ, VT, ST, gnw, gnb, lgf, lgb);
        }
#endif
    }
    SEAM(4);

    if (IN(5)) {
        pg8::Gemm g{PROJ + C_RG, WOUT, M, DM, DM, INW}; pg8::StaticOrder S; S.init(M, DM, G, bid);
        pg8::EpiResid E{x, out, XN, SS1};
        pg8::gemm_phase<pg8::EpiResid, pg8::StaticOrder, true, true>(F.lds, g, S, E);
    }
    SEAM(5);

    if (IN(6)) {
        pg8::Gemm g{XN, WQ, M, CWID, DM, DM}; pg8::StaticOrder S; S.init(M, CWID, G, bid);
        pg8::EpiBf<1> E{QC, CWID, SS1};
        pg8::gemm_phase<pg8::EpiBf<1>, pg8::StaticOrder, true, true>(F.lds, g, S, E);
        if (G == 256 && bid >= 128) {
            LAS float* scr = (LAS float*)(F.lds + F.wave * 18432);
            const int w0 = (bid - 128) * NWAVES + F.wave, nw = 128 * NWAVES;
            constexpr int I_DN = (DFF / 64) * (DM / 64);
            for (int it = w0; it < I_DN; it += nw) p0_transpose_item(w_dn, DFF, DM, WDN, 0, nullptr, scr, it, F.lane);
        }
    }
    SEAM(6);

    if (IN(7)) {
        for (int u = bid; u < BATCH * 4 * 32; u += G) {
            const int b = u >> 7, h = (u >> 5) & 3, qb = u & 31;
            bf16* Qb = QC + ((size_t)b * SEQ + (size_t)qb * 256) * CWID + h * 128;
            const bf16* Kh = KVC + (size_t)b * MEMT * (2 * CWID) + h * 128;
            att::attn_dense_body<CWID, 2 * CWID, CWID, CWID>((const att::bf16*)Qb, (const att::bf16*)Kh, (att::bf16*)Qb, MEMT, F.ldsg);
            __syncthreads();
        }
    }
    SEAM(7);

    if (IN(8)) {
        pg8::Gemm g{QC, WO, M, DM, CWID, CWID}; pg8::StaticOrder S; S.init(M, DM, G, bid);
        pg8::EpiResid E{out, out, XN, SS2};
        pg8::gemm_phase<pg8::EpiResid, pg8::StaticOrder, true, true>(F.lds, g, S, E);
    }
    SEAM(8);

    if (IN(9)) {
        pg8::Gemm g{XN, WUP, M, DFF, DM, DM}; pg8::StaticOrder S; S.init(M, DFF, G, bid);
        pg8::EpiBf<2> E{U, DFF, SS2};
        pg8::gemm_phase<pg8::EpiBf<2>, pg8::StaticOrder, true, true>(F.lds, g, S, E);
#ifdef PROBE_P9X2
        __syncthreads(); pg8::gemm_phase<pg8::EpiBf<2>, pg8::StaticOrder, true, true>(F.lds, g, S, E);
#endif
#ifdef PROBE_P9NULL
        __syncthreads(); { pg8::EpiNull EN{U}; pg8::gemm_phase<pg8::EpiNull, pg8::StaticOrder, true, true>(F.lds, g, S, EN); }
#endif
    }
    SEAM(9);

    if (IN(10)) {
        pg8::Gemm g{U, WDN, M, DM, DFF, DFF}; pg8::StaticOrder S; S.init(M, DM, G, bid);
        pg8::EpiResid E{out, out, nullptr, SS3};
        pg8::gemm_phase<pg8::EpiResid, pg8::StaticOrder, true, true>(F.lds, g, S, E);
    }
    SEAM(10);

    if (IN(11)) {
        for (int m = gw; m < M; m += NGW) {
            const float p = (F.lane < 32) ? SS3[(size_t)m * 32 + F.lane] : 0.f;
            const float rs = 1.0f / sqrtf(wave_sum(p) * (1.0f / 2048.0f) + EPS);
            f32x4* xr = (f32x4*)(out + (size_t)m * DM) + F.lane; const f32x4* wr = (const f32x4*)norm_final_w + F.lane;
#pragma unroll
            for (int j = 0; j < 8; ++j) { const f32x4 v = xr[64 * j], g = wr[64 * j]; xr[64 * j] = v * rs * g; }
        }
    }
#undef IN
#undef SEAM
}

#ifndef MK_PER_PHASE
#define MK_PER_PHASE 0
#endif
constexpr int NPHASE = 12;
extern "C" void kernel_launch(void* const* d_in, const int* in_sizes, int n_in, void* d_out, int out_size, void* d_ws, size_t ws_size, hipStream_t stream) {
    static int grid = 0;
    if (grid == 0) {
        if (n_in != 21 || in_sizes[0] != M * DM || out_size != M * DM || ws_size < WS_END) {
            fprintf(stderr, "kernel_launch: unexpected shapes: n_in %d in0 %d out %d ws %zu (need >= %zu); nothing launched\n", n_in, n_in > 0 ? in_sizes[0] : -1, out_size, ws_size, (size_t)WS_END);
            grid = -1; return; }
        int dev = 0, cus = 0, per_cu = 0;
        if (hipGetDevice(&dev) != hipSuccess || hipDeviceGetAttribute(&cus, hipDeviceAttributeMultiprocessorCount, dev) != hipSuccess) { grid = -1; return; }
        if (hipFuncSetAttribute((const void*)mega_fwd, hipFuncAttributeMaxDynamicSharedMemorySize, LDS_BYTES) != hipSuccess) { fprintf(stderr, "kernel_launch: hipFuncSetAttribute failed\n"); grid = -1; return; }
        if (hipOccupancyMaxActiveBlocksPerMultiprocessor(&per_cu, (const void*)mega_fwd, NWAVES * 64, LDS_BYTES) != hipSuccess || per_cu < 1) {
            fprintf(stderr, "kernel_launch: occupancy query says %d blocks per CU\n", per_cu); per_cu = 1; }
        (void)hipGetLastError();
        grid = cus;
    }
    if (grid < 0) return;
    Args a{};
    for (int i = 0; i < 21; ++i) a.in[i] = (const float*)d_in[i];
    a.out = (float*)d_out; a.ws = (unsigned char*)d_ws;
#if MK_PER_PHASE
    for (int p = 0; p < NPHASE; ++p) { a.ph_lo = p; a.ph_hi = p + 1; a.coop = 0; hipLaunchKernelGGL(mega_fwd, dim3(grid), dim3(NWAVES * 64), LDS_BYTES, stream, a); }
#else
    if (hipMemsetAsync((char*)d_ws + WS_CTL, 0, CTL_ZERO_BYTES, stream) != hipSuccess) { fprintf(stderr, "kernel_launch: memset failed\n"); return; }
    a.ph_lo = 0; a.ph_hi = NPHASE; a.coop = 1;
    void* kargs[] = {&a};
    const hipError_t e = hipLaunchCooperativeKernel((const void*)mega_fwd, dim3(grid), dim3(NWAVES * 64), kargs, LDS_BYTES, stream);
    if (e != hipSuccess) fprintf(stderr, "kernel_launch: cooperative launch failed: %s (grid %d)\n", hipGetErrorString(e), grid);
#endif
}
```

```cpp
#include <hip/hip_runtime.h>
#include <hip/hip_bf16.h>
#include <hip/hip_cooperative_groups.h>
#include <cstdio>
#include <cstdint>
namespace cg = cooperative_groups;
namespace pg8 {
#define PG8_LAS __attribute__((address_space(3)))
typedef unsigned short bf16_t;
typedef short bf16x8 __attribute__((ext_vector_type(8)));
typedef float f32x4 __attribute__((ext_vector_type(4)));
typedef unsigned u32x4 __attribute__((ext_vector_type(4)));
constexpr int BM = 256, BK = 64, HALF = 128, HTB = HALF * BK * 2  , STAGE_BYTES = 8 * HTB, NXCD = 8, WGM = 8;

__host__ __device__ __forceinline__ int lds_byte(int r, int c) { const int st = (r >> 4) * 2 + (c >> 5), rr = r & 15, cc = c & 31, ob = rr * 64 + cc * 2; return st * 1024 + (ob ^ (((ob >> 9) & 1) << 5)); }
__host__ __device__ __forceinline__ void stage_rc(int b, int& R, int& C) { const int st = b / 1024, sb = b % 1024, swz = sb ^ (((sb >> 9) & 1) << 5); R = (st >> 1) * 16 + swz / 64; C = (st & 1) * 32 + (swz % 64) / 2; }
__host__ __device__ __forceinline__ int perm32(int rho) { const int n = rho >> 4, i = rho & 15; return 8 * (i >> 2) + 4 * n + (i & 3); }

struct Unit { int pm, pn; };
struct Gemm { const bf16_t* A; const bf16_t* Bt; int M, N, K, lda; };

struct StaticOrder {
    int nM, nN, nwg, G, c;
    __host__ __device__ void init(int M, int N, int G_, int c_) { nM = M / BM; nN = N / BM; nwg = nM * nN; G = G_; c = c_; }
    __host__ __device__ bool next(int i, Unit& u) const {
        const long L = (long)i * G + c; if (L >= nwg) return false;
        int wgid = (int)L; { const int q = nwg / NXCD, r = nwg % NXCD, xcd = wgid % NXCD, off = wgid / NXCD; wgid = (xcd < r ? xcd * (q + 1) : r * (q + 1) + (xcd - r) * q) + off; }
        const int nig = WGM * nN, gid = wgid / nig, fm = gid * WGM, gsz = (nM - fm) < WGM ? (nM - fm) : WGM;
        u.pm = fm + ((wgid % nig) % gsz); u.pn = (wgid % nig) / gsz; return true;
    }
    __device__ __forceinline__ void a_ready(const Unit&) const {}
    __device__ __forceinline__ void done(const Unit&) const {}
};

__device__ __forceinline__ unsigned cvt_pk_bf16(float lo, float hi) { unsigned r; asm volatile("v_cvt_pk_bf16_f32 %0, %1, %2" : "=v"(r) : "v"(lo), "v"(hi)); return r; }
__device__ __forceinline__ float row_rs(const float* ss, int row, int fq) {
    const f32x4 a = *(const f32x4*)(ss + (size_t)row * 32 + fq * 8), b = *(const f32x4*)(ss + (size_t)row * 32 + fq * 8 + 4);
    float s = ((a[0] + a[1]) + (a[2] + a[3])) + ((b[0] + b[1]) + (b[2] + b[3]));
    s += __shfl_xor(s, 16); s += __shfl_xor(s, 32);
    return 1.0f / sqrtf(s * (1.0f / 2048.0f) + 1e-6f);
}
template <int MODE> struct EpiBf {
    static constexpr bool PERM = true, AFTER_DRAIN = false;
    bf16_t* O; int ldc; const float* ss;
    __device__ __forceinline__ void operator()(const f32x4 (&acc)[2][2][4][2], const Unit& u, int wr, int wc, int fr, int fq) const {
        const int row0 = u.pm * BM + wr * 64 + fr, col0 = u.pn * BM + wc * 32 + 8 * fq;
        float scv[2][4];
#pragma unroll
        for (int ai = 0; ai < 2; ++ai)
#pragma unroll
            for (int m = 0; m < 4; ++m) scv[ai][m] = (MODE != 0) ? row_rs(ss, row0 + ai * HALF + m * 16, fq) : 1.f;
#pragma unroll
        for (int ai = 0; ai < 2; ++ai)
#pragma unroll
            for (int m = 0; m < 4; ++m) { const int row = row0 + ai * HALF + m * 16; bf16_t* rowp = O + (size_t)row * ldc + col0;
                const float sc = scv[ai][m];
#pragma unroll
                for (int bj = 0; bj < 2; ++bj) { f32x4 v0 = acc[ai][bj][m][0] * sc, v1 = acc[ai][bj][m][1] * sc;
                    if (MODE == 2) {
#pragma unroll
                        for (int j = 0; j < 4; ++j) { const float a = fmaxf(v0[j], 0.f), b = fmaxf(v1[j], 0.f); v0[j] = a * a; v1[j] = b * b; } }
                    u32x4 w; w.x = cvt_pk_bf16(v0[0], v0[1]); w.y = cvt_pk_bf16(v0[2], v0[3]); w.z = cvt_pk_bf16(v1[0], v1[1]); w.w = cvt_pk_bf16(v1[2], v1[3]);
                    *(u32x4*)(rowp + bj * HALF) = w; } }
    }
};
struct EpiNull {
    static constexpr bool PERM = true, AFTER_DRAIN = false;
    bf16_t* O;
    __device__ __forceinline__ void operator()(const f32x4 (&acc)[2][2][4][2], const Unit& u, int wr, int wc, int fr, int fq) const {
        float s = 0.f;
#pragma unroll
        for (int ai = 0; ai < 2; ++ai)
#pragma unroll
            for (int bj = 0; bj < 2; ++bj)
#pragma unroll
                for (int m = 0; m < 4; ++m)
#pragma unroll
                    for (int n = 0; n < 2; ++n) s += (acc[ai][bj][m][n][0] + acc[ai][bj][m][n][1]) + (acc[ai][bj][m][n][2] + acc[ai][bj][m][n][3]);
        if (s == 1.2345e30f) O[u.pm + u.pn] = 1;
    }
};
struct EpiResid {
    static constexpr bool PERM = false, AFTER_DRAIN = false;
    const float* base; float* out; bf16_t* xb; float* ss;
    __device__ __forceinline__ void operator()(const f32x4 (&acc)[2][2][4][2], const Unit& u, int wr, int wc, int fr, int fq) const {
        typedef unsigned u32x2v __attribute__((ext_vector_type(2)));
        const int col0 = u.pn * BM + wc * 32 + 4 * fq;
#pragma unroll
        for (int ai = 0; ai < 2; ++ai) {
            f32x4 bs[4][2][2];
#pragma unroll
            for (int m = 0; m < 4; ++m) { const size_t off = (size_t)(u.pm * BM + ai * HALF + wr * 64 + m * 16 + fr) * 2048 + col0;
#pragma unroll
                for (int bj = 0; bj < 2; ++bj)
#pragma unroll
                    for (int n = 0; n < 2; ++n) bs[m][bj][n] = *(const f32x4*)(base + off + bj * HALF + n * 16); }
#pragma unroll
            for (int m = 0; m < 4; ++m) { const int row = u.pm * BM + ai * HALF + wr * 64 + m * 16 + fr; const size_t off = (size_t)row * 2048 + col0; float sq = 0.f;
#pragma unroll
                for (int bj = 0; bj < 2; ++bj)
#pragma unroll
                    for (int n = 0; n < 2; ++n) { const f32x4 x = bs[m][bj][n] + acc[ai][bj][m][n];
                        if (out) *(f32x4*)(out + off + bj * HALF + n * 16) = x; sq += (x[0] * x[0] + x[1] * x[1]) + (x[2] * x[2] + x[3] * x[3]);
                        if (xb) { u32x2v w; w.x = cvt_pk_bf16(x[0], x[1]); w.y = cvt_pk_bf16(x[2], x[3]); *(u32x2v*)(xb + off + bj * HALF + n * 16) = w; } }
                sq += __shfl_xor(sq, 16); sq += __shfl_xor(sq, 32);
                if (fq == 0) ss[(size_t)row * 32 + u.pn * 4 + wc] = sq; }
            asm volatile("" ::: "memory");
        }
    }
};

template <class Epi, class Sched, bool ALIGN_EPI = false, bool SP2 = false>
__device__ __forceinline__ void gemm_phase(PG8_LAS unsigned char* lds, const Gemm g, const Sched& S, const Epi& E) {
    const int tid = threadIdx.x, wid = __builtin_amdgcn_readfirstlane(tid >> 6), lane = tid & 63, wr = wid >> 2, wc = wid & 3, fr = lane & 15, fq = lane >> 4;
    const int K = g.K, nt = K / BK;
    unsigned voffA[2], voffB[2];
#pragma unroll
    for (int i = 0; i < 2; ++i) { int R, C; stage_rc(tid * 16 + i * 8192, R, C); const int Rb = Epi::PERM ? ((R & ~31) + perm32(R & 31)) : R;
        voffA[i] = (unsigned)(R * g.lda + C) * 2u; voffB[i] = (unsigned)(Rb * K + C) * 2u; }
    const size_t kstep = (size_t)(BK * 2);
    const size_t hstep = (size_t)HALF * K * 2;
    const size_t tstep = 2 * hstep; const size_t hstepA = (size_t)HALF * g.lda * 2, tstepA = 2 * hstepA;
    const unsigned ldsw = (unsigned)wid * 1024u;
    const int aoff = lds_byte(wr * 64 + fr, fq * 8), boff = lds_byte(wc * 32 + fr, fq * 8);
#define PG8_SA(b, h) (((b) * 2 + (h)) * HTB)
#define PG8_SB(b, h) ((4 + (b) * 2 + (h)) * HTB)
#define PG8_STAGE(bufoff, gbase, voff) do { _Pragma("unroll") for (int _i = 0; _i < 2; ++_i) \
        __builtin_amdgcn_global_load_lds((const unsigned*)((const char*)(gbase) + (voff)[_i]), (PG8_LAS unsigned*)(lds + (bufoff) + ldsw + _i * 8192), 16, 0, 0); } while (0)
#define PG8_LDA(dst, b, h) do { _Pragma("unroll") for (int m = 0; m < 4; ++m) _Pragma("unroll") for (int k = 0; k < 2; ++k) dst[m][k] = *(const PG8_LAS bf16x8*)(lds + PG8_SA(b, h) + aoff + m * 2048 + k * 1024); } while (0)
#define PG8_LDB(dst, b, h) do { _Pragma("unroll") for (int n = 0; n < 2; ++n) _Pragma("unroll") for (int k = 0; k < 2; ++k) dst[n][k] = *(const PG8_LAS bf16x8*)(lds + PG8_SB(b, h) + boff + n * 2048 + k * 1024); } while (0)
#define PG8_MMA(ai, bj, At, Bt) do { __builtin_amdgcn_s_setprio(1); _Pragma("unroll") for (int m = 0; m < 4; ++m) _Pragma("unroll") for (int n = 0; n < 2; ++n) _Pragma("unroll") for (int k = 0; k < 2; ++k) \
        acc[ai][bj][m][n] = __builtin_amdgcn_mfma_f32_16x16x32_bf16(Bt[n][k], At[m][k], acc[ai][bj][m][n], 0, 0, 0); __builtin_amdgcn_s_setprio(0); } while (0)
#define PG8_WAIT_V(n) asm volatile("s_waitcnt vmcnt(" #n ")" ::: "memory")
#define PG8_WAIT_L(n) asm volatile("s_waitcnt lgkmcnt(" #n ")" ::: "memory")
#define PG8_BAR __builtin_amdgcn_s_barrier()
#define PG8_SCHED __builtin_amdgcn_sched_barrier(0)
    Unit cur, nxt; int ui = 0;
    if (!S.next(0, cur)) return;
    f32x4 acc[2][2][4][2];
#pragma unroll
    for (int a = 0; a < 2; ++a)
#pragma unroll
        for (int b = 0; b < 2; ++b)
#pragma unroll
            for (int m = 0; m < 4; ++m)
#pragma unroll
                for (int n = 0; n < 2; ++n) acc[a][b][m][n] = (f32x4){0.f, 0.f, 0.f, 0.f};
    bf16x8 At[4][2], B0[2][2], B1[2][2];
    const char* cA = (const char*)g.A + (size_t)cur.pm * tstepA; const char* cB = (const char*)g.Bt + (size_t)cur.pn * tstep;
    S.a_ready(cur);
    if constexpr (SP2) {
        PG8_STAGE(PG8_SB(0, 0), cB, voffB); PG8_STAGE(PG8_SB(0, 1), cB + hstep, voffB); PG8_STAGE(PG8_SA(0, 0), cA, voffA); PG8_STAGE(PG8_SA(0, 1), cA + hstepA, voffA);
        if (wr == 1) PG8_BAR;
        PG8_WAIT_V(2); PG8_BAR;
        PG8_STAGE(PG8_SB(1, 0), cB + kstep, voffB); PG8_STAGE(PG8_SA(1, 0), cA + kstep, voffA); PG8_STAGE(PG8_SB(1, 1), cB + hstep + kstep, voffB);
        PG8_WAIT_V(6); PG8_BAR;
    } else {
        PG8_STAGE(PG8_SB(0, 0), cB, voffB); PG8_STAGE(PG8_SA(0, 0), cA, voffA); PG8_STAGE(PG8_SB(0, 1), cB + hstep, voffB); PG8_STAGE(PG8_SA(0, 1), cA + hstepA, voffA);
        if (wr == 1) PG8_BAR;
        PG8_WAIT_V(4); PG8_BAR;
        PG8_STAGE(PG8_SB(1, 0), cB + kstep, voffB); PG8_STAGE(PG8_SA(1, 0), cA + kstep, voffA); PG8_STAGE(PG8_SB(1, 1), cB + hstep + kstep, voffB);
        PG8_WAIT_V(6); PG8_BAR;
    }
    for (;;) {
        const bool has_next = S.next(ui + 1, nxt);
        const char* nA = has_next ? (const char*)g.A + (size_t)nxt.pm * tstepA : cA; const char* nB = has_next ? (const char*)g.Bt + (size_t)nxt.pn * tstep : cB;
        for (int t = 0; t < nt; t += 2) {
            const bool last = (t == nt - 2);
            const char* a1 = cA + (size_t)(t + 1) * kstep;
            const char* a2 = last ? nA : cA + (size_t)(t + 2) * kstep; const char* b2 = last ? nB : cB + (size_t)(t + 2) * kstep;
            const char* a3 = a2 + kstep; const char* b3 = b2 + kstep;
            if (last && has_next) S.a_ready(nxt);
            if constexpr (SP2) {
            PG8_LDB(B0, 0, 0); PG8_LDB(B1, 0, 1); PG8_SCHED; PG8_LDA(At, 0, 0); PG8_STAGE(PG8_SA(1, 1), a1 + hstepA, voffA);
            PG8_WAIT_V(8); PG8_WAIT_L(0); PG8_BAR; PG8_MMA(0, 0, At, B0); PG8_MMA(0, 1, At, B1); PG8_BAR; PG8_SCHED;
            PG8_LDA(At, 0, 1); PG8_STAGE(PG8_SB(0, 0), b2, voffB); PG8_STAGE(PG8_SB(0, 1), b2 + hstep, voffB); PG8_STAGE(PG8_SA(0, 0), a2, voffA);
            PG8_WAIT_V(8); PG8_WAIT_L(0); PG8_BAR; PG8_MMA(1, 0, At, B0); PG8_MMA(1, 1, At, B1); PG8_BAR; PG8_SCHED;
            PG8_LDB(B0, 1, 0); PG8_LDB(B1, 1, 1); PG8_SCHED; PG8_LDA(At, 1, 0); PG8_STAGE(PG8_SA(0, 1), a2 + hstepA, voffA);
            PG8_WAIT_V(8); PG8_WAIT_L(0); PG8_BAR; PG8_MMA(0, 0, At, B0); PG8_MMA(0, 1, At, B1); PG8_BAR; PG8_SCHED;
            PG8_LDA(At, 1, 1); PG8_STAGE(PG8_SB(1, 0), b3, voffB); PG8_STAGE(PG8_SB(1, 1), b3 + hstep, voffB); PG8_STAGE(PG8_SA(1, 0), a3, voffA);
            PG8_WAIT_V(8); PG8_WAIT_L(0); PG8_BAR; PG8_MMA(1, 0, At, B0); PG8_MMA(1, 1, At, B1); PG8_BAR; PG8_SCHED;
            } else {
            PG8_LDB(B0, 0, 0); PG8_SCHED; PG8_LDA(At, 0, 0); PG8_STAGE(PG8_SA(1, 1), a1 + hstepA, voffA);
            PG8_WAIT_L(8); PG8_BAR; PG8_WAIT_L(0); PG8_MMA(0, 0, At, B0); PG8_BAR; PG8_SCHED;
            PG8_LDB(B1, 0, 1); PG8_STAGE(PG8_SB(0, 0), b2, voffB);
            PG8_BAR; PG8_WAIT_L(0); PG8_MMA(0, 1, At, B1); PG8_BAR;
            PG8_LDA(At, 0, 1); PG8_STAGE(PG8_SA(0, 0), a2, voffA);
            PG8_BAR; PG8_WAIT_L(0); PG8_MMA(1, 0, At, B0); PG8_BAR; PG8_SCHED;
            PG8_STAGE(PG8_SB(0, 1), b2 + hstep, voffB);
            PG8_WAIT_V(6); PG8_BAR; PG8_MMA(1, 1, At, B1); PG8_BAR;
            PG8_LDB(B0, 1, 0); PG8_SCHED; PG8_LDA(At, 1, 0); PG8_STAGE(PG8_SA(0, 1), a2 + hstepA, voffA);
            PG8_WAIT_L(8); PG8_BAR; PG8_WAIT_L(0); PG8_MMA(0, 0, At, B0); PG8_BAR; PG8_SCHED;
            PG8_LDB(B1, 1, 1); PG8_STAGE(PG8_SB(1, 0), b3, voffB);
            PG8_BAR; PG8_WAIT_L(0); PG8_MMA(0, 1, At, B1); PG8_BAR;
            PG8_LDA(At, 1, 1); PG8_STAGE(PG8_SA(1, 0), a3, voffA);
            PG8_BAR; PG8_WAIT_L(0); PG8_MMA(1, 0, At, B0); PG8_BAR; PG8_SCHED;
            PG8_STAGE(PG8_SB(1, 1), b3 + hstep, voffB);
            PG8_WAIT_V(6); PG8_BAR; PG8_MMA(1, 1, At, B1); PG8_BAR;
            }
        }
        if constexpr (ALIGN_EPI) { if (wr == 0) PG8_BAR; }
        if constexpr (!Epi::AFTER_DRAIN) { E(acc, cur, wr, wc, fr, fq); S.done(cur); }
        if (!has_next) break;
#pragma unroll
        for (int a = 0; a < 2; ++a)
#pragma unroll
            for (int b = 0; b < 2; ++b)
#pragma unroll
                for (int m = 0; m < 4; ++m)
#pragma unroll
                    for (int n = 0; n < 2; ++n) acc[a][b][m][n] = (f32x4){0.f, 0.f, 0.f, 0.f};
        cur = nxt; cA = nA; cB = nB; ++ui;
        if constexpr (ALIGN_EPI) { if (wr == 1) PG8_BAR; }
    }
    PG8_WAIT_V(0);
    if constexpr (!ALIGN_EPI) { if (wr == 0) PG8_BAR; }
    PG8_BAR;
    if constexpr (Epi::AFTER_DRAIN) { E.fused(acc, cur, wr, wc, fr, fq, lds, wid, lane); S.done(cur); }
#undef PG8_SA
#undef PG8_SB
#undef PG8_STAGE
#undef PG8_LDA
#undef PG8_LDB
#undef PG8_MMA
#undef PG8_WAIT_V
#undef PG8_WAIT_L
#undef PG8_BAR
#undef PG8_SCHED
}
}
namespace att {
using bf16 = __hip_bfloat16;
constexpr int   D = 128, NW = 8, QBLK = 32, KVBLK = 64;
constexpr float SCALE = 0.088388347648318440f;
constexpr float THR = 8.f;
constexpr int SDEPTH = 2;
constexpr size_t SHM_V = KVBLK * D * 2, SHM_K = KVBLK * D * 2, SHM_ATTN = 2 * SHM_V + 2 * SHM_K + NW * 64 * 4;
using bf16x8 = __attribute__((ext_vector_type(8))) short;
using s16x4  = __attribute__((ext_vector_type(4))) short;
using f32x16 = __attribute__((ext_vector_type(16))) float;
using f32x8  = __attribute__((ext_vector_type(8))) float;
using u32x4  = __attribute__((ext_vector_type(4))) unsigned;
#define KSWZ(row, colB) ((row) * 256 + ((colB) ^ (((row) & 7) << 4)))
#define SBAR() __builtin_amdgcn_sched_barrier(0)
__device__ __forceinline__ int crow(int r, int hi) { return (r & 3) + 8 * (r >> 2) + 4 * hi; }
__device__ __forceinline__ unsigned cvtpk(float lo, float hi) {
  unsigned r; asm volatile("v_cvt_pk_bf16_f32 %0, %1, %2" : "=v"(r) : "v"(lo), "v"(hi)); return r;
}
struct StageB { using T = bf16x8;
  __device__ static __forceinline__ T ld8(const bf16* p) { return *reinterpret_cast<const bf16x8*>(p); }
  __device__ static __forceinline__ bf16x8 tobf(T x) { return x; } };

__device__ __forceinline__ void partialSM(f32x16& p0, f32x16& p1, float& m_reg, float& mn, float& alpha) {
  constexpr float C = SCALE * 1.4426950408889634f;
  float pmax = p0[0]; for (int r = 1; r < 16; ++r) pmax = fmaxf(pmax, p0[r]); for (int r = 0; r < 16; ++r) pmax = fmaxf(pmax, p1[r]);
  { auto rr = __builtin_amdgcn_permlane32_swap(__float_as_uint(pmax), __float_as_uint(pmax), false, false);
    pmax = fmaxf(__uint_as_float(rr[0]), __uint_as_float(rr[1])); }
  if (__builtin_expect(__all(pmax - m_reg <= THR / SCALE), 1)) { mn = m_reg; alpha = 1.f; }
  else { mn = fmaxf(m_reg, pmax); alpha = __builtin_amdgcn_exp2f((m_reg - mn) * C); m_reg = mn; }
  float mnC = -mn * C;
  for (int r = 0; r < 16; ++r) p0[r] = fmaf(p0[r], C, mnC); for (int r = 0; r < 16; ++r) p1[r] = fmaf(p1[r], C, mnC);
  for (int r = 0; r < 16; ++r) p0[r] = __builtin_amdgcn_exp2f(p0[r]);
}
__device__ __forceinline__ void finishSM(f32x16& p0, f32x16& p1, float alpha, float& l_reg, bf16x8& pa0, bf16x8& pa1, bf16x8& pa2, bf16x8& pa3) {
  for (int r = 0; r < 16; ++r) p1[r] = __builtin_amdgcn_exp2f(p1[r]);
  float ps = 0; for (int r = 0; r < 16; ++r) ps += p0[r]; for (int r = 0; r < 16; ++r) ps += p1[r];
  { auto rr = __builtin_amdgcn_permlane32_swap(__float_as_uint(ps), __float_as_uint(ps), false, false);
    ps = __uint_as_float(rr[0]) + __uint_as_float(rr[1]); }
  l_reg = l_reg * alpha + ps;
#define PK4(P, BASE, OUT) do { unsigned a0 = cvtpk(P[BASE + 0], P[BASE + 1]), a1 = cvtpk(P[BASE + 2], P[BASE + 3]);   \
    unsigned b0 = cvtpk(P[BASE + 4], P[BASE + 5]), b1 = cvtpk(P[BASE + 6], P[BASE + 7]);                              \
    auto r0 = __builtin_amdgcn_permlane32_swap(a0, b0, false, false); auto r1 = __builtin_amdgcn_permlane32_swap(a1, b1, false, false); \
    u32x4 w = {r0[0], r1[0], r0[1], r1[1]}; OUT = *reinterpret_cast<bf16x8*>(&w); } while (0)
  PK4(p0, 0, pa0); PK4(p0, 8, pa1); PK4(p1, 0, pa2); PK4(p1, 8, pa3);
#undef PK4
}
__device__ __forceinline__ void qkt(f32x16& p0, f32x16& p1, const bf16* Ks, const bf16x8* qr, int r32, int hi) {
  p0 = f32x16{}; p1 = f32x16{};
  for (int d0 = 0; d0 < 8; ++d0) { int cb = (d0 * 16 + hi * 8) * 2;
    bf16x8 b0 = *reinterpret_cast<const bf16x8*>((const char*)Ks + KSWZ(r32, cb));
    bf16x8 b1 = *reinterpret_cast<const bf16x8*>((const char*)Ks + KSWZ(32 + r32, cb));
    p0 = __builtin_amdgcn_mfma_f32_32x32x16_bf16(b0, qr[d0], p0, 0, 0, 0);
    p1 = __builtin_amdgcn_mfma_f32_32x32x16_bf16(b1, qr[d0], p1, 0, 0, 0); }
}
__device__ __forceinline__ int v_st(int k, int c) { const int kk = (k & ~0xC) | ((k & 4) << 1) | ((k & 8) >> 1); return ((kk >> 3) * 4 + (c >> 5)) * 512 + ((kk & 7) * 32 + (c & 31)) * 2; }
__device__ __forceinline__ int v_rd_base(int lane) { return ((lane & 3) << 3) | (((lane >> 2) & 3) << 6) | (((lane >> 4) & 1) << 5) | (((lane >> 5) & 1) << 8); }
constexpr int v_rd_off(int d0, int ks, int half) { return d0 * 512 + ks * 4096 + half * 2048; }
template <int OFF> __device__ __forceinline__ s16x4 tr_read(int vb) {
  s16x4 r; asm volatile("ds_read_b64_tr_b16 %0, %1 offset:%2" : "=&v"(r) : "v"(vb), "i"(OFF) : "memory"); return r;
}
template <int D0> __device__ __forceinline__ void pv_one(f32x16& od, int vb, bf16x8 pa0, bf16x8 pa1, bf16x8 pa2, bf16x8 pa3) {
  const s16x4 l0 = tr_read<v_rd_off(D0, 0, 0)>(vb), h0 = tr_read<v_rd_off(D0, 0, 1)>(vb), l1 = tr_read<v_rd_off(D0, 1, 0)>(vb), h1 = tr_read<v_rd_off(D0, 1, 1)>(vb);
  const s16x4 l2 = tr_read<v_rd_off(D0, 2, 0)>(vb), h2 = tr_read<v_rd_off(D0, 2, 1)>(vb), l3 = tr_read<v_rd_off(D0, 3, 0)>(vb), h3 = tr_read<v_rd_off(D0, 3, 1)>(vb);
  asm volatile("s_waitcnt lgkmcnt(0)" ::: "memory"); SBAR();
#define PK(L, H) (bf16x8){L[0], L[1], L[2], L[3], H[0], H[1], H[2], H[3]}
  od = __builtin_amdgcn_mfma_f32_32x32x16_bf16(pa0, PK(l0, h0), od, 0, 0, 0);
  od = __builtin_amdgcn_mfma_f32_32x32x16_bf16(pa1, PK(l1, h1), od, 0, 0, 0);
  od = __builtin_amdgcn_mfma_f32_32x32x16_bf16(pa2, PK(l2, h2), od, 0, 0, 0);
  od = __builtin_amdgcn_mfma_f32_32x32x16_bf16(pa3, PK(l3, h3), od, 0, 0, 0);
#undef PK
}
__device__ __forceinline__ void pv_d0(f32x16* o, int vb, bf16x8 pa0, bf16x8 pa1, bf16x8 pa2, bf16x8 pa3) {
  pv_one<0>(o[0], vb, pa0, pa1, pa2, pa3); pv_one<1>(o[1], vb, pa0, pa1, pa2, pa3); pv_one<2>(o[2], vb, pa0, pa1, pa2, pa3); pv_one<3>(o[3], vb, pa0, pa1, pa2, pa3);
}

template <int LDQ, int LDK, int LDO, int VOFF>
__device__ __forceinline__ void attn_dense_body(const bf16* Qb, const bf16* __restrict__ Kh,
                                                bf16* Ob, int seq, char* lds) {
  using St = StageB; using SQ = StageB;
  const int tid = threadIdx.x, wid = tid >> 6, lane = tid & 63, r32 = lane & 31, hi = lane >> 5;
  bf16* V_lds = (bf16*)lds; bf16* K_lds = (bf16*)(lds + 2 * SHM_V);
  float* ws = (float*)(lds + 2 * SHM_V + 2 * SHM_K) + wid * 64; float* li_l = ws; float* al_l = ws + 32;
  float m_reg = -1e30f, l_reg = 0; f32x16 o[4] = {}; bf16x8 qr[8];
  const bf16* Qw = Qb + (long)(wid * QBLK + r32) * LDQ + hi * 8;
#pragma unroll
  for (int d0 = 0; d0 < 8; ++d0) qr[d0] = SQ::tobf(SQ::ld8(Qw + d0 * 16));
  const int sr = tid >> 4, sc = (tid & 15) * 8, vst0 = v_st(sr, sc), vst1 = v_st(32 + sr, sc);
  const int vb0 = (int)(uintptr_t)V_lds + v_rd_base(lane);
  struct { typename St::T vs0, vs1, ks0, ks1; } sr_[SDEPTH];
  const unsigned kvo0 = (unsigned)(sr * LDK + sc) * 2u, kvo1 = kvo0 + 32u * LDK * 2u;
#define SLOAD(i, k0) do { const char* kb_ = (const char*)Kh + (size_t)(k0) * (LDK * 2); \
    sr_[i].vs0 = *(const bf16x8*)(kb_ + kvo0 + VOFF * 2); sr_[i].vs1 = *(const bf16x8*)(kb_ + kvo1 + VOFF * 2); \
    sr_[i].ks0 = *(const bf16x8*)(kb_ + kvo0); sr_[i].ks1 = *(const bf16x8*)(kb_ + kvo1); } while (0)
#define SWRITE(b, i) do { *(bf16x8*)((char*)V_lds + (b) * SHM_V + vst0) = St::tobf(sr_[i].vs0);          \
    *(bf16x8*)((char*)V_lds + (b) * SHM_V + vst1) = St::tobf(sr_[i].vs1); int kc = sc * 2;               \
    *(bf16x8*)((char*)K_lds + (b) * SHM_K + KSWZ(sr, kc)) = St::tobf(sr_[i].ks0);                       \
    *(bf16x8*)((char*)K_lds + (b) * SHM_K + KSWZ(32 + sr, kc)) = St::tobf(sr_[i].ks1); } while (0)
#define SWAIT() do { if constexpr (SDEPTH == 2) asm volatile("s_waitcnt vmcnt(4)" ::: "memory"); else asm volatile("s_waitcnt vmcnt(0)" ::: "memory"); } while (0)
#define RESC(a) do { if (__any((a) < 1.f)) { if (hi == 0) al_l[r32] = (a); asm volatile("s_waitcnt lgkmcnt(0)" ::: "memory"); \
    for (int d = 0; d < 4; ++d) for (int r = 0; r < 16; ++r) o[d][r] *= al_l[crow(r, hi)]; } } while (0)
  f32x16 pA0, pA1, pB0, pB1; float mnA, mnB, alA, alB; bf16x8 pa0, pa1, pa2, pa3; const int NT = seq / KVBLK;
  constexpr int SE = 0, SO = SDEPTH - 1;
  SLOAD(SE, 0); asm volatile("s_waitcnt vmcnt(0)" ::: "memory"); SWRITE(0, SE); __syncthreads();
  qkt(pA0, pA1, K_lds, qr, r32, hi); partialSM(pA0, pA1, m_reg, mnA, alA);
  SLOAD(SO, KVBLK); if constexpr (SDEPTH == 2) { if (2 < NT) SLOAD(SE, 2 * KVBLK); }
  SWAIT(); SWRITE(1, SO); __syncthreads();
  for (int j = 1; j + 1 < NT; j += 2) {
    SBAR(); qkt(pB0, pB1, (bf16*)((char*)K_lds + SHM_K), qr, r32, hi);
    finishSM(pA0, pA1, alA, l_reg, pa0, pa1, pa2, pa3); SBAR();
    SLOAD(SO, (j + SDEPTH) * KVBLK); SBAR();
    pv_d0(o, vb0, pa0, pa1, pa2, pa3); partialSM(pB0, pB1, m_reg, mnB, alB);
    __syncthreads(); SWAIT(); SWRITE(0, SE);
    RESC(alB); __syncthreads();
    SBAR(); qkt(pA0, pA1, K_lds, qr, r32, hi);
    finishSM(pB0, pB1, alB, l_reg, pa0, pa1, pa2, pa3); SBAR();
    if (SDEPTH == 1 || j + 3 < NT) SLOAD(SE, (j + 1 + SDEPTH) * KVBLK); SBAR();
    pv_d0(o, vb0 + (int)SHM_V, pa0, pa1, pa2, pa3); partialSM(pA0, pA1, m_reg, mnA, alA);
    __syncthreads(); SWAIT(); SWRITE(1, SO);
    RESC(alA); __syncthreads();
  }
  SBAR(); qkt(pB0, pB1, (bf16*)((char*)K_lds + SHM_K), qr, r32, hi);
  finishSM(pA0, pA1, alA, l_reg, pa0, pa1, pa2, pa3); SBAR();
  pv_d0(o, vb0, pa0, pa1, pa2, pa3); partialSM(pB0, pB1, m_reg, mnB, alB);
  __syncthreads(); RESC(alB);
  finishSM(pB0, pB1, alB, l_reg, pa0, pa1, pa2, pa3); SBAR();
  pv_d0(o, vb0 + (int)SHM_V, pa0, pa1, pa2, pa3);
  if (hi == 0) li_l[r32] = l_reg; asm volatile("s_waitcnt lgkmcnt(0)" ::: "memory");
  float rli[16];
#pragma unroll
  for (int r = 0; r < 16; ++r) rli[r] = __builtin_amdgcn_rcpf(li_l[crow(r, hi)]);
  unsigned short* Ow = (unsigned short*)Ob + (long)(wid * QBLK) * LDO;
  int hi_o = hi, r32_o = r32; asm volatile("" : "+v"(hi_o), "+v"(r32_o));
  const unsigned lane_off = (unsigned)(4 * hi_o * LDO + r32_o);
#pragma unroll
  for (int r = 0; r < 16; ++r) {
#pragma unroll
    for (int d0 = 0; d0 < 4; ++d0) Ow[lane_off + (unsigned)(((r & 3) + 8 * (r >> 2)) * LDO + d0 * 32)] = (unsigned short)(cvtpk(o[d0][r] * rli[r], 0.f) & 0xffffu); }
#undef SLOAD
#undef SWRITE
#undef SWAIT
#undef RESC
}

}
constexpr int BATCH = 2, SEQ = 8192, DM = 2048, M = BATCH * SEQ, INW = 5632, DFF = 8192, CWID = 512, MEMT = 256, MROWS = BATCH * MEMT;
constexpr int C_RQ = 0, C_RK = 1024, C_RV = 2048, C_RG = 3072, C_AQ = 4096, C_AK = 5120, C_AV = 5376;
constexpr int NCH = 64;
constexpr float EPS = 1e-6f;
constexpr int NWAVES = 8;
constexpr size_t MiB = 1u << 20;
constexpr size_t WS_ROPE = 0;
constexpr size_t WS_CTL = 512 * 1024, CTL_ZERO_BYTES = 16384;
constexpr size_t WS_SS1 = 1 * MiB, WS_SS2 = 3 * MiB, WS_SS3 = 5 * MiB;
constexpr size_t WS_KVC = 7 * MiB;
constexpr size_t WS_WIN = 8 * MiB, WS_WOUT = 30 * MiB, WS_WQ = 38 * MiB, WS_WKV = 40 * MiB, WS_WO = 44 * MiB, WS_WUP = 46 * MiB, WS_WDN = 78 * MiB;
constexpr size_t WS_XN = 110 * MiB;
constexpr size_t WS_MN = 174 * MiB;
constexpr size_t WS_PROJ = 176 * MiB;
constexpr size_t WS_VT = 352 * MiB;
constexpr size_t WS_ST = 384 * MiB;
constexpr size_t WS_QC = 448 * MiB;
constexpr size_t WS_U = 176 * MiB;
constexpr size_t WS_END = 464 * MiB;
static_assert(WS_U + (size_t)M * DFF * 2 <= WS_QC, "U overlay");
constexpr int LDS_BYTES = 147456;
constexpr int LDT = 136, TILE_B = 128 * LDT * 2;
constexpr int RED_OFF = 4 * TILE_B;
constexpr int MISC_OFF = LDS_BYTES - 64;
static_assert(MISC_OFF + 16 <= LDS_BYTES && RED_OFF + 4096 <= MISC_OFF && 7 * 18432 + 64 * 65 * 4 <= MISC_OFF, "LDS map");

#define LAS __attribute__((address_space(3)))
typedef unsigned short bf16;
typedef unsigned v4u __attribute__((ext_vector_type(4)));
typedef unsigned v2u __attribute__((ext_vector_type(2)));
typedef float f32x4 __attribute__((ext_vector_type(4)));
typedef float f32x2 __attribute__((ext_vector_type(2)));
typedef short bf16x8 __attribute__((ext_vector_type(8)));
#define LDS_WAIT() asm volatile("s_waitcnt lgkmcnt(0)" ::: "memory")
__device__ __forceinline__ unsigned f2bf(float f) { unsigned u = __builtin_bit_cast(unsigned, f); return (u + 0x7fffu + ((u >> 16) & 1u)) >> 16; }
__device__ __forceinline__ unsigned pk2(float lo, float hi) { return f2bf(lo) | (f2bf(hi) << 16); }
__device__ __forceinline__ float bflo(unsigned w) { return __uint_as_float(w << 16); }
__device__ __forceinline__ float bfhi(unsigned w) { return __uint_as_float(w & 0xffff0000u); }
__device__ __forceinline__ float bf1(unsigned short h) { return __uint_as_float((unsigned)h << 16); }
__device__ __forceinline__ float wave_sum(float v) {
#pragma unroll
    for (int o = 1; o < 64; o <<= 1) v += __shfl_xor(v, o);
    return v;
}

#define XB_TMO      128
#define XB_XCNT(j)  (256  + 64 * (j))
#define XB_XSUB(j)  (1280 + 64 * (j))
#define XB_XGEN(j)  (2304 + 64 * (j))
#define XB_TOP      3328
#define XB_TOPGEN   3392
#define XCD_BAR_WORDS 3456
#define XB_SPIN_CAP (1u << 18)

__device__ __forceinline__ unsigned xb_ld(unsigned* p)              { return __hip_atomic_load(p, __ATOMIC_RELAXED, __HIP_MEMORY_SCOPE_AGENT); }
__device__ __forceinline__ unsigned xb_add(unsigned* p, unsigned v) { return __hip_atomic_fetch_add(p, v, __ATOMIC_RELAXED, __HIP_MEMORY_SCOPE_AGENT); }
__device__ __forceinline__ unsigned xb_xcc_id() { return (unsigned)__builtin_amdgcn_s_getreg((3 << 11) | 20) & 0xFu; }
#define XB_SPIN(cond, bar) do { unsigned _sp = 0; while (cond) { __builtin_amdgcn_s_sleep(1); \
    if ((++_sp & 255u) == 0u) { if (xb_ld(&(bar)[XB_TMO])) break; if (_sp > XB_SPIN_CAP) { atomicAdd(&(bar)[XB_TMO], 1u); break; } } } } while (0)

struct XcdBarrier {
    unsigned* bar; unsigned x;
    volatile LAS unsigned* st;
};

__device__ __forceinline__ XcdBarrier xcd_barrier_post(unsigned* bar, volatile LAS unsigned* st) {
    XcdBarrier b; b.bar = bar; b.x = xb_xcc_id(); b.st = st;
    if (threadIdx.x == 0) (void)xb_add(&bar[XB_XCNT(b.x)], 1u);
    return b;
}
__device__ __forceinline__ void xcd_barrier_complete(unsigned* bar, unsigned x, unsigned& nloc, unsigned& nx) {
    const unsigned G = gridDim.x * gridDim.y * gridDim.z;
    unsigned sum, cnt, mine, sp = 0u;
    for (;;) {
        sum = 0u; cnt = 0u; mine = 0u;
#pragma unroll
        for (unsigned j = 0; j < 16; ++j) { const unsigned c = xb_ld(&bar[XB_XCNT(j)]); sum += c; cnt += (c > 0u) ? 1u : 0u; mine = (j == x) ? c : mine; }
        if (sum == G) break;
        __builtin_amdgcn_s_sleep(1);
        if ((++sp & 255u) == 0u) { if (xb_ld(&bar[XB_TMO])) break; if (sp > XB_SPIN_CAP) { atomicAdd(&bar[XB_TMO], 1u); break; } }
    }
    nloc = mine > 0u ? mine : 1u; nx = cnt > 0u ? cnt : 1u;
}

__device__ __forceinline__ void xcd_barrier(const XcdBarrier& b) {
    asm volatile("s_waitcnt vmcnt(0)" ::: "memory");
    __syncthreads();
    if (threadIdx.x == 0) {
        unsigned* bar = b.bar;
        __builtin_amdgcn_s_waitcnt(0);
        unsigned nloc = b.st[0], nx = b.st[1];
        if (nloc == 0u) { xcd_barrier_complete(bar, b.x, nloc, nx); b.st[0] = nloc; b.st[1] = nx; }
        const unsigned old = xb_add(&bar[XB_XSUB(b.x)], 1u);
        const unsigned gen = old / nloc;
        if (old + 1u == (gen + 1u) * nloc) {
            __builtin_amdgcn_fence(__ATOMIC_RELEASE, "agent");
            asm volatile("s_waitcnt vmcnt(0)" ::: "memory");
            const unsigned og = xb_add(&bar[XB_TOP], 1u);
            const unsigned tg = og / nx;
            if (og + 1u == (tg + 1u) * nx) xb_add(&bar[XB_TOPGEN], 1u);
            else XB_SPIN(xb_ld(&bar[XB_TOPGEN]) == tg, bar);
            __builtin_amdgcn_fence(__ATOMIC_ACQUIRE, "agent");
            xb_add(&bar[XB_XGEN(b.x)], 1u);
            asm volatile("s_waitcnt vmcnt(0)" ::: "memory");
        } else {
            XB_SPIN(xb_ld(&bar[XB_XGEN(b.x)]) == gen, bar);
            __builtin_amdgcn_fence(__ATOMIC_ACQUIRE, "agent");
            asm volatile("s_waitcnt vmcnt(0)" ::: "memory");
        }
    }
    __syncthreads();
}

struct Args { const float* in[21]; float* out; unsigned char* ws; int ph_lo, ph_hi, coop, pad; };

struct Frame {
    LAS unsigned char* lds; char* ldsg;
    int tid, lane, wave, vcu, G;
};

__device__ __forceinline__ void p0_transpose_item(const float* W, int K, int N, bf16* WT, int row_off, const float* gain, LAS float* scr, int item, int lane) {
    const int nblk = N / 64, kb = item / nblk, nb = item - kb * nblk, k0 = 64 * kb, n0 = 64 * nb;
    const int r4 = lane >> 4, c4 = (lane & 15) * 4;
    f32x4 v[16];
#pragma unroll
    for (int i = 0; i < 16; ++i) v[i] = *(const f32x4*)(W + (size_t)(k0 + 4 * i + r4) * N + n0 + c4);
    if (gain) {
#pragma unroll
        for (int i = 0; i < 16; ++i) v[i] = v[i] * gain[k0 + 4 * i + r4]; }
#pragma unroll
    for (int i = 0; i < 16; ++i) { LAS float* d = scr + (4 * i + r4) * 65 + c4; d[0] = v[i][0]; d[1] = v[i][1]; d[2] = v[i][2]; d[3] = v[i][3]; }
    LDS_WAIT(); asm volatile("" ::: "memory");
    const int c = lane & 7, nl = lane >> 3;
#pragma unroll
    for (int j = 0; j < 8; ++j) { const int n = nl + 8 * j; const LAS float* s = scr + (8 * c) * 65 + n;
        v4u o; o.x = pk2(s[0 * 65], s[1 * 65]); o.y = pk2(s[2 * 65], s[3 * 65]); o.z = pk2(s[4 * 65], s[5 * 65]); o.w = pk2(s[6 * 65], s[7 * 65]);
        *(v4u*)(WT + (size_t)(row_off + n0 + n) * K + k0 + 8 * c) = o; }
    LDS_WAIT(); asm volatile("" ::: "memory");
}
__device__ __forceinline__ void rms_row_to_bf16(const float* xrow, const float* w, bf16* orow, int lane) {
    const f32x4* xr = (const f32x4*)xrow + lane; const f32x4* wr = (const f32x4*)w + lane;
    f32x4 v[8]; float s = 0.f;
#pragma unroll
    for (int j = 0; j < 8; ++j) { v[j] = xr[64 * j]; s += (v[j].x * v[j].x + v[j].y * v[j].y) + (v[j].z * v[j].z + v[j].w * v[j].w); }
    const float rs = 1.0f / sqrtf(wave_sum(s) * (1.0f / 2048.0f) + EPS);
    v2u* o8 = (v2u*)orow + lane;
#pragma unroll
    for (int j = 0; j < 8; ++j) { const f32x4 g = wr[64 * j]; v2u o; o.x = pk2(v[j].x * rs * g.x, v[j].y * rs * g.y); o.y = pk2(v[j].z * rs * g.z, v[j].w * rs * g.w); o8[64 * j] = o; }
}

__device__ __forceinline__ void lds_mma128(f32x4 (&acc)[4][2], const LAS unsigned char* A, const LAS unsigned char* Bt, int wr, int wc, int fr, int fq) {
#pragma unroll
    for (int k0 = 0; k0 < 4; ++k0) {
        bf16x8 a[4], b[2];
#pragma unroll
        for (int m = 0; m < 4; ++m) a[m] = *(const LAS bf16x8*)(A + ((wr * 64 + m * 16 + fr) * LDT + k0 * 32 + fq * 8) * 2);
#pragma unroll
        for (int n = 0; n < 2; ++n) b[n] = *(const LAS bf16x8*)(Bt + ((wc * 32 + n * 16 + fr) * LDT + k0 * 32 + fq * 8) * 2);
#pragma unroll
        for (int m = 0; m < 4; ++m)
#pragma unroll
            for (int n = 0; n < 2; ++n) acc[m][n] = __builtin_amdgcn_mfma_f32_16x16x32_bf16(b[n], a[m], acc[m][n], 0, 0, 0);
    }
}
__device__ __forceinline__ void zero_acc(f32x4 (&acc)[4][2]) {
#pragma unroll
    for (int m = 0; m < 4; ++m)
#pragma unroll
        for (int n = 0; n < 2; ++n) acc[m][n] = (f32x4){0.f, 0.f, 0.f, 0.f};
}
__device__ __forceinline__ void tile_g2l(const bf16* g, size_t ld, LAS unsigned char* dst, int tid) {
    const int row = tid >> 2, seg = (tid & 3) * 32; const v4u* p = (const v4u*)(g + (size_t)row * ld + seg);
    v4u a = p[0], b = p[1], c = p[2], d = p[3];
    LAS v4u* q = (LAS v4u*)(dst + (row * LDT + seg) * 2);
    q[0] = a; q[1] = b; q[2] = c; q[3] = d;
}

__device__ __forceinline__ void ret_prep_task(const Frame& F, int task, bf16* PROJ, const f32x2* ROPE, bf16* VT, float* L, float lgf, float lgb, bool wb = true) {
    int tid = F.tid; asm volatile("" : "+v"(tid));
    const int b = task >> 9, h = (task >> 6) & 7, c = task & 63;
    const int r = tid >> 2, q = tid & 3, half = q >> 1, sub = q & 1;
    const int t = c * 128 + r, pos = half ? (t & 63) : (t >> 6);
    const f32x4* rp = (const f32x4*)(ROPE + pos * 32 + sub * 16);
    const int d1 = half * 64 + sub * 16, d2 = d1 + 32;
    const size_t tok = (size_t)b * SEQ + t;
    LAS unsigned char* B0 = F.lds; LAS unsigned char* B1 = F.lds + TILE_B; LAS unsigned char* B2 = F.lds + 2 * TILE_B;
    f32x4 cs[8];
#pragma unroll
    for (int i = 0; i < 8; ++i) cs[i] = rp[i];
    {
        bf16* row = PROJ + tok * INW + C_RQ + h * 128;
        v4u a0 = *(const v4u*)(row + d1), a1 = *(const v4u*)(row + d1 + 8), b0 = *(const v4u*)(row + d2), b1 = *(const v4u*)(row + d2 + 8);
        v4u o1[2], o2[2];
#pragma unroll
        for (int i = 0; i < 8; ++i) {
            const unsigned wa = (i < 4) ? a0[i & 3] : a1[i & 3], wb = (i < 4) ? b0[i & 3] : b1[i & 3];
            const float x1l = bflo(wa), x1h = bfhi(wa), x2l = bflo(wb), x2h = bfhi(wb);
            const float cl = cs[i][0], sl = cs[i][1], ch = cs[i][2], sh = cs[i][3];
            const float y1l = x1l * cl - x2l * sl, y2l = x2l * cl + x1l * sl, y1h = x1h * ch - x2h * sh, y2h = x2h * ch + x1h * sh;
            o1[i >> 2][i & 3] = pk2(y1l, y1h); o2[i >> 2][i & 3] = pk2(y2l, y2h);
        }
        if (wb) { *(v4u*)(row + d1) = o1[0]; *(v4u*)(row + d1 + 8) = o1[1]; *(v4u*)(row + d2) = o2[0]; *(v4u*)(row + d2 + 8) = o2[1]; }
        else if (o1[0][0] == 0x12345678u && o2[1][3] == 0x9abcdef0u) row[0] = 0;
    }
    {
        bf16* row = PROJ + tok * INW + C_RK + h * 128;
        v4u a0 = *(const v4u*)(row + d1), a1 = *(const v4u*)(row + d1 + 8), b0 = *(const v4u*)(row + d2), b1 = *(const v4u*)(row + d2 + 8);
        const float wf = __expf(lgf * (float)(127 - r)), wb_ = __expf(lgb * (float)r);
        v4u o1[2], o2[2];
#pragma unroll
        for (int i = 0; i < 8; ++i) {
            const unsigned wa = (i < 4) ? a0[i & 3] : a1[i & 3], wb = (i < 4) ? b0[i & 3] : b1[i & 3];
            const float x1l = bflo(wa), x1h = bfhi(wa), x2l = bflo(wb), x2h = bfhi(wb);
            const float cl = cs[i][0], sl = cs[i][1], ch = cs[i][2], sh = cs[i][3];
            const float sc = 0.08838834764831845f;
            const float y1l = (x1l * cl - x2l * sl) * sc, y2l = (x2l * cl + x1l * sl) * sc, y1h = (x1h * ch - x2h * sh) * sc, y2h = (x2h * ch + x1h * sh) * sc;
            o1[i >> 2][i & 3] = pk2(y1l, y1h); o2[i >> 2][i & 3] = pk2(y2l, y2h);
            const int e = 2 * i;
            *(LAS unsigned short*)(B0 + ((d1 + e) * LDT + r) * 2) = (unsigned short)f2bf(y1l * wf);
            *(LAS unsigned short*)(B0 + ((d1 + e + 1) * LDT + r) * 2) = (unsigned short)f2bf(y1h * wf);
            *(LAS unsigned short*)(B0 + ((d2 + e) * LDT + r) * 2) = (unsigned short)f2bf(y2l * wf);
            *(LAS unsigned short*)(B0 + ((d2 + e + 1) * LDT + r) * 2) = (unsigned short)f2bf(y2h * wf);
            *(LAS unsigned short*)(B1 + ((d1 + e) * LDT + r) * 2) = (unsigned short)f2bf(y1l * wb_);
            *(LAS unsigned short*)(B1 + ((d1 + e + 1) * LDT + r) * 2) = (unsigned short)f2bf(y1h * wb_);
            *(LAS unsigned short*)(B1 + ((d2 + e) * LDT + r) * 2) = (unsigned short)f2bf(y2l * wb_);
            *(LAS unsigned short*)(B1 + ((d2 + e + 1) * LDT + r) * 2) = (unsigned short)f2bf(y2h * wb_);
        }
        if (wb) { *(v4u*)(row + d1) = o1[0]; *(v4u*)(row + d1 + 8) = o1[1]; *(v4u*)(row + d2) = o2[0]; *(v4u*)(row + d2 + 8) = o2[1]; }
    }
    {
        const bf16* row = PROJ + tok * INW + C_RV + h * 128 + q * 32;
        v4u vv[4];
#pragma unroll
        for (int i = 0; i < 4; ++i) vv[i] = *(const v4u*)(row + 8 * i);
#pragma unroll
        for (int i = 0; i < 16; ++i) { const unsigned w = vv[i >> 2][i & 3]; const int dv = q * 32 + 2 * i;
            *(LAS unsigned short*)(B2 + (dv * LDT + r) * 2) = (unsigned short)(w & 0xffffu);
            *(LAS unsigned short*)(B2 + ((dv + 1) * LDT + r) * 2) = (unsigned short)(w >> 16); }
    }
    __syncthreads();
    {
        const int dv = tid >> 2, seg = (tid & 3) * 32; const LAS v4u* s = (const LAS v4u*)(B2 + (dv * LDT + seg) * 2);
        v4u* g = (v4u*)(VT + ((size_t)(b * 8 + h) * 128 + dv) * SEQ + c * 128 + seg);
        v4u x0 = s[0], x1 = s[1], x2 = s[2], x3 = s[3]; g[0] = x0; g[1] = x1; g[2] = x2; g[3] = x3;
    }
    const int wid = __builtin_amdgcn_readfirstlane(tid >> 6), lane = tid & 63, wr = wid >> 2, wc = wid & 3, fr = lane & 15, fq = lane >> 4;
#pragma unroll
    for (int dir = 0; dir < 2; ++dir) {
        f32x4 acc[4][2]; zero_acc(acc);
        lds_mma128(acc, B2, dir ? B1 : B0, wr, wc, fr, fq);
        float* Lp = L + ((size_t)(((b * 8 + h) * 2 + dir) * NCH + c)) * 16384;
#pragma unroll
        for (int m = 0; m < 4; ++m)
#pragma unroll
            for (int n = 0; n < 2; ++n) *(f32x4*)(Lp + (wr * 64 + m * 16 + fr) * 128 + wc * 32 + n * 16 + fq * 4) = acc[m][n];
    }
    __syncthreads();
}


__device__ __forceinline__ void qknorm_task(const Frame& F, int task, bf16* PROJ, const f32x2* ROPE, const float* qnw, const float* knw, bf16* scratch = nullptr) {
    int tid = F.tid; asm volatile("" : "+v"(tid));
    const int tile = task / 10, hh = task - tile * 10;
    const int r = tid >> 2, q = tid & 3, half = q >> 1, sub = q & 1;
    const int tokg = tile * 128 + r, t = tokg & (SEQ - 1), pos = half ? (t & 63) : (t >> 6);
    const int col0 = hh < 8 ? C_AQ + hh * 128 : C_AK + (hh - 8) * 128; const float* w = hh < 8 ? qnw : knw;
    const int d1 = half * 64 + sub * 16, d2 = d1 + 32;
    bf16* row = PROJ + (size_t)tokg * INW + col0;
    const v4u a0 = *(const v4u*)(row + d1), a1 = *(const v4u*)(row + d1 + 8), b0 = *(const v4u*)(row + d2), b1 = *(const v4u*)(row + d2 + 8);
    const f32x4* rp = (const f32x4*)(ROPE + pos * 32 + sub * 16);
    f32x4 cs[8], w1[4], w2[4];
#pragma unroll
    for (int i = 0; i < 8; ++i) cs[i] = rp[i];
#pragma unroll
    for (int i = 0; i < 4; ++i) { w1[i] = *(const f32x4*)(w + d1 + 4 * i); w2[i] = *(const f32x4*)(w + d2 + 4 * i); }
    float x1[16], x2[16]; float ss = 0.f;
#pragma unroll
    for (int i = 0; i < 8; ++i) { const unsigned wa = (i < 4) ? a0[i & 3] : a1[i & 3], wb = (i < 4) ? b0[i & 3] : b1[i & 3];
        x1[2 * i] = bflo(wa); x1[2 * i + 1] = bfhi(wa); x2[2 * i] = bflo(wb); x2[2 * i + 1] = bfhi(wb);
        ss += (x1[2 * i] * x1[2 * i] + x1[2 * i + 1] * x1[2 * i + 1]) + (x2[2 * i] * x2[2 * i] + x2[2 * i + 1] * x2[2 * i + 1]); }
    ss += __shfl_xor(ss, 1); ss += __shfl_xor(ss, 2);
    const float rs = 1.0f / sqrtf(ss * (1.0f / 128.0f) + EPS);
    v4u o1[2], o2[2];
#pragma unroll
    for (int i = 0; i < 8; ++i) {
        const float x1l = x1[2 * i] * rs * w1[i >> 1][(2 * i) & 3], x1h = x1[2 * i + 1] * rs * w1[i >> 1][(2 * i + 1) & 3];
        const float x2l = x2[2 * i] * rs * w2[i >> 1][(2 * i) & 3], x2h = x2[2 * i + 1] * rs * w2[i >> 1][(2 * i + 1) & 3];
        const float cl = cs[i][0], sl = cs[i][1], ch = cs[i][2], sh = cs[i][3];
        o1[i >> 2][i & 3] = pk2(x1l * cl - x2l * sl, x1h * ch - x2h * sh); o2[i >> 2][i & 3] = pk2(x2l * cl + x1l * sl, x2h * ch + x1h * sh);
    }
    bf16* drow = scratch ? scratch + (size_t)(task & 255) * 16384 + r * 128 : row;
    *(v4u*)(drow + d1) = o1[0]; *(v4u*)(drow + d1 + 8) = o1[1]; *(v4u*)(drow + d2) = o2[0]; *(v4u*)(drow + d2 + 8) = o2[1];
}

__device__ __forceinline__ void ret_out_task(const Frame& F, int task, bf16* PROJ, const bf16* VT, const bf16* ST, const float* gnw, const float* gnb, float lgf, float lgb, bf16* scratch = nullptr) {
    int tid = F.tid; asm volatile("" : "+v"(tid));
    const int b = task >> 9, h = (task >> 6) & 7, c = task & 63;
    const size_t tok0 = (size_t)b * SEQ + (size_t)c * 128;
    LAS unsigned char* B0 = F.lds; LAS unsigned char* B1 = F.lds + TILE_B; LAS unsigned char* B2 = F.lds + 2 * TILE_B; LAS unsigned char* B3 = F.lds + 3 * TILE_B;
    LAS float* red1 = (LAS float*)(F.lds + RED_OFF); LAS float* red2 = red1 + 512;
    const size_t sf = ((size_t)(((b * 8 + h) * 2 + 0) * NCH + c)) * 16384, sb = ((size_t)(((b * 8 + h) * 2 + 1) * NCH + c)) * 16384;
    tile_g2l(PROJ + tok0 * INW + C_RQ + h * 128, INW, B0, tid);
    tile_g2l(PROJ + tok0 * INW + C_RK + h * 128, INW, B1, tid);
    tile_g2l(VT + (size_t)(b * 8 + h) * 128 * SEQ + c * 128, SEQ, B2, tid);
    tile_g2l(ST + sf, 128, B3, tid);
    v4u sbr[4];
    { const v4u* p = (const v4u*)(ST + sb + (size_t)(tid >> 2) * 128 + (tid & 3) * 32); sbr[0] = p[0]; sbr[1] = p[1]; sbr[2] = p[2]; sbr[3] = p[3]; }
    const int wid = __builtin_amdgcn_readfirstlane(tid >> 6), lane = tid & 63, wr = wid >> 2, wc = wid & 3, fr = lane & 15, fq = lane >> 4;
    v2u rgv[4][2];
#pragma unroll
    for (int m = 0; m < 4; ++m)
#pragma unroll
        for (int n = 0; n < 2; ++n) rgv[m][n] = *(const v2u*)(PROJ + (tok0 + wr * 64 + m * 16 + fr) * INW + C_RG + h * 128 + wc * 32 + n * 16 + fq * 4);
    __syncthreads();
    f32x4 accS[4][2], accO[4][2];
    zero_acc(accS); zero_acc(accO);
    lds_mma128(accS, B0, B1, wr, wc, fr, fq);
    lds_mma128(accO, B0, B3, wr, wc, fr, fq);
    __syncthreads();
#pragma unroll
    for (int m = 0; m < 4; ++m) { const int nrow = wr * 64 + m * 16 + fr; const float df = __expf(lgf * (float)(nrow + 1));
#pragma unroll
        for (int n = 0; n < 2; ++n) { const int mc0 = wc * 32 + n * 16 + fq * 4; float p[4];
#pragma unroll
            for (int j = 0; j < 4; ++j) { const int d = nrow - (mc0 + j); const float dec = __expf((float)d * (d >= 0 ? lgf : -lgb)); p[j] = accS[m][n][j] * dec; }
            v2u w; w.x = pk2(p[0], p[1]); w.y = pk2(p[2], p[3]);
            *(LAS v2u*)(B1 + (nrow * LDT + mc0) * 2) = w;
            accO[m][n] = accO[m][n] * df; } }
    { LAS v4u* q = (LAS v4u*)(B3 + ((tid >> 2) * LDT + (tid & 3) * 32) * 2); q[0] = sbr[0]; q[1] = sbr[1]; q[2] = sbr[2]; q[3] = sbr[3]; }
    __syncthreads();
    lds_mma128(accO, B1, B2, wr, wc, fr, fq);
    zero_acc(accS);
    lds_mma128(accS, B0, B3, wr, wc, fr, fq);
    float mean[4], rstd[4];
#pragma unroll
    for (int m = 0; m < 4; ++m) { const int nrow = wr * 64 + m * 16 + fr; const float db = __expf(lgb * (float)(128 - nrow)); float s = 0.f;
#pragma unroll
        for (int n = 0; n < 2; ++n) { accO[m][n] = accO[m][n] + accS[m][n] * db; s += (accO[m][n][0] + accO[m][n][1]) + (accO[m][n][2] + accO[m][n][3]); }
        s += __shfl_xor(s, 16); s += __shfl_xor(s, 32);
        if (fq == 0) red1[nrow * 4 + wc] = s; }
    __syncthreads();
#pragma unroll
    for (int m = 0; m < 4; ++m) { const int nrow = wr * 64 + m * 16 + fr; const f32x4 pr = *(const LAS f32x4*)(red1 + nrow * 4);
        mean[m] = ((pr[0] + pr[1]) + (pr[2] + pr[3])) * (1.0f / 128.0f); float s = 0.f;
#pragma unroll
        for (int n = 0; n < 2; ++n) { const f32x4 d = accO[m][n] - mean[m]; s += (d[0] * d[0] + d[1] * d[1]) + (d[2] * d[2] + d[3] * d[3]); }
        s += __shfl_xor(s, 16); s += __shfl_xor(s, 32);
        if (fq == 0) red2[nrow * 4 + wc] = s; }
    __syncthreads();
#pragma unroll
    for (int m = 0; m < 4; ++m) { const int nrow = wr * 64 + m * 16 + fr; const f32x4 pr = *(const LAS f32x4*)(red2 + nrow * 4);
        rstd[m] = 1.0f / sqrtf(((pr[0] + pr[1]) + (pr[2] + pr[3])) * (1.0f / 128.0f) + EPS);
        bf16* grow = PROJ + (tok0 + nrow) * INW + C_RG + h * 128;
#pragma unroll
        for (int n = 0; n < 2; ++n) { const int col = wc * 32 + n * 16 + fq * 4;
            const f32x4 gw = *(const f32x4*)(gnw + h * 128 + col), gb = *(const f32x4*)(gnb + h * 128 + col);
            const v2u gv = rgv[m][n];
            const float g0 = bflo(gv.x), g1 = bfhi(gv.x), g2 = bflo(gv.y), g3 = bfhi(gv.y);
            const f32x4 y = (accO[m][n] - mean[m]) * rstd[m] * gw + gb;
            const float o0 = y[0] * g0 / (1.0f + __expf(-g0)), o1 = y[1] * g1 / (1.0f + __expf(-g1)), o2 = y[2] * g2 / (1.0f + __expf(-g2)), o3 = y[3] * g3 / (1.0f + __expf(-g3));
            v2u w; w.x = pk2(o0, o1); w.y = pk2(o2, o3); bf16* dst = scratch ? scratch + (size_t)(task & 255) * 16384 + nrow * 128 : grow; *(v2u*)(dst + col) = w; } }
    __syncthreads();
}

__global__ void __launch_bounds__(NWAVES * 64, 2) mega_fwd(Args args) {
    extern __shared__ __attribute__((aligned(16))) unsigned char lds[];
    cg::grid_group grid = cg::this_grid();
    Frame F;
    F.lds = (LAS unsigned char*)lds; F.ldsg = (char*)lds;
    F.tid = threadIdx.x; F.lane = F.tid & 63; F.wave = __builtin_amdgcn_readfirstlane(F.tid >> 6);
    F.G = gridDim.x; { const int bx = blockIdx.x; F.vcu = (F.G % 8 == 0) ? (bx % 8) * (F.G / 8) + bx / 8 : bx; }
    unsigned char* ws = args.ws;
    const float* x = args.in[0]; const float* mem = args.in[1]; const float* norm_mix_w = args.in[2]; const float* w_in = args.in[3];
    const float* dec_f = args.in[4]; const float* dec_b = args.in[5]; const float* gnw = args.in[6]; const float* gnb = args.in[7];
    const float* qnw = args.in[8]; const float* knw = args.in[9]; const float* w_out = args.in[10]; const float* norm_cross_w = args.in[11];
    const float* norm_mem_w = args.in[12]; const float* wcq = args.in[13]; const float* wck = args.in[14]; const float* wcv = args.in[15];
    const float* wco = args.in[16]; const float* norm_mlp_w = args.in[17]; const float* w_up = args.in[18]; const float* w_dn = args.in[19];
    const float* norm_final_w = args.in[20];
    float* out = args.out;
    f32x2* ROPE = (f32x2*)(ws + WS_ROPE);
    float* SS1 = (float*)(ws + WS_SS1); float* SS2 = (float*)(ws + WS_SS2); float* SS3 = (float*)(ws + WS_SS3);
    bf16* KVC = (bf16*)(ws + WS_KVC);
    bf16* WIN = (bf16*)(ws + WS_WIN); bf16* WOUT = (bf16*)(ws + WS_WOUT); bf16* WQ = (bf16*)(ws + WS_WQ); bf16* WKV = (bf16*)(ws + WS_WKV);
    bf16* WO = (bf16*)(ws + WS_WO); bf16* WUP = (bf16*)(ws + WS_WUP); bf16* WDN = (bf16*)(ws + WS_WDN);
    bf16* XN = (bf16*)(ws + WS_XN); bf16* MN = (bf16*)(ws + WS_MN); bf16* PROJ = (bf16*)(ws + WS_PROJ); bf16* VT = (bf16*)(ws + WS_VT);
    bf16* ST = (bf16*)(ws + WS_ST); bf16* QC = (bf16*)(ws + WS_QC); bf16* U = (bf16*)(ws + WS_U);
    float* L = out;
    const int lo = args.ph_lo, hi = args.ph_hi;
    volatile LAS unsigned* misc = (volatile LAS unsigned*)(F.lds + MISC_OFF);
    if (F.tid < 4) misc[F.tid] = 0u;
    __syncthreads();
    XcdBarrier xbar; xbar.bar = (unsigned*)(ws + WS_CTL); xbar.x = 0; xbar.st = nullptr;
    if (args.coop == 1) xbar = xcd_barrier_post((unsigned*)(ws + WS_CTL), misc);
#ifndef PH_MASK
#define PH_MASK 0xfff
#endif
#define IN(k) ((((PH_MASK) >> (k)) & 1) && lo <= (k) && (k) < hi)
#ifndef REPS
#define REPS 1
#endif
#define SEAM(k) do { if (IN(k) && IN((k) + 1)) { if (args.coop == 1) { for (int rs_ = 0; rs_ < REPS; ++rs_) xcd_barrier(xbar); } else if (args.coop == 2) grid.sync(); } } while (0)
    const int gw = F.vcu * NWAVES + F.wave, NGW = F.G * NWAVES;
    const int bid = blockIdx.x, G = F.G;

#ifndef REP0
#define REP0 1
#endif
    if (IN(0)) for (int rep_ = 0; rep_ < REP0; ++rep_) {
        __syncthreads();
        LAS float* scr = (LAS float*)(F.lds + F.wave * 18432);
        constexpr int I_IN = (DM / 64) * (INW / 64), I_C = (DM / 64) * (CWID / 64);
        constexpr int NITEMS = I_IN + 2 * I_C;
        for (int it = gw; it < NITEMS; it += NGW) {
            int r = it;
            if (r < I_IN) { p0_transpose_item(w_in, DM, INW, WIN, 0, nullptr, scr, r, F.lane); continue; } r -= I_IN;
            if (r < I_C) { p0_transpose_item(wck, DM, CWID, WKV, 0, nullptr, scr, r, F.lane); continue; } r -= I_C;
            p0_transpose_item(wcv, DM, CWID, WKV, CWID, nullptr, scr, r, F.lane);
        }
        if (G != 256) {
            constexpr int I_OUT = (DM / 64) * (DM / 64), I_CO = (CWID / 64) * (DM / 64), I_UP = (DM / 64) * (DFF / 64), I_DN = (DFF / 64) * (DM / 64);
            for (int it = gw; it < I_OUT + I_C + I_CO + I_UP + I_DN; it += NGW) {
                int r = it;
                if (r < I_OUT) { p0_transpose_item(w_out, DM, DM, WOUT, 0, nullptr, scr, r, F.lane); continue; } r -= I_OUT;
                if (r < I_C) { p0_transpose_item(wcq, DM, CWID, WQ, 0, norm_cross_w, scr, r, F.lane); continue; } r -= I_C;
                if (r < I_CO) { p0_transpose_item(wco, CWID, DM, WO, 0, nullptr, scr, r, F.lane); continue; } r -= I_CO;
                if (r < I_UP) { p0_transpose_item(w_up, DM, DFF, WUP, 0, norm_mlp_w, scr, r, F.lane); continue; } r -= I_UP;
                p0_transpose_item(w_dn, DFF, DM, WDN, 0, nullptr, scr, r, F.lane);
            }
        }
        for (int m = gw; m < M + MROWS; m += NGW) {
            if (m < M) rms_row_to_bf16(x + (size_t)m * DM, norm_mix_w, XN + (size_t)m * DM, F.lane);
            else rms_row_to_bf16(mem + (size_t)(m - M) * DM, norm_mem_w, MN + (size_t)(m - M) * DM, F.lane);
        }
        for (int e = bid * 512 + F.tid; e < 128 * 32; e += G * 512) {
            const int pos = e >> 5, i = e & 31;
            double f = 1.0; for (int k = 0; k < i; ++k) f *= 0.7498942093324559;
            const float invf = (float)f; const float angf = (float)pos * invf; const double a = (double)angf;
            const double kk = __builtin_rint(a * 0.15915494309189535); const double r = a - kk * 6.283185307179586477;
            const double r2 = r * r; double tc = 1.0, cc = 1.0, ts = r, sn = r;
            for (int n = 1; n <= 16; ++n) { tc *= -r2 / (double)((2 * n - 1) * (2 * n)); cc += tc; ts *= -r2 / (double)((2 * n) * (2 * n + 1)); sn += ts; }
            ROPE[e] = (f32x2){(float)cc, (float)sn};
        }
    }
    SEAM(0);

    if (IN(1)) {
        { pg8::Gemm g{XN, WIN, M, INW, DM, DM}; pg8::StaticOrder S; S.init(M, INW, G, bid);
          pg8::EpiBf<0> E{PROJ, INW, nullptr};
          pg8::gemm_phase<pg8::EpiBf<0>, pg8::StaticOrder, true, true>(F.lds, g, S, E); }
        { pg8::Gemm g{MN, WKV, MROWS, 2 * CWID, DM, DM}; pg8::StaticOrder S; S.init(MROWS, 2 * CWID, G, (bid + G / 2) % G);
          pg8::EpiBf<0> E{KVC, 2 * CWID, nullptr};
          pg8::gemm_phase<pg8::EpiBf<0>, pg8::StaticOrder, true, true>(F.lds, g, S, E); }
        const int nfull = ((M / 256) * (INW / 256)) % G, nkv = (MROWS / 256) * (2 * CWID / 256);
        if (G == 256 && bid >= G / 2 + nkv) {
            __syncthreads();
            LAS float* scr = (LAS float*)(F.lds + F.wave * 18432);
            const int w0 = (bid - (G / 2 + nkv)) * NWAVES + F.wave, nw = (G - (G / 2 + nkv)) * NWAVES;
            constexpr int I_OUT = (DM / 64) * (DM / 64), I_C = (DM / 64) * (CWID / 64), I_CO = (CWID / 64) * (DM / 64), I_UP = (DM / 64) * (DFF / 64);
            for (int it = w0; it < I_OUT + I_C + I_CO + I_UP; it += nw) {
                int r = it;
                if (r < I_OUT) { p0_transpose_item(w_out, DM, DM, WOUT, 0, nullptr, scr, r, F.lane); continue; } r -= I_OUT;
                if (r < I_C) { p0_transpose_item(wcq, DM, CWID, WQ, 0, norm_cross_w, scr, r, F.lane); continue; } r -= I_C;
                if (r < I_CO) { p0_transpose_item(wco, CWID, DM, WO, 0, nullptr, scr, r, F.lane); continue; } r -= I_CO;
                p0_transpose_item(w_up, DM, DFF, WUP, 0, norm_mlp_w, scr, r, F.lane);
            }
        }
        (void)nfull;
    }
    SEAM(1);

    if (IN(2)) {
#ifdef PROBE_P2A
        for (int task = bid; task < BATCH * 8 * NCH; task += G) {
            const int h = (task >> 6) & 7;
            const float lgf = -expf(dec_f[h]), lgb = -expf(dec_b[h]);
            ret_prep_task(F, task, PROJ, ROPE, VT, L, lgf, lgb, false);
        }
#endif
#ifdef PROBE_P2B
        for (int task = bid; task < (M / 128) * 10; task += G) qknorm_task(F, task, PROJ, ROPE, qnw, knw, QC);
#endif
        for (int task = bid; task < BATCH * 8 * NCH; task += G) {
            const int h = (task >> 6) & 7;
            const float lgf = -expf(dec_f[h]), lgb = -expf(dec_b[h]);
            ret_prep_task(F, task, PROJ, ROPE, VT, L, lgf, lgb);
        }
        for (int task = bid; task < (M / 128) * 10; task += G) qknorm_task(F, task, PROJ, ROPE, qnw, knw);
    }
    SEAM(2);

#ifndef REP3
#define REP3 1
#endif
    if (IN(3)) for (int rep_ = 0; rep_ < REP3; ++rep_) {
        for (int e = bid * 512 + F.tid; e < 32 * 4096; e += G * 512) {
            const int series = e >> 12, off4 = e & 4095, dir = series & 1, h = (series >> 1) & 7;
            const float lg = -expf(dir ? dec_b[h] : dec_f[h]); const float g128 = expf(lg * 128.0f);
            const f32x4* Lp = (const f32x4*)(L + (size_t)series * NCH * 16384) + off4; v2u* Sp = (v2u*)(ST + (size_t)series * NCH * 16384) + off4;
            f32x4 s = (f32x4){0.f, 0.f, 0.f, 0.f};
            if (dir == 0) {
                for (int c0 = 0; c0 < NCH; c0 += 8) { f32x4 l[8];
#pragma unroll
                    for (int i = 0; i < 8; ++i) l[i] = Lp[(size_t)(c0 + i) * 4096];
#pragma unroll
                    for (int i = 0; i < 8; ++i) { v2u w; w.x = pk2(s[0], s[1]); w.y = pk2(s[2], s[3]); Sp[(size_t)(c0 + i) * 4096] = w; s = s * g128 + l[i]; } }
            } else {
                for (int c0 = NCH - 8; c0 >= 0; c0 -= 8) { f32x4 l[8];
#pragma unroll
                    for (int i = 0; i < 8; ++i) l[i] = Lp[(size_t)(c0 + i) * 4096];
#pragma unroll
                    for (int i = 7; i >= 0; --i) { v2u w; w.x = pk2(s[0], s[1]); w.y = pk2(s[2], s[3]); Sp[(size_t)(c0 + i) * 4096] = w; s = s * g128 + l[i]; } }
            }
        }
    }
    SEAM(3);

    if (IN(4)) {
#ifdef PROBE_P4A
        for (int u = bid; u < 512; u += G) {
            const int bk = u >> 7, b = bk >> 1, kvh = bk & 1, g = (u >> 5) & 3, qb = u & 31, h = kvh * 4 + g;
            bf16* Qb = PROJ + ((size_t)b * SEQ + (size_t)qb * 256) * INW + C_AQ + h * 128;
            const bf16* Kh = PROJ + (size_t)b * SEQ * INW + C_AK + kvh * 128;
            bf16* Od = (bf16*)out + ((size_t)b * SEQ + (size_t)qb * 256) * 1024 + h * 128;
            att::attn_dense_body<INW, INW, 1024, C_AV - C_AK>((const att::bf16*)Qb, (const att::bf16*)Kh, (att::bf16*)Od, SEQ, F.ldsg);
            __syncthreads();
        }
#endif
#ifdef PROBE_P4B
        for (int task = bid; task < BATCH * 8 * NCH; task += G) {
            const int h = (task >> 6) & 7;
            const float lgf = -expf(dec_f[h]), lgb = -expf(dec_b[h]);
            ret_out_task(F, task, PROJ, VT, ST, gnw, gnb, lgf, lgb, QC);
        }
#endif
#ifndef SKIP_ATT
        for (int u = bid; u < 512; u += G) {
            const int bk = u >> 7, b = bk >> 1, kvh = bk & 1, g = (u >> 5) & 3, qb = u & 31, h = kvh * 4 + g;
            bf16* Qb = PROJ + ((size_t)b * SEQ + (size_t)qb * 256) * INW + C_AQ + h * 128;
            const bf16* Kh = PROJ + (size_t)b * SEQ * INW + C_AK + kvh * 128;
            att::attn_dense_body<INW, INW, INW, C_AV - C_AK>((const att::bf16*)Qb, (const att::bf16*)Kh, (att::bf16*)Qb, SEQ, F.ldsg);
            __syncthreads();
        }
#endif
#ifndef SKIP_RET
        for (int task = bid; task < BATCH * 8 * NCH; task += G) {
            const int h = (task >> 6) & 7;
            const float lgf = -expf(dec_f[h]), lgb = -expf(dec_b[h]);
            ret_out_task(F, task, PROJ, VT, ST, gnw, gnb, lgf, lgb);
        }
#endif
    }
    SEAM(4);

    if (IN(5)) {
        pg8::Gemm g{PROJ + C_RG, WOUT, M, DM, DM, INW}; pg8::StaticOrder S; S.init(M, DM, G, bid);
        pg8::EpiResid E{x, out, XN, SS1};
        pg8::gemm_phase<pg8::EpiResid, pg8::StaticOrder, true, true>(F.lds, g, S, E);
    }
    SEAM(5);

    if (IN(6)) {
        pg8::Gemm g{XN, WQ, M, CWID, DM, DM}; pg8::StaticOrder S; S.init(M, CWID, G, bid);
        pg8::EpiBf<1> E{QC, CWID, SS1};
        pg8::gemm_phase<pg8::EpiBf<1>, pg8::StaticOrder, true, true>(F.lds, g, S, E);
        if (G == 256 && bid >= 128) {
            LAS float* scr = (LAS float*)(F.lds + F.wave * 18432);
            const int w0 = (bid - 128) * NWAVES + F.wave, nw = 128 * NWAVES;
            constexpr int I_DN = (DFF / 64) * (DM / 64);
            for (int it = w0; it < I_DN; it += nw) p0_transpose_item(w_dn, DFF, DM, WDN, 0, nullptr, scr, it, F.lane);
        }
    }
    SEAM(6);

    if (IN(7)) {
        for (int u = bid; u < BATCH * 4 * 32; u += G) {
            const int b = u >> 7, h = (u >> 5) & 3, qb = u & 31;
            bf16* Qb = QC + ((size_t)b * SEQ + (size_t)qb * 256) * CWID + h * 128;
            const bf16* Kh = KVC + (size_t)b * MEMT * (2 * CWID) + h * 128;
            att::attn_dense_body<CWID, 2 * CWID, CWID, CWID>((const att::bf16*)Qb, (const att::bf16*)Kh, (att::bf16*)Qb, MEMT, F.ldsg);
            __syncthreads();
        }
    }
    SEAM(7);

    if (IN(8)) {
        pg8::Gemm g{QC, WO, M, DM, CWID, CWID}; pg8::StaticOrder S; S.init(M, DM, G, bid);
        pg8::EpiResid E{out, out, XN, SS2};
        pg8::gemm_phase<pg8::EpiResid, pg8::StaticOrder, true, true>(F.lds, g, S, E);
    }
    SEAM(8);

    if (IN(9)) {
        pg8::Gemm g{XN, WUP, M, DFF, DM, DM}; pg8::StaticOrder S; S.init(M, DFF, G, bid);
        pg8::EpiBf<2> E{U, DFF, SS2};
        pg8::gemm_phase<pg8::EpiBf<2>, pg8::StaticOrder, true, true>(F.lds, g, S, E);
#ifdef PROBE_P9X2
        __syncthreads(); pg8::gemm_phase<pg8::EpiBf<2>, pg8::StaticOrder, true, true>(F.lds, g, S, E);
#endif
#ifdef PROBE_P9NULL
        __syncthreads(); { pg8::EpiNull EN{U}; pg8::gemm_phase<pg8::EpiNull, pg8::StaticOrder, true, true>(F.lds, g, S, EN); }
#endif
    }
    SEAM(9);

    if (IN(10)) {
        pg8::Gemm g{U, WDN, M, DM, DFF, DFF}; pg8::StaticOrder S; S.init(M, DM, G, bid);
        pg8::EpiResid E{out, nullptr, XN, SS3};
        pg8::gemm_phase<pg8::EpiResid, pg8::StaticOrder, true, true>(F.lds, g, S, E);
    }
    SEAM(10);

    if (IN(11)) {
        const f32x4* wr = (const f32x4*)norm_final_w + F.lane;
        for (int m = gw; m < M; m += 2 * NGW) {
            const int m2 = (m + NGW < M) ? m + NGW : m;
            const float p0 = (F.lane < 32) ? SS3[(size_t)m * 32 + F.lane] : 0.f, p1 = (F.lane < 32) ? SS3[(size_t)m2 * 32 + F.lane] : 0.f;
            const v2u* xr0 = (const v2u*)(XN + (size_t)m * DM) + F.lane; const v2u* xr1 = (const v2u*)(XN + (size_t)m2 * DM) + F.lane;
            v2u v0[8], v1[8];
#pragma unroll
            for (int j = 0; j < 8; ++j) { v0[j] = xr0[64 * j]; v1[j] = xr1[64 * j]; }
            const float rs0 = 1.0f / sqrtf(wave_sum(p0) * (1.0f / 2048.0f) + EPS), rs1 = 1.0f / sqrtf(wave_sum(p1) * (1.0f / 2048.0f) + EPS);
            f32x4* o0 = (f32x4*)(out + (size_t)m * DM) + F.lane; f32x4* o1 = (f32x4*)(out + (size_t)m2 * DM) + F.lane;
#pragma unroll
            for (int j = 0; j < 8; ++j) { const f32x4 g = wr[64 * j];
                o0[64 * j] = (f32x4){bflo(v0[j].x) * rs0 * g[0], bfhi(v0[j].x) * rs0 * g[1], bflo(v0[j].y) * rs0 * g[2], bfhi(v0[j].y) * rs0 * g[3]};
                o1[64 * j] = (f32x4){bflo(v1[j].x) * rs1 * g[0], bfhi(v1[j].x) * rs1 * g[1], bflo(v1[j].y) * rs1 * g[2], bfhi(v1[j].y) * rs1 * g[3]}; }
        }
    }
#undef IN
#undef SEAM
}

#ifndef MK_PER_PHASE
#define MK_PER_PHASE 0
#endif
constexpr int NPHASE = 12;
extern "C" void kernel_launch(void* const* d_in, const int* in_sizes, int n_in, void* d_out, int out_size, void* d_ws, size_t ws_size, hipStream_t stream) {
    static int grid = 0;
    if (grid == 0) {
        if (n_in != 21 || in_sizes[0] != M * DM || out_size != M * DM || ws_size < WS_END) {
            fprintf(stderr, "kernel_launch: unexpected shapes: n_in %d in0 %d out %d ws %zu (need >= %zu); nothing launched\n", n_in, n_in > 0 ? in_sizes[0] : -1, out_size, ws_size, (size_t)WS_END);
            grid = -1; return; }
        int dev = 0, cus = 0, per_cu = 0;
        if (hipGetDevice(&dev) != hipSuccess || hipDeviceGetAttribute(&cus, hipDeviceAttributeMultiprocessorCount, dev) != hipSuccess) { grid = -1; return; }
        if (hipFuncSetAttribute((const void*)mega_fwd, hipFuncAttributeMaxDynamicSharedMemorySize, LDS_BYTES) != hipSuccess) { fprintf(stderr, "kernel_launch: hipFuncSetAttribute failed\n"); grid = -1; return; }
        if (hipOccupancyMaxActiveBlocksPerMultiprocessor(&per_cu, (const void*)mega_fwd, NWAVES * 64, LDS_BYTES) != hipSuccess || per_cu < 1) {
            fprintf(stderr, "kernel_launch: occupancy query says %d blocks per CU\n", per_cu); per_cu = 1; }
        (void)hipGetLastError();
        grid = cus;
    }
    if (grid < 0) return;
    Args a{};
    for (int i = 0; i < 21; ++i) a.in[i] = (const float*)d_in[i];
    a.out = (float*)d_out; a.ws = (unsigned char*)d_ws;
#if MK_PER_PHASE
    for (int p = 0; p < NPHASE; ++p) { a.ph_lo = p; a.ph_hi = p + 1; a.coop = 0; hipLaunchKernelGGL(mega_fwd, dim3(grid), dim3(NWAVES * 64), LDS_BYTES, stream, a); }
#else
    if (hipMemsetAsync((char*)d_ws + WS_CTL, 0, CTL_ZERO_BYTES, stream) != hipSuccess) { fprintf(stderr, "kernel_launch: memset failed\n"); return; }
    a.ph_lo = 0; a.ph_hi = NPHASE; a.coop = 1;
    void* kargs[] = {&a};
    const hipError_t e = hipLaunchCooperativeKernel((const void*)mega_fwd, dim3(grid), dim3(NWAVES * 64), kargs, LDS_BYTES, stream);
    if (e != hipSuccess) fprintf(stderr, "kernel_launch: cooperative launch failed: %s (grid %d)\n", hipGetErrorString(e), grid);
#endif
}
```

```cpp
#include <hip/hip_runtime.h>
#include <hip/hip_bf16.h>
#include <hip/hip_cooperative_groups.h>
#include <cstdio>
#include <cstdint>
namespace cg = cooperative_groups;

__device__ __forceinline__ int lane_id_() { int l; asm volatile("v_mbcnt_lo_u32_b32 %0, -1, 0\n\tv_mbcnt_hi_u32_b32 %0, -1, %0" : "=v"(l)); return l; }
#define TID_(wave) ((wave) * 64 + lane_id_())
namespace pg8 {
#define PG8_LAS __attribute__((address_space(3)))
typedef unsigned short bf16_t;
typedef short bf16x8 __attribute__((ext_vector_type(8)));
typedef float f32x4 __attribute__((ext_vector_type(4)));
typedef unsigned u32x4 __attribute__((ext_vector_type(4)));
constexpr int BM = 256, BK = 64, HALF = 128, HTB = HALF * BK * 2  , STAGE_BYTES = 8 * HTB, NXCD = 8, WGM = 8;

__host__ __device__ __forceinline__ int lds_byte(int r, int c) { const int st = (r >> 4) * 2 + (c >> 5), rr = r & 15, cc = c & 31, ob = rr * 64 + cc * 2; return st * 1024 + (ob ^ (((ob >> 9) & 1) << 5)); }
__host__ __device__ __forceinline__ void stage_rc(int b, int& R, int& C) { const int st = b / 1024, sb = b % 1024, swz = sb ^ (((sb >> 9) & 1) << 5); R = (st >> 1) * 16 + swz / 64; C = (st & 1) * 32 + (swz % 64) / 2; }
__host__ __device__ __forceinline__ int perm32(int rho) { const int n = rho >> 4, i = rho & 15; return 8 * (i >> 2) + 4 * n + (i & 3); }

struct Unit { int pm, pn; };
struct Gemm { const bf16_t* A; const bf16_t* Bt; int M, N, K, lda; };

struct StaticOrder {
    int nM, nN, nwg, G, c;
    __host__ __device__ void init(int M, int N, int G_, int c_) { nM = M / BM; nN = N / BM; nwg = nM * nN; G = G_; c = c_; }
    __host__ __device__ __forceinline__ bool next(int i, Unit& u) const {
        const long L = (long)i * G + c; if (L >= nwg) return false;
        int wgid = (int)L; { const int q = nwg / NXCD, r = nwg % NXCD, xcd = wgid % NXCD, off = wgid / NXCD; wgid = (xcd < r ? xcd * (q + 1) : r * (q + 1) + (xcd - r) * q) + off; }
        const int nig = WGM * nN, gid = wgid / nig, fm = gid * WGM, gsz = (nM - fm) < WGM ? (nM - fm) : WGM;
        u.pm = fm + ((wgid % nig) % gsz); u.pn = (wgid % nig) / gsz; return true;
    }
    __device__ __forceinline__ void a_ready(const Unit&) const {}
    __device__ __forceinline__ void done(const Unit&) const {}
};

__device__ __forceinline__ unsigned cvt_pk_bf16(float lo, float hi) { unsigned r; asm volatile("v_cvt_pk_bf16_f32 %0, %1, %2" : "=v"(r) : "v"(lo), "v"(hi)); return r; }
__device__ __forceinline__ float row_rs(const float* ss, int row, int fq) {
    const f32x4 a = *(const f32x4*)(ss + (size_t)row * 32 + fq * 8), b = *(const f32x4*)(ss + (size_t)row * 32 + fq * 8 + 4);
    float s = ((a[0] + a[1]) + (a[2] + a[3])) + ((b[0] + b[1]) + (b[2] + b[3]));
    s += __shfl_xor(s, 16); s += __shfl_xor(s, 32);
    return 1.0f / sqrtf(s * (1.0f / 2048.0f) + 1e-6f);
}
template <int MODE> struct EpiBf {
    static constexpr bool PERM = true, AFTER_DRAIN = false;
    bf16_t* O; int ldc; const float* ss; int gap_pn, gap_add;
    const PG8_LAS float* rsl;
    __device__ __forceinline__ void operator()(const f32x4 (&acc)[2][2][4][2], const Unit& u, int wr, int wc, int fr, int fq) const {
        const int pnc = (gap_add != 0 && u.pn >= gap_pn) ? u.pn + gap_add : u.pn;
        const int row0 = u.pm * BM + wr * 64 + fr, col0 = pnc * BM + wc * 32 + 8 * fq;
        float scv[2][4];
#pragma unroll
        for (int ai = 0; ai < 2; ++ai)
#pragma unroll
            for (int m = 0; m < 4; ++m) scv[ai][m] = (MODE == 3) ? rsl[ai * HALF + wr * 64 + m * 16 + fr] : ((MODE != 0) ? row_rs(ss, row0 + ai * HALF + m * 16, fq) : 1.f);
#pragma unroll
        for (int ai = 0; ai < 2; ++ai)
#pragma unroll
            for (int m = 0; m < 4; ++m) { const int row = row0 + ai * HALF + m * 16; bf16_t* rowp = O + (size_t)row * ldc + col0;
                const float sc = scv[ai][m];
#pragma unroll
                for (int bj = 0; bj < 2; ++bj) { f32x4 v0 = acc[ai][bj][m][0] * sc, v1 = acc[ai][bj][m][1] * sc;
                    if (MODE >= 2) {
#pragma unroll
                        for (int j = 0; j < 4; ++j) { const float a = fmaxf(v0[j], 0.f), b = fmaxf(v1[j], 0.f); v0[j] = a * a; v1[j] = b * b; } }
                    u32x4 w; w.x = cvt_pk_bf16(v0[0], v0[1]); w.y = cvt_pk_bf16(v0[2], v0[3]); w.z = cvt_pk_bf16(v1[0], v1[1]); w.w = cvt_pk_bf16(v1[2], v1[3]);
                    if (MODE >= 2) __builtin_nontemporal_store(w, (u32x4*)(rowp + bj * HALF)); else *(u32x4*)(rowp + bj * HALF) = w; } }
    }
};
struct EpiNull {
    static constexpr bool PERM = true, AFTER_DRAIN = false;
    bf16_t* O;
    __device__ __forceinline__ void operator()(const f32x4 (&acc)[2][2][4][2], const Unit& u, int wr, int wc, int fr, int fq) const {
        float s = 0.f;
#pragma unroll
        for (int ai = 0; ai < 2; ++ai)
#pragma unroll
            for (int bj = 0; bj < 2; ++bj)
#pragma unroll
                for (int m = 0; m < 4; ++m)
#pragma unroll
                    for (int n = 0; n < 2; ++n) s += (acc[ai][bj][m][n][0] + acc[ai][bj][m][n][1]) + (acc[ai][bj][m][n][2] + acc[ai][bj][m][n][3]);
        if (s == 1.2345e30f) O[u.pm + u.pn] = 1;
    }
};
struct EpiResid {
    static constexpr bool PERM = true, AFTER_DRAIN = false;
    const float* basef; const bf16_t* baseb; float* out; bf16_t* xb; float* ss;
    __device__ __forceinline__ void operator()(const f32x4 (&acc)[2][2][4][2], const Unit& u, int wr, int wc, int fr, int fq) const {
        const int col0 = u.pn * BM + wc * 32 + 8 * fq;
#pragma unroll
        for (int ai = 0; ai < 2; ++ai) {
            f32x4 bs[4][2][2];
#pragma unroll
            for (int m = 0; m < 4; ++m) { const size_t off = (size_t)(u.pm * BM + ai * HALF + wr * 64 + m * 16 + fr) * 2048 + col0;
#pragma unroll
                for (int bj = 0; bj < 2; ++bj) {
                    if (baseb) { const u32x4 w = *(const u32x4*)(baseb + off + bj * HALF);
                        bs[m][bj][0] = (f32x4){__uint_as_float(w.x << 16), __uint_as_float(w.x & 0xffff0000u), __uint_as_float(w.y << 16), __uint_as_float(w.y & 0xffff0000u)};
                        bs[m][bj][1] = (f32x4){__uint_as_float(w.z << 16), __uint_as_float(w.z & 0xffff0000u), __uint_as_float(w.w << 16), __uint_as_float(w.w & 0xffff0000u)}; }
                    else { bs[m][bj][0] = __builtin_nontemporal_load((const f32x4*)(basef + off + bj * HALF)); bs[m][bj][1] = __builtin_nontemporal_load((const f32x4*)(basef + off + bj * HALF + 4)); } } }
#pragma unroll
            for (int m = 0; m < 4; ++m) { const int row = u.pm * BM + ai * HALF + wr * 64 + m * 16 + fr; const size_t off = (size_t)row * 2048 + col0; float sq = 0.f;
#pragma unroll
                for (int bj = 0; bj < 2; ++bj) { const f32x4 x0 = bs[m][bj][0] + acc[ai][bj][m][0], x1 = bs[m][bj][1] + acc[ai][bj][m][1];
                    if (out) { *(f32x4*)(out + off + bj * HALF) = x0; *(f32x4*)(out + off + bj * HALF + 4) = x1; }
                    sq += ((x0[0] * x0[0] + x0[1] * x0[1]) + (x0[2] * x0[2] + x0[3] * x0[3])) + ((x1[0] * x1[0] + x1[1] * x1[1]) + (x1[2] * x1[2] + x1[3] * x1[3]));
                    u32x4 w; w.x = cvt_pk_bf16(x0[0], x0[1]); w.y = cvt_pk_bf16(x0[2], x0[3]); w.z = cvt_pk_bf16(x1[0], x1[1]); w.w = cvt_pk_bf16(x1[2], x1[3]);
                    *(u32x4*)(xb + off + bj * HALF) = w; }
                sq += __shfl_xor(sq, 16); sq += __shfl_xor(sq, 32);
                if (fq == 0) ss[(size_t)row * 32 + u.pn * 4 + wc] = sq; }
            asm volatile("" ::: "memory");
        }
    }
};

template <class Epi, class Sched, bool ALIGN_EPI = false, bool SP2 = false>
__device__ __forceinline__ void gemm_phase(PG8_LAS unsigned char* lds, const Gemm g, const Sched& S, const Epi& E, const int wave_) {
    const int wid = wave_, lane = lane_id_(), tid = wid * 64 + lane, wr = wid >> 2, wc = wid & 3, fr = lane & 15, fq = lane >> 4;
    const int K = g.K, nt = K / BK;
    unsigned voffA[2], voffB[2];
#pragma unroll
    for (int i = 0; i < 2; ++i) { int R, C; stage_rc(tid * 16 + i * 8192, R, C); const int Rb = Epi::PERM ? ((R & ~31) + perm32(R & 31)) : R;
        voffA[i] = (unsigned)(R * g.lda + C) * 2u; voffB[i] = (unsigned)(Rb * K + C) * 2u; }
    const size_t kstep = (size_t)(BK * 2);
    const size_t hstep = (size_t)HALF * K * 2;
    const size_t tstep = 2 * hstep; const size_t hstepA = (size_t)HALF * g.lda * 2, tstepA = 2 * hstepA;
    const unsigned ldsw = (unsigned)wid * 1024u;
    const int aoff = lds_byte(wr * 64 + fr, fq * 8), boff = lds_byte(wc * 32 + fr, fq * 8);
#define PG8_SA(b, h) (((b) * 2 + (h)) * HTB)
#define PG8_SB(b, h) ((4 + (b) * 2 + (h)) * HTB)
#define PG8_STAGE(bufoff, gbase, voff) do { _Pragma("unroll") for (int _i = 0; _i < 2; ++_i) \
        __builtin_amdgcn_global_load_lds((const unsigned*)((const char*)(gbase) + (voff)[_i]), (PG8_LAS unsigned*)(lds + (bufoff) + ldsw + _i * 8192), 16, 0, 0); } while (0)
#define PG8_LDA(dst, b, h) do { _Pragma("unroll") for (int m = 0; m < 4; ++m) _Pragma("unroll") for (int k = 0; k < 2; ++k) dst[m][k] = *(const PG8_LAS bf16x8*)(lds + PG8_SA(b, h) + aoff + m * 2048 + k * 1024); } while (0)
#define PG8_LDB(dst, b, h) do { _Pragma("unroll") for (int n = 0; n < 2; ++n) _Pragma("unroll") for (int k = 0; k < 2; ++k) dst[n][k] = *(const PG8_LAS bf16x8*)(lds + PG8_SB(b, h) + boff + n * 2048 + k * 1024); } while (0)
#define PG8_MMA(ai, bj, At, Bt) do { __builtin_amdgcn_s_setprio(1); _Pragma("unroll") for (int m = 0; m < 4; ++m) _Pragma("unroll") for (int n = 0; n < 2; ++n) _Pragma("unroll") for (int k = 0; k < 2; ++k) \
        acc[ai][bj][m][n] = __builtin_amdgcn_mfma_f32_16x16x32_bf16(Bt[n][k], At[m][k], acc[ai][bj][m][n], 0, 0, 0); __builtin_amdgcn_s_setprio(0); } while (0)
#define PG8_WAIT_V(n) asm volatile("s_waitcnt vmcnt(" #n ")" ::: "memory")
#define PG8_WAIT_L(n) asm volatile("s_waitcnt lgkmcnt(" #n ")" ::: "memory")
#define PG8_BAR __builtin_amdgcn_s_barrier()
#define PG8_SCHED __builtin_amdgcn_sched_barrier(0)
    Unit cur, nxt; int ui = 0;
    if (!S.next(0, cur)) return;
    f32x4 acc[2][2][4][2];
#pragma unroll
    for (int a = 0; a < 2; ++a)
#pragma unroll
        for (int b = 0; b < 2; ++b)
#pragma unroll
            for (int m = 0; m < 4; ++m)
#pragma unroll
                for (int n = 0; n < 2; ++n) acc[a][b][m][n] = (f32x4){0.f, 0.f, 0.f, 0.f};
    bf16x8 At[4][2], B0[2][2], B1[2][2];
    const char* cA = (const char*)g.A + (size_t)cur.pm * tstepA; const char* cB = (const char*)g.Bt + (size_t)cur.pn * tstep;
    S.a_ready(cur);
    if constexpr (SP2) {
        PG8_STAGE(PG8_SB(0, 0), cB, voffB); PG8_STAGE(PG8_SB(0, 1), cB + hstep, voffB); PG8_STAGE(PG8_SA(0, 0), cA, voffA); PG8_STAGE(PG8_SA(0, 1), cA + hstepA, voffA);
        if (wr == 1) PG8_BAR;
        PG8_WAIT_V(2); PG8_BAR;
        PG8_STAGE(PG8_SB(1, 0), cB + kstep, voffB); PG8_STAGE(PG8_SA(1, 0), cA + kstep, voffA); PG8_STAGE(PG8_SB(1, 1), cB + hstep + kstep, voffB);
        PG8_WAIT_V(6); PG8_BAR;
    } else {
        PG8_STAGE(PG8_SB(0, 0), cB, voffB); PG8_STAGE(PG8_SA(0, 0), cA, voffA); PG8_STAGE(PG8_SB(0, 1), cB + hstep, voffB); PG8_STAGE(PG8_SA(0, 1), cA + hstepA, voffA);
        if (wr == 1) PG8_BAR;
        PG8_WAIT_V(4); PG8_BAR;
        PG8_STAGE(PG8_SB(1, 0), cB + kstep, voffB); PG8_STAGE(PG8_SA(1, 0), cA + kstep, voffA); PG8_STAGE(PG8_SB(1, 1), cB + hstep + kstep, voffB);
        PG8_WAIT_V(6); PG8_BAR;
    }
    for (;;) {
        const bool has_next = S.next(ui + 1, nxt);
        const char* nA = has_next ? (const char*)g.A + (size_t)nxt.pm * tstepA : cA; const char* nB = has_next ? (const char*)g.Bt + (size_t)nxt.pn * tstep : cB;
        for (int t = 0; t < nt; t += 2) {
            const bool last = (t == nt - 2);
            const char* a1 = cA + (size_t)(t + 1) * kstep;
            const char* a2 = last ? nA : cA + (size_t)(t + 2) * kstep; const char* b2 = last ? nB : cB + (size_t)(t + 2) * kstep;
            const char* a3 = a2 + kstep; const char* b3 = b2 + kstep;
            if (last && has_next) S.a_ready(nxt);
            if constexpr (SP2) {
            PG8_LDB(B0, 0, 0); PG8_LDB(B1, 0, 1); PG8_SCHED; PG8_LDA(At, 0, 0); PG8_STAGE(PG8_SA(1, 1), a1 + hstepA, voffA);
            PG8_WAIT_V(8); PG8_WAIT_L(0); PG8_BAR; PG8_MMA(0, 0, At, B0); PG8_MMA(0, 1, At, B1); PG8_BAR; PG8_SCHED;
            PG8_LDA(At, 0, 1); PG8_STAGE(PG8_SB(0, 0), b2, voffB); PG8_STAGE(PG8_SB(0, 1), b2 + hstep, voffB); PG8_STAGE(PG8_SA(0, 0), a2, voffA);
            PG8_WAIT_V(8); PG8_WAIT_L(0); PG8_BAR; PG8_MMA(1, 0, At, B0); PG8_MMA(1, 1, At, B1); PG8_BAR; PG8_SCHED;
            PG8_LDB(B0, 1, 0); PG8_LDB(B1, 1, 1); PG8_SCHED; PG8_LDA(At, 1, 0); PG8_STAGE(PG8_SA(0, 1), a2 + hstepA, voffA);
            PG8_WAIT_V(8); PG8_WAIT_L(0); PG8_BAR; PG8_MMA(0, 0, At, B0); PG8_MMA(0, 1, At, B1); PG8_BAR; PG8_SCHED;
            PG8_LDA(At, 1, 1); PG8_STAGE(PG8_SB(1, 0), b3, voffB); PG8_STAGE(PG8_SB(1, 1), b3 + hstep, voffB); PG8_STAGE(PG8_SA(1, 0), a3, voffA);
            PG8_WAIT_V(8); PG8_WAIT_L(0); PG8_BAR; PG8_MMA(1, 0, At, B0); PG8_MMA(1, 1, At, B1); PG8_BAR; PG8_SCHED;
            } else {
            PG8_LDB(B0, 0, 0); PG8_SCHED; PG8_LDA(At, 0, 0); PG8_STAGE(PG8_SA(1, 1), a1 + hstepA, voffA);
            PG8_WAIT_L(8); PG8_BAR; PG8_WAIT_L(0); PG8_MMA(0, 0, At, B0); PG8_BAR; PG8_SCHED;
            PG8_LDB(B1, 0, 1); PG8_STAGE(PG8_SB(0, 0), b2, voffB);
            PG8_BAR; PG8_WAIT_L(0); PG8_MMA(0, 1, At, B1); PG8_BAR;
            PG8_LDA(At, 0, 1); PG8_STAGE(PG8_SA(0, 0), a2, voffA);
            PG8_BAR; PG8_WAIT_L(0); PG8_MMA(1, 0, At, B0); PG8_BAR; PG8_SCHED;
            PG8_STAGE(PG8_SB(0, 1), b2 + hstep, voffB);
            PG8_WAIT_V(6); PG8_BAR; PG8_MMA(1, 1, At, B1); PG8_BAR;
            PG8_LDB(B0, 1, 0); PG8_SCHED; PG8_LDA(At, 1, 0); PG8_STAGE(PG8_SA(0, 1), a2 + hstepA, voffA);
            PG8_WAIT_L(8); PG8_BAR; PG8_WAIT_L(0); PG8_MMA(0, 0, At, B0); PG8_BAR; PG8_SCHED;
            PG8_LDB(B1, 1, 1); PG8_STAGE(PG8_SB(1, 0), b3, voffB);
            PG8_BAR; PG8_WAIT_L(0); PG8_MMA(0, 1, At, B1); PG8_BAR;
            PG8_LDA(At, 1, 1); PG8_STAGE(PG8_SA(1, 0), a3, voffA);
            PG8_BAR; PG8_WAIT_L(0); PG8_MMA(1, 0, At, B0); PG8_BAR; PG8_SCHED;
            PG8_STAGE(PG8_SB(1, 1), b3 + hstep, voffB);
            PG8_WAIT_V(6); PG8_BAR; PG8_MMA(1, 1, At, B1); PG8_BAR;
            }
        }
        if constexpr (ALIGN_EPI) { if (wr == 0) PG8_BAR; }
        if constexpr (!Epi::AFTER_DRAIN) { E(acc, cur, wr, wc, fr, fq); S.done(cur); }
        if (!has_next) break;
#pragma unroll
        for (int a = 0; a < 2; ++a)
#pragma unroll
            for (int b = 0; b < 2; ++b)
#pragma unroll
                for (int m = 0; m < 4; ++m)
#pragma unroll
                    for (int n = 0; n < 2; ++n) acc[a][b][m][n] = (f32x4){0.f, 0.f, 0.f, 0.f};
        cur = nxt; cA = nA; cB = nB; ++ui;
        if constexpr (ALIGN_EPI) { if (wr == 1) PG8_BAR; }
    }
    PG8_WAIT_V(0);
    if constexpr (!ALIGN_EPI) { if (wr == 0) PG8_BAR; }
    PG8_BAR;
    if constexpr (Epi::AFTER_DRAIN) { E.fused(acc, cur, wr, wc, fr, fq, lds, wid, lane); S.done(cur); }
#undef PG8_SA
#undef PG8_SB
#undef PG8_STAGE
#undef PG8_LDA
#undef PG8_LDB
#undef PG8_MMA
#undef PG8_WAIT_V
#undef PG8_WAIT_L
#undef PG8_BAR
#undef PG8_SCHED
}
}
namespace att {
using bf16 = __hip_bfloat16;
constexpr int   D = 128, NW = 8, QBLK = 32, KVBLK = 64;
constexpr float SCALE = 0.088388347648318440f;
constexpr float THR = 8.f;
constexpr int SDEPTH = 2;
constexpr size_t SHM_V = KVBLK * D * 2, SHM_K = KVBLK * D * 2, SHM_ATTN = 3 * SHM_V + 3 * SHM_K + NW * 64 * 4;
using bf16x8 = __attribute__((ext_vector_type(8))) short;
using s16x4  = __attribute__((ext_vector_type(4))) short;
using f32x16 = __attribute__((ext_vector_type(16))) float;
using f32x8  = __attribute__((ext_vector_type(8))) float;
using u32x4  = __attribute__((ext_vector_type(4))) unsigned;
#define KSWZ(row, colB) ((row) * 256 + ((colB) ^ (((row) & 7) << 4)))
#define SBAR() __builtin_amdgcn_sched_barrier(0)
__device__ __forceinline__ int crow(int r, int hi) { return (r & 3) + 8 * (r >> 2) + 4 * hi; }
__device__ __forceinline__ unsigned cvtpk(float lo, float hi) {
  unsigned r; asm volatile("v_cvt_pk_bf16_f32 %0, %1, %2" : "=v"(r) : "v"(lo), "v"(hi)); return r;
}
struct StageB { using T = bf16x8;
  __device__ static __forceinline__ T ld8(const bf16* p) { return *reinterpret_cast<const bf16x8*>(p); }
  __device__ static __forceinline__ bf16x8 tobf(T x) { return x; } };

__device__ __forceinline__ void partialSM(f32x16& p0, f32x16& p1, float& m_reg, float& mn, float& alpha) {
  constexpr float C = SCALE * 1.4426950408889634f;
  float pmax = p0[0]; for (int r = 1; r < 16; ++r) pmax = fmaxf(pmax, p0[r]); for (int r = 0; r < 16; ++r) pmax = fmaxf(pmax, p1[r]);
  { auto rr = __builtin_amdgcn_permlane32_swap(__float_as_uint(pmax), __float_as_uint(pmax), false, false);
    pmax = fmaxf(__uint_as_float(rr[0]), __uint_as_float(rr[1])); }
  if (__builtin_expect(__all(pmax - m_reg <= THR / SCALE), 1)) { mn = m_reg; alpha = 1.f; }
  else { mn = fmaxf(m_reg, pmax); alpha = __builtin_amdgcn_exp2f((m_reg - mn) * C); m_reg = mn; }
  float mnC = -mn * C;
  for (int r = 0; r < 16; ++r) p0[r] = fmaf(p0[r], C, mnC); for (int r = 0; r < 16; ++r) p1[r] = fmaf(p1[r], C, mnC);
  for (int r = 0; r < 16; ++r) p0[r] = __builtin_amdgcn_exp2f(p0[r]);
}
__device__ __forceinline__ void finishSM(f32x16& p0, f32x16& p1, float alpha, float& l_reg, bf16x8& pa0, bf16x8& pa1, bf16x8& pa2, bf16x8& pa3) {
  for (int r = 0; r < 16; ++r) p1[r] = __builtin_amdgcn_exp2f(p1[r]);
  float ps = 0; for (int r = 0; r < 16; ++r) ps += p0[r]; for (int r = 0; r < 16; ++r) ps += p1[r];
  { auto rr = __builtin_amdgcn_permlane32_swap(__float_as_uint(ps), __float_as_uint(ps), false, false);
    ps = __uint_as_float(rr[0]) + __uint_as_float(rr[1]); }
  l_reg = l_reg * alpha + ps;
#define PK4(P, BASE, OUT) do { unsigned a0 = cvtpk(P[BASE + 0], P[BASE + 1]), a1 = cvtpk(P[BASE + 2], P[BASE + 3]);   \
    unsigned b0 = cvtpk(P[BASE + 4], P[BASE + 5]), b1 = cvtpk(P[BASE + 6], P[BASE + 7]);                              \
    auto r0 = __builtin_amdgcn_permlane32_swap(a0, b0, false, false); auto r1 = __builtin_amdgcn_permlane32_swap(a1, b1, false, false); \
    u32x4 w = {r0[0], r1[0], r0[1], r1[1]}; OUT = *reinterpret_cast<bf16x8*>(&w); } while (0)
  PK4(p0, 0, pa0); PK4(p0, 8, pa1); PK4(p1, 0, pa2); PK4(p1, 8, pa3);
#undef PK4
}
__device__ __forceinline__ void qkt(f32x16& p0, f32x16& p1, const bf16* Ks, const bf16x8* qr, int r32, int hi) {
  p0 = f32x16{}; p1 = f32x16{};
  for (int d0 = 0; d0 < 8; ++d0) { int cb = (d0 * 16 + hi * 8) * 2;
    bf16x8 b0 = *reinterpret_cast<const bf16x8*>((const char*)Ks + KSWZ(r32, cb));
    bf16x8 b1 = *reinterpret_cast<const bf16x8*>((const char*)Ks + KSWZ(32 + r32, cb));
    p0 = __builtin_amdgcn_mfma_f32_32x32x16_bf16(b0, qr[d0], p0, 0, 0, 0);
    p1 = __builtin_amdgcn_mfma_f32_32x32x16_bf16(b1, qr[d0], p1, 0, 0, 0); }
}
__device__ __forceinline__ int v_st(int k, int c) { const int kk = (k & ~0xC) | ((k & 4) << 1) | ((k & 8) >> 1); return ((kk >> 3) * 4 + (c >> 5)) * 512 + ((kk & 7) * 32 + (c & 31)) * 2; }
__device__ __forceinline__ int v_rd_base(int lane) { return ((lane & 3) << 3) | (((lane >> 2) & 3) << 6) | (((lane >> 4) & 1) << 5) | (((lane >> 5) & 1) << 8); }
constexpr int v_rd_off(int d0, int ks, int half) { return d0 * 512 + ks * 4096 + half * 2048; }
template <int OFF> __device__ __forceinline__ s16x4 tr_read(int vb) {
  s16x4 r; asm volatile("ds_read_b64_tr_b16 %0, %1 offset:%2" : "=&v"(r) : "v"(vb), "i"(OFF) : "memory"); return r;
}
template <int D0> __device__ __forceinline__ void pv_one(f32x16& od, int vb, bf16x8 pa0, bf16x8 pa1, bf16x8 pa2, bf16x8 pa3) {
  const s16x4 l0 = tr_read<v_rd_off(D0, 0, 0)>(vb), h0 = tr_read<v_rd_off(D0, 0, 1)>(vb), l1 = tr_read<v_rd_off(D0, 1, 0)>(vb), h1 = tr_read<v_rd_off(D0, 1, 1)>(vb);
  const s16x4 l2 = tr_read<v_rd_off(D0, 2, 0)>(vb), h2 = tr_read<v_rd_off(D0, 2, 1)>(vb), l3 = tr_read<v_rd_off(D0, 3, 0)>(vb), h3 = tr_read<v_rd_off(D0, 3, 1)>(vb);
  asm volatile("s_waitcnt lgkmcnt(0)" ::: "memory"); SBAR();
#define PK(L, H) (bf16x8){L[0], L[1], L[2], L[3], H[0], H[1], H[2], H[3]}
  od = __builtin_amdgcn_mfma_f32_32x32x16_bf16(pa0, PK(l0, h0), od, 0, 0, 0);
  od = __builtin_amdgcn_mfma_f32_32x32x16_bf16(pa1, PK(l1, h1), od, 0, 0, 0);
  od = __builtin_amdgcn_mfma_f32_32x32x16_bf16(pa2, PK(l2, h2), od, 0, 0, 0);
  od = __builtin_amdgcn_mfma_f32_32x32x16_bf16(pa3, PK(l3, h3), od, 0, 0, 0);
#undef PK
}
__device__ __forceinline__ void pv_d0(f32x16* o, int vb, bf16x8 pa0, bf16x8 pa1, bf16x8 pa2, bf16x8 pa3) {
  pv_one<0>(o[0], vb, pa0, pa1, pa2, pa3); pv_one<1>(o[1], vb, pa0, pa1, pa2, pa3); pv_one<2>(o[2], vb, pa0, pa1, pa2, pa3); pv_one<3>(o[3], vb, pa0, pa1, pa2, pa3);
}

using f32x4a = __attribute__((ext_vector_type(4))) float;
template <int LDQ, int LDK, int LDO, int VOFF, bool QNORM = false>
__device__ __forceinline__ void attn_dense_body(const bf16* Qb, const bf16* __restrict__ Kh,
                                                bf16* Ob, int seq, char* lds, const int wave_, const float* rope = nullptr, const float* qw = nullptr, int t0 = 0) {
  using St = StageB; using SQ = StageB;
  const int wid = wave_, lane = lane_id_(), tid = wid * 64 + lane, r32 = lane & 31, hi = lane >> 5;
  bf16* V_lds = (bf16*)lds; bf16* K_lds = (bf16*)(lds + 3 * SHM_V);
  float* ws = (float*)(lds + 3 * SHM_V + 3 * SHM_K) + wid * 64; float* li_l = ws; float* al_l = ws + 32;
  float m_reg = -1e30f, l_reg = 0; f32x16 o[4] = {}; bf16x8 qr[8];
  const bf16* Qw = Qb + (long)(wid * QBLK + r32) * LDQ + hi * 8;
#pragma unroll
  for (int d0 = 0; d0 < 8; ++d0) qr[d0] = SQ::tobf(SQ::ld8(Qw + d0 * 16));
  if constexpr (QNORM) {
    float x[8][8]; float ss = 0.f;
#pragma unroll
    for (int d0 = 0; d0 < 8; ++d0)
#pragma unroll
      for (int j = 0; j < 8; ++j) { x[d0][j] = __uint_as_float((unsigned)(unsigned short)qr[d0][j] << 16); ss += x[d0][j] * x[d0][j]; }
    { auto rr = __builtin_amdgcn_permlane32_swap(__float_as_uint(ss), __float_as_uint(ss), false, false); ss = __uint_as_float(rr[0]) + __uint_as_float(rr[1]); }
    const float rs = 1.0f / sqrtf(ss * (1.0f / 128.0f) + 1e-6f);
#pragma unroll
    for (int d0 = 0; d0 < 8; ++d0) { const f32x4a w0 = *(const f32x4a*)(qw + d0 * 16 + hi * 8), w1 = *(const f32x4a*)(qw + d0 * 16 + hi * 8 + 4);
#pragma unroll
      for (int j = 0; j < 4; ++j) { x[d0][j] = x[d0][j] * rs * w0[j]; x[d0][4 + j] = x[d0][4 + j] * rs * w1[j]; } }
    const int t = t0 + wid * QBLK + r32;
#pragma unroll
    for (int hf = 0; hf < 2; ++hf) { const int pos = hf ? (t & 63) : (t >> 6);
#pragma unroll
      for (int db = 0; db < 2; ++db) { const int a = hf * 4 + db, b = a + 2; const float* tp = rope + (size_t)(pos * 32 + db * 16 + hi * 8) * 2;
#pragma unroll
        for (int j2 = 0; j2 < 4; ++j2) { const f32x4a cs = *(const f32x4a*)(tp + 4 * j2);
          const float xa0 = x[a][2 * j2], xb0 = x[b][2 * j2], xa1 = x[a][2 * j2 + 1], xb1 = x[b][2 * j2 + 1];
          x[a][2 * j2] = xa0 * cs[0] - xb0 * cs[1]; x[b][2 * j2] = xb0 * cs[0] + xa0 * cs[1];
          x[a][2 * j2 + 1] = xa1 * cs[2] - xb1 * cs[3]; x[b][2 * j2 + 1] = xb1 * cs[2] + xa1 * cs[3]; } } }
#pragma unroll
    for (int d0 = 0; d0 < 8; ++d0) { u32x4 w = {cvtpk(x[d0][0], x[d0][1]), cvtpk(x[d0][2], x[d0][3]), cvtpk(x[d0][4], x[d0][5]), cvtpk(x[d0][6], x[d0][7])}; qr[d0] = *reinterpret_cast<bf16x8*>(&w); }
  }
  const int sr = tid >> 4, sc = (tid & 15) * 8, vst0 = v_st(sr, sc), vst1 = v_st(32 + sr, sc);
  const int vb0 = (int)(uintptr_t)V_lds + v_rd_base(lane);
  struct { typename St::T vs0, vs1, ks0, ks1; } sr_[SDEPTH];
  const unsigned kvo0 = (unsigned)(sr * LDK + sc) * 2u, kvo1 = kvo0 + 32u * LDK * 2u;
#define SLOAD(i, k0) do { const char* kb_ = (const char*)Kh + (size_t)(k0) * (LDK * 2); \
    sr_[i].vs0 = *(const bf16x8*)(kb_ + kvo0 + VOFF * 2); sr_[i].vs1 = *(const bf16x8*)(kb_ + kvo1 + VOFF * 2); \
    sr_[i].ks0 = *(const bf16x8*)(kb_ + kvo0); sr_[i].ks1 = *(const bf16x8*)(kb_ + kvo1); } while (0)
#define SWRITE(b, i) do { *(bf16x8*)((char*)V_lds + (b) * SHM_V + vst0) = St::tobf(sr_[i].vs0);          \
    *(bf16x8*)((char*)V_lds + (b) * SHM_V + vst1) = St::tobf(sr_[i].vs1); int kc = sc * 2;               \
    *(bf16x8*)((char*)K_lds + (b) * SHM_K + KSWZ(sr, kc)) = St::tobf(sr_[i].ks0);                       \
    *(bf16x8*)((char*)K_lds + (b) * SHM_K + KSWZ(32 + sr, kc)) = St::tobf(sr_[i].ks1); } while (0)
#define SWAIT() do { if constexpr (SDEPTH == 2) asm volatile("s_waitcnt vmcnt(4)" ::: "memory"); else asm volatile("s_waitcnt vmcnt(0)" ::: "memory"); } while (0)
#define RESC(a) do { if (__any((a) < 1.f)) { if (hi == 0) al_l[r32] = (a); asm volatile("s_waitcnt lgkmcnt(0)" ::: "memory"); \
    for (int d = 0; d < 4; ++d) for (int r = 0; r < 16; ++r) o[d][r] *= al_l[crow(r, hi)]; } } while (0)
  f32x16 pA0, pA1, pB0, pB1; float mnA, mnB, alA, alB; bf16x8 pa0, pa1, pa2, pa3; const int NT = seq / KVBLK;
  constexpr int SE = 0, SO = SDEPTH - 1;
  SLOAD(SE, 0); asm volatile("s_waitcnt vmcnt(0)" ::: "memory"); SWRITE(0, SE); __syncthreads();
  qkt(pA0, pA1, K_lds, qr, r32, hi); partialSM(pA0, pA1, m_reg, mnA, alA);
  SLOAD(SO, KVBLK); if constexpr (SDEPTH == 2) { if (2 < NT) SLOAD(SE, 2 * KVBLK); }
  SWAIT(); SWRITE(1, SO);
  int sp = 0, scu = 1, sn = 2;
#define ROT3() do { const int t_ = sp; sp = scu; scu = sn; sn = t_; } while (0)
  for (int j = 1; j + 1 < NT; j += 2) {
    __syncthreads();
    SBAR(); qkt(pB0, pB1, (bf16*)((char*)K_lds + scu * SHM_K), qr, r32, hi);
    finishSM(pA0, pA1, alA, l_reg, pa0, pa1, pa2, pa3); SBAR();
    SLOAD(SO, (j + SDEPTH) * KVBLK); SBAR();
    pv_d0(o, vb0 + sp * (int)SHM_V, pa0, pa1, pa2, pa3); partialSM(pB0, pB1, m_reg, mnB, alB);
    SWAIT(); SWRITE(sn, SE);
    RESC(alB); ROT3();
    __syncthreads();
    SBAR(); qkt(pA0, pA1, (bf16*)((char*)K_lds + scu * SHM_K), qr, r32, hi);
    finishSM(pB0, pB1, alB, l_reg, pa0, pa1, pa2, pa3); SBAR();
    if (SDEPTH == 1 || j + 3 < NT) SLOAD(SE, (j + 1 + SDEPTH) * KVBLK); SBAR();
    pv_d0(o, vb0 + sp * (int)SHM_V, pa0, pa1, pa2, pa3); partialSM(pA0, pA1, m_reg, mnA, alA);
    SWAIT(); SWRITE(sn, SO);
    RESC(alA); ROT3();
  }
  __syncthreads();
  SBAR(); qkt(pB0, pB1, (bf16*)((char*)K_lds + scu * SHM_K), qr, r32, hi);
  finishSM(pA0, pA1, alA, l_reg, pa0, pa1, pa2, pa3); SBAR();
  pv_d0(o, vb0 + sp * (int)SHM_V, pa0, pa1, pa2, pa3); partialSM(pB0, pB1, m_reg, mnB, alB);
  RESC(alB);
  finishSM(pB0, pB1, alB, l_reg, pa0, pa1, pa2, pa3); SBAR();
  pv_d0(o, vb0 + scu * (int)SHM_V, pa0, pa1, pa2, pa3);
#undef ROT3
  if (hi == 0) li_l[r32] = l_reg; asm volatile("s_waitcnt lgkmcnt(0)" ::: "memory");
  float rli[16];
#pragma unroll
  for (int r = 0; r < 16; ++r) rli[r] = __builtin_amdgcn_rcpf(li_l[crow(r, hi)]);
  unsigned short* Ow = (unsigned short*)Ob + (long)(wid * QBLK) * LDO;
  int hi_o = hi, r32_o = r32; asm volatile("" : "+v"(hi_o), "+v"(r32_o));
  const unsigned lane_off = (unsigned)(4 * hi_o * LDO + r32_o);
#pragma unroll
  for (int r = 0; r < 16; ++r) {
#pragma unroll
    for (int d0 = 0; d0 < 4; ++d0) Ow[lane_off + (unsigned)(((r & 3) + 8 * (r >> 2)) * LDO + d0 * 32)] = (unsigned short)(cvtpk(o[d0][r] * rli[r], 0.f) & 0xffffu); }
#undef SLOAD
#undef SWRITE
#undef SWAIT
#undef RESC
}

}
constexpr int BATCH = 2, SEQ = 8192, DM = 2048, M = BATCH * SEQ, INW = 5632, DFF = 8192, CWID = 512, MEMT = 256, MROWS = BATCH * MEMT;
constexpr int C_RQ = 0, C_RK = 1024, C_RV = 2048, C_RG = 3072, C_AQ = 4096, C_AK = 5120, C_AV = 5376;
constexpr int NCH = 64;
constexpr int DEF_C0 = 3584, DEF_W = 512;
constexpr float EPS = 1e-6f;
constexpr int NWAVES = 8;
constexpr size_t MiB = 1u << 20;
constexpr size_t WS_ROPE = 0;
constexpr size_t WS_CTL = 512 * 1024, CTL_ZERO_BYTES = 16384;
constexpr size_t WS_SS1 = 1 * MiB, WS_SS2 = 3 * MiB, WS_SS3 = 5 * MiB;
constexpr size_t WS_KVC = 7 * MiB;
constexpr size_t WS_WIN = 8 * MiB, WS_WOUT = 30 * MiB, WS_WQ = 38 * MiB, WS_WKV = 40 * MiB, WS_WO = 44 * MiB, WS_WUP = 46 * MiB, WS_WDN = 78 * MiB;
constexpr size_t WS_XN = 110 * MiB;
constexpr size_t WS_MN = 174 * MiB;
constexpr size_t WS_PROJ = 176 * MiB;
constexpr size_t WS_VT = 352 * MiB;
constexpr size_t WS_ST = 384 * MiB;
constexpr size_t WS_QC = 448 * MiB;
constexpr size_t WS_U = 176 * MiB;
constexpr size_t WS_END = 464 * MiB;
static_assert(WS_U + (size_t)M * DFF * 2 <= WS_QC, "U overlay");
constexpr int LDS_BYTES = 147456;
constexpr int LDT = 136, TILE_B = 128 * LDT * 2;
constexpr int RED_OFF = 4 * TILE_B;
constexpr int MISC_OFF = LDS_BYTES - 64;
static_assert(MISC_OFF + 16 <= LDS_BYTES && RED_OFF + 4096 <= MISC_OFF && 7 * 18432 + 64 * 65 * 4 <= MISC_OFF, "LDS map");

#define LAS __attribute__((address_space(3)))
typedef unsigned short bf16;
typedef unsigned v4u __attribute__((ext_vector_type(4)));
typedef unsigned v2u __attribute__((ext_vector_type(2)));
typedef float f32x4 __attribute__((ext_vector_type(4)));
typedef float f32x2 __attribute__((ext_vector_type(2)));
typedef short bf16x8 __attribute__((ext_vector_type(8)));
#define LDS_WAIT() asm volatile("s_waitcnt lgkmcnt(0)" ::: "memory")
__device__ __forceinline__ unsigned f2bf(float f) { unsigned u = __builtin_bit_cast(unsigned, f); return (u + 0x7fffu + ((u >> 16) & 1u)) >> 16; }
__device__ __forceinline__ unsigned pk2(float lo, float hi) { return f2bf(lo) | (f2bf(hi) << 16); }
__device__ __forceinline__ float bflo(unsigned w) { return __uint_as_float(w << 16); }
__device__ __forceinline__ float bfhi(unsigned w) { return __uint_as_float(w & 0xffff0000u); }
__device__ __forceinline__ float bf1(unsigned short h) { return __uint_as_float((unsigned)h << 16); }
__device__ __forceinline__ float wave_sum(float v) {
#pragma unroll
    for (int o = 1; o < 64; o <<= 1) v += __shfl_xor(v, o);
    return v;
}

#define XB_TMO      128
#define XB_XCNT(j)  (256  + 64 * (j))
#define XB_XSUB(j)  (1280 + 64 * (j))
#define XB_XGEN(j)  (2304 + 64 * (j))
#define XB_TOP      3328
#define XB_TOPGEN   3392
#define XCD_BAR_WORDS 3456
#define XB_SPIN_CAP (1u << 18)

__device__ __forceinline__ unsigned xb_ld(unsigned* p)              { return __hip_atomic_load(p, __ATOMIC_RELAXED, __HIP_MEMORY_SCOPE_AGENT); }
__device__ __forceinline__ unsigned xb_add(unsigned* p, unsigned v) { return __hip_atomic_fetch_add(p, v, __ATOMIC_RELAXED, __HIP_MEMORY_SCOPE_AGENT); }
__device__ __forceinline__ unsigned xb_xcc_id() { return (unsigned)__builtin_amdgcn_s_getreg((3 << 11) | 20) & 0xFu; }
#define XB_SPIN(cond, bar) do { unsigned _sp = 0; while (cond) { __builtin_amdgcn_s_sleep(1); \
    if ((++_sp & 255u) == 0u) { if (xb_ld(&(bar)[XB_TMO])) break; if (_sp > XB_SPIN_CAP) { atomicAdd(&(bar)[XB_TMO], 1u); break; } } } } while (0)

struct XcdBarrier {
    unsigned* bar; unsigned x;
    volatile LAS unsigned* st;
};

__device__ __forceinline__ XcdBarrier xcd_barrier_post(unsigned* bar, volatile LAS unsigned* st, const bool t0_) {
    XcdBarrier b; b.bar = bar; b.x = xb_xcc_id(); b.st = st;
    if (t0_) (void)xb_add(&bar[XB_XCNT(b.x)], 1u);
    return b;
}
__device__ __forceinline__ void xcd_barrier_complete(unsigned* bar, unsigned x, unsigned& nloc, unsigned& nx) {
    const unsigned G = gridDim.x * gridDim.y * gridDim.z;
    unsigned sum, cnt, mine, sp = 0u;
    for (;;) {
        sum = 0u; cnt = 0u; mine = 0u;
#pragma unroll
        for (unsigned j = 0; j < 16; ++j) { const unsigned c = xb_ld(&bar[XB_XCNT(j)]); sum += c; cnt += (c > 0u) ? 1u : 0u; mine = (j == x) ? c : mine; }
        if (sum == G) break;
        __builtin_amdgcn_s_sleep(1);
        if ((++sp & 255u) == 0u) { if (xb_ld(&bar[XB_TMO])) break; if (sp > XB_SPIN_CAP) { atomicAdd(&bar[XB_TMO], 1u); break; } }
    }
    nloc = mine > 0u ? mine : 1u; nx = cnt > 0u ? cnt : 1u;
}

__device__ __forceinline__ void xcd_barrier(const XcdBarrier& b, const bool t0_) {
    asm volatile("s_waitcnt vmcnt(0)" ::: "memory");
    __syncthreads();
    if (t0_) {
        unsigned* bar = b.bar;
        __builtin_amdgcn_s_waitcnt(0);
        unsigned nloc = b.st[0], nx = b.st[1];
        if (nloc == 0u) { xcd_barrier_complete(bar, b.x, nloc, nx); b.st[0] = nloc; b.st[1] = nx; }
        const unsigned old = xb_add(&bar[XB_XSUB(b.x)], 1u);
        const unsigned gen = old / nloc;
        if (old + 1u == (gen + 1u) * nloc) {
            __builtin_amdgcn_fence(__ATOMIC_RELEASE, "agent");
            asm volatile("s_waitcnt vmcnt(0)" ::: "memory");
            const unsigned og = xb_add(&bar[XB_TOP], 1u);
            const unsigned tg = og / nx;
            if (og + 1u == (tg + 1u) * nx) xb_add(&bar[XB_TOPGEN], 1u);
            else XB_SPIN(xb_ld(&bar[XB_TOPGEN]) == tg, bar);
            __builtin_amdgcn_fence(__ATOMIC_ACQUIRE, "agent");
            xb_add(&bar[XB_XGEN(b.x)], 1u);
            asm volatile("s_waitcnt vmcnt(0)" ::: "memory");
        } else {
            XB_SPIN(xb_ld(&bar[XB_XGEN(b.x)]) == gen, bar);
            __builtin_amdgcn_fence(__ATOMIC_ACQUIRE, "agent");
            asm volatile("s_waitcnt vmcnt(0)" ::: "memory");
        }
    }
    __syncthreads();
}

struct Args { const float* in[21]; float* out; unsigned char* ws; int ph_lo, ph_hi, coop, pad; };

struct Frame {
    LAS unsigned char* lds; char* ldsg;
    int tid, lane, wave, vcu, G;
};

__device__ __forceinline__ void p0_transpose_item(const float* W, int K, int N, bf16* WT, int row_off, const float* gain, LAS float* scr, int item, int lane) {
    const int nblk = N / 64, kb = item / nblk, nb = item - kb * nblk, k0 = 64 * kb, n0 = 64 * nb;
    const int r4 = lane >> 4, c4 = (lane & 15) * 4;
    f32x4 v[16];
#pragma unroll
    for (int i = 0; i < 16; ++i) v[i] = __builtin_nontemporal_load((const f32x4*)(W + (size_t)(k0 + 4 * i + r4) * N + n0 + c4));
    if (gain) {
#pragma unroll
        for (int i = 0; i < 16; ++i) v[i] = v[i] * gain[k0 + 4 * i + r4]; }
#pragma unroll
    for (int i = 0; i < 16; ++i) { LAS float* d = scr + (4 * i + r4) * 65 + c4; d[0] = v[i][0]; d[1] = v[i][1]; d[2] = v[i][2]; d[3] = v[i][3]; }
    LDS_WAIT(); asm volatile("" ::: "memory");
    const int c = lane & 7, nl = lane >> 3;
#pragma unroll
    for (int j = 0; j < 8; ++j) { const int n = nl + 8 * j; const LAS float* s = scr + (8 * c) * 65 + n;
        v4u o; o.x = pk2(s[0 * 65], s[1 * 65]); o.y = pk2(s[2 * 65], s[3 * 65]); o.z = pk2(s[4 * 65], s[5 * 65]); o.w = pk2(s[6 * 65], s[7 * 65]);
        *(v4u*)(WT + (size_t)(row_off + n0 + n) * K + k0 + 8 * c) = o; }
    LDS_WAIT(); asm volatile("" ::: "memory");
}
__device__ __forceinline__ void rms_row_to_bf16(const float* xrow, const float* w, bf16* orow, int lane) {
    const f32x4* xr = (const f32x4*)xrow + lane; const f32x4* wr = (const f32x4*)w + lane;
    f32x4 v[8]; float s = 0.f;
#pragma unroll
    for (int j = 0; j < 8; ++j) { v[j] = __builtin_nontemporal_load(xr + 64 * j); s += (v[j].x * v[j].x + v[j].y * v[j].y) + (v[j].z * v[j].z + v[j].w * v[j].w); }
    const float rs = 1.0f / sqrtf(wave_sum(s) * (1.0f / 2048.0f) + EPS);
    v2u* o8 = (v2u*)orow + lane;
#pragma unroll
    for (int j = 0; j < 8; ++j) { const f32x4 g = wr[64 * j]; v2u o; o.x = pk2(v[j].x * rs * g.x, v[j].y * rs * g.y); o.y = pk2(v[j].z * rs * g.z, v[j].w * rs * g.w); o8[64 * j] = o; }
}

__device__ __forceinline__ void lds_mma128(f32x4 (&acc)[4][2], const LAS unsigned char* A, const LAS unsigned char* Bt, int wr, int wc, int fr, int fq) {
#pragma unroll
    for (int k0 = 0; k0 < 4; ++k0) {
        bf16x8 a[4], b[2];
#pragma unroll
        for (int m = 0; m < 4; ++m) a[m] = *(const LAS bf16x8*)(A + ((wr * 64 + m * 16 + fr) * LDT + k0 * 32 + fq * 8) * 2);
#pragma unroll
        for (int n = 0; n < 2; ++n) b[n] = *(const LAS bf16x8*)(Bt + ((wc * 32 + n * 16 + fr) * LDT + k0 * 32 + fq * 8) * 2);
#pragma unroll
        for (int m = 0; m < 4; ++m)
#pragma unroll
            for (int n = 0; n < 2; ++n) acc[m][n] = __builtin_amdgcn_mfma_f32_16x16x32_bf16(b[n], a[m], acc[m][n], 0, 0, 0);
    }
}
__device__ __forceinline__ void zero_acc(f32x4 (&acc)[4][2]) {
#pragma unroll
    for (int m = 0; m < 4; ++m)
#pragma unroll
        for (int n = 0; n < 2; ++n) acc[m][n] = (f32x4){0.f, 0.f, 0.f, 0.f};
}
typedef short s16x4 __attribute__((ext_vector_type(4)));
__device__ __forceinline__ unsigned tr_lane_off(int lane) { return (unsigned)((8 * (lane >> 4) + ((lane & 15) >> 2)) * (LDT * 2) + 8 * (lane & 3)); }
__device__ __forceinline__ void tr_issue(s16x4& lo, s16x4& hi, unsigned tb, int ks, int c) {
    const unsigned a = tb + (unsigned)(ks * 32 * LDT * 2 + c * 32);
    asm volatile("ds_read_b64_tr_b16 %0, %1" : "=&v"(lo) : "v"(a) : "memory");
    asm volatile("ds_read_b64_tr_b16 %0, %1 offset:1088" : "=&v"(hi) : "v"(a) : "memory");
}
#define TRPK(L, H) (bf16x8){L[0], L[1], L[2], L[3], H[0], H[1], H[2], H[3]}
__device__ __forceinline__ void lds_mma128_tt(f32x4 (&acc)[4][2], const LAS unsigned char* TA, const LAS unsigned char* TB, int wr, int wc, int lane) {
    const unsigned ta = (unsigned)(size_t)TA + tr_lane_off(lane), tb = (unsigned)(size_t)TB + tr_lane_off(lane);
#pragma unroll
    for (int k0 = 0; k0 < 4; ++k0) {
        s16x4 al[4], ah[4], bl[2], bh[2];
#pragma unroll
        for (int m = 0; m < 4; ++m) tr_issue(al[m], ah[m], ta, k0, wr * 4 + m);
#pragma unroll
        for (int n = 0; n < 2; ++n) tr_issue(bl[n], bh[n], tb, k0, wc * 2 + n);
        asm volatile("s_waitcnt lgkmcnt(0)" ::: "memory"); __builtin_amdgcn_sched_barrier(0);
#pragma unroll
        for (int m = 0; m < 4; ++m)
#pragma unroll
            for (int n = 0; n < 2; ++n) acc[m][n] = __builtin_amdgcn_mfma_f32_16x16x32_bf16(TRPK(bl[n], bh[n]), TRPK(al[m], ah[m]), acc[m][n], 0, 0, 0);
    }
}
__device__ __forceinline__ void lds_mma128_nt(f32x4 (&acc)[4][2], const LAS unsigned char* A, const LAS unsigned char* TB, int wr, int wc, int fr, int fq, int lane) {
    const unsigned tb = (unsigned)(size_t)TB + tr_lane_off(lane);
#pragma unroll
    for (int k0 = 0; k0 < 4; ++k0) {
        bf16x8 a[4]; s16x4 bl[2], bh[2];
#pragma unroll
        for (int n = 0; n < 2; ++n) tr_issue(bl[n], bh[n], tb, k0, wc * 2 + n);
#pragma unroll
        for (int m = 0; m < 4; ++m) a[m] = *(const LAS bf16x8*)(A + ((wr * 64 + m * 16 + fr) * LDT + k0 * 32 + fq * 8) * 2);
        asm volatile("s_waitcnt lgkmcnt(0)" ::: "memory"); __builtin_amdgcn_sched_barrier(0);
#pragma unroll
        for (int m = 0; m < 4; ++m)
#pragma unroll
            for (int n = 0; n < 2; ++n) acc[m][n] = __builtin_amdgcn_mfma_f32_16x16x32_bf16(TRPK(bl[n], bh[n]), a[m], acc[m][n], 0, 0, 0);
    }
}
__device__ __forceinline__ void tile_g2l(const bf16* g, size_t ld, LAS unsigned char* dst, int tid) {
    const int row = tid >> 2, seg = (tid & 3) * 32; const v4u* p = (const v4u*)(g + (size_t)row * ld + seg);
    v4u a = p[0], b = p[1], c = p[2], d = p[3];
    LAS v4u* q = (LAS v4u*)(dst + (row * LDT + seg) * 2);
    q[0] = a; q[1] = b; q[2] = c; q[3] = d;
}

__device__ __forceinline__ void tile_g2l_rope(const bf16* g, LAS unsigned char* dst, int tid, const f32x4 (&cs)[8], float sc) {
    const int r = tid >> 2, q = tid & 3, d1 = (q >> 1) * 64 + (q & 1) * 16, d2 = d1 + 32;
    const bf16* row = g + (size_t)r * INW;
    const v4u a0 = *(const v4u*)(row + d1), a1 = *(const v4u*)(row + d1 + 8), b0 = *(const v4u*)(row + d2), b1 = *(const v4u*)(row + d2 + 8);
    v4u o1[2], o2[2];
#pragma unroll
    for (int i = 0; i < 8; ++i) {
        const unsigned wa = (i < 4) ? a0[i & 3] : a1[i & 3], wb = (i < 4) ? b0[i & 3] : b1[i & 3];
        const float x1l = bflo(wa), x1h = bfhi(wa), x2l = bflo(wb), x2h = bfhi(wb);
        const float cl = cs[i][0], sl = cs[i][1], ch = cs[i][2], sh = cs[i][3];
        o1[i >> 2][i & 3] = pk2((x1l * cl - x2l * sl) * sc, (x1h * ch - x2h * sh) * sc); o2[i >> 2][i & 3] = pk2((x2l * cl + x1l * sl) * sc, (x2h * ch + x1h * sh) * sc);
    }
    LAS v4u* p = (LAS v4u*)(dst + (r * LDT + d1) * 2); p[0] = o1[0]; p[1] = o1[1];
    p = (LAS v4u*)(dst + (r * LDT + d2) * 2); p[0] = o2[0]; p[1] = o2[1];
}

__device__ __forceinline__ void ret_prep_task(const Frame& F, int task, bf16* PROJ, const f32x2* ROPE, bf16* VT, bf16* L, float lgf, float lgb, bool wb = true) {
    int tid = TID_(F.wave); asm volatile("" : "+v"(tid));
    const int b = task >> 9, h = (task >> 6) & 7, c = task & 63;
    const int r = tid >> 2, q = tid & 3, half = q >> 1, sub = q & 1;
    const int t = c * 128 + r, pos = half ? (t & 63) : (t >> 6);
    const f32x4* rp = (const f32x4*)(ROPE + pos * 32 + sub * 16);
    const int d1 = half * 64 + sub * 16, d2 = d1 + 32;
    const size_t tok = (size_t)b * SEQ + t;
    LAS unsigned char* B0 = F.lds; LAS unsigned char* B1 = F.lds + TILE_B; LAS unsigned char* B2 = F.lds + 2 * TILE_B;
    f32x4 cs[8];
#pragma unroll
    for (int i = 0; i < 8; ++i) cs[i] = rp[i];
    {
        bf16* row = PROJ + tok * INW + C_RK + h * 128;
        v4u a0 = *(const v4u*)(row + d1), a1 = *(const v4u*)(row + d1 + 8), b0 = *(const v4u*)(row + d2), b1 = *(const v4u*)(row + d2 + 8);
        const float wf = __expf(lgf * (float)(127 - r)), wb_ = __expf(lgb * (float)r);
        v4u o1[2], o2[2], f1[2], f2[2], g1[2], g2[2];
#pragma unroll
        for (int i = 0; i < 8; ++i) {
            const unsigned wa = (i < 4) ? a0[i & 3] : a1[i & 3], wb = (i < 4) ? b0[i & 3] : b1[i & 3];
            const float x1l = bflo(wa), x1h = bfhi(wa), x2l = bflo(wb), x2h = bfhi(wb);
            const float cl = cs[i][0], sl = cs[i][1], ch = cs[i][2], sh = cs[i][3];
            const float sc = 0.08838834764831845f;
            const float y1l = (x1l * cl - x2l * sl) * sc, y2l = (x2l * cl + x1l * sl) * sc, y1h = (x1h * ch - x2h * sh) * sc, y2h = (x2h * ch + x1h * sh) * sc;
            o1[i >> 2][i & 3] = pk2(y1l, y1h); o2[i >> 2][i & 3] = pk2(y2l, y2h);
            f1[i >> 2][i & 3] = pk2(y1l * wf, y1h * wf); f2[i >> 2][i & 3] = pk2(y2l * wf, y2h * wf);
            g1[i >> 2][i & 3] = pk2(y1l * wb_, y1h * wb_); g2[i >> 2][i & 3] = pk2(y2l * wb_, y2h * wb_);
        }
        { LAS v4u* p = (LAS v4u*)(B0 + (r * LDT + d1) * 2); p[0] = f1[0]; p[1] = f1[1]; p = (LAS v4u*)(B0 + (r * LDT + d2) * 2); p[0] = f2[0]; p[1] = f2[1];
          p = (LAS v4u*)(B1 + (r * LDT + d1) * 2); p[0] = g1[0]; p[1] = g1[1]; p = (LAS v4u*)(B1 + (r * LDT + d2) * 2); p[0] = g2[0]; p[1] = g2[1]; }
        (void)o1; (void)o2; (void)wb;
    }
    {
        const bf16* row = PROJ + tok * INW + C_RV + h * 128 + q * 32;
        v4u vv[4];
#pragma unroll
        for (int i = 0; i < 4; ++i) vv[i] = *(const v4u*)(row + 8 * i);
        LAS v4u* p = (LAS v4u*)(B2 + (r * LDT + q * 32) * 2);
#pragma unroll
        for (int i = 0; i < 4; ++i) p[i] = vv[i];
    }
    __syncthreads();
    const int wid = __builtin_amdgcn_readfirstlane(tid >> 6), lane = tid & 63, wr = wid >> 2, wc = wid & 3, fr = lane & 15, fq = lane >> 4;
#pragma unroll
    for (int dir = 0; dir < 2; ++dir) {
        f32x4 acc[4][2]; zero_acc(acc);
        lds_mma128_tt(acc, B2, dir ? B1 : B0, wr, wc, lane);
        bf16* Lp = L + ((size_t)(((b * 8 + h) * 2 + dir) * NCH + c)) * 16384;
#pragma unroll
        for (int m = 0; m < 4; ++m)
#pragma unroll
            for (int n = 0; n < 2; ++n) { v2u w; w.x = pk2(acc[m][n][0], acc[m][n][1]); w.y = pk2(acc[m][n][2], acc[m][n][3]);
                *(v2u*)(Lp + (wr * 64 + m * 16 + fr) * 128 + wc * 32 + n * 16 + fq * 4) = w; }
    }
    __syncthreads();
}


__device__ __forceinline__ void qknorm_task(const Frame& F, int task, bf16* PROJ, const f32x2* ROPE, const float* qnw, const float* knw, bf16* scratch = nullptr) {
    int tid = TID_(F.wave); asm volatile("" : "+v"(tid));
    const int tile = task / 10, hh = task - tile * 10;
    const int r = tid >> 2, q = tid & 3, half = q >> 1, sub = q & 1;
    const int tokg = tile * 128 + r, t = tokg & (SEQ - 1), pos = half ? (t & 63) : (t >> 6);
    const int col0 = hh < 8 ? C_AQ + hh * 128 : C_AK + (hh - 8) * 128; const float* w = hh < 8 ? qnw : knw;
    const int d1 = half * 64 + sub * 16, d2 = d1 + 32;
    bf16* row = PROJ + (size_t)tokg * INW + col0;
    const v4u a0 = *(const v4u*)(row + d1), a1 = *(const v4u*)(row + d1 + 8), b0 = *(const v4u*)(row + d2), b1 = *(const v4u*)(row + d2 + 8);
    const f32x4* rp = (const f32x4*)(ROPE + pos * 32 + sub * 16);
    f32x4 cs[8], w1[4], w2[4];
#pragma unroll
    for (int i = 0; i < 8; ++i) cs[i] = rp[i];
#pragma unroll
    for (int i = 0; i < 4; ++i) { w1[i] = *(const f32x4*)(w + d1 + 4 * i); w2[i] = *(const f32x4*)(w + d2 + 4 * i); }
    float x1[16], x2[16]; float ss = 0.f;
#pragma unroll
    for (int i = 0; i < 8; ++i) { const unsigned wa = (i < 4) ? a0[i & 3] : a1[i & 3], wb = (i < 4) ? b0[i & 3] : b1[i & 3];
        x1[2 * i] = bflo(wa); x1[2 * i + 1] = bfhi(wa); x2[2 * i] = bflo(wb); x2[2 * i + 1] = bfhi(wb);
        ss += (x1[2 * i] * x1[2 * i] + x1[2 * i + 1] * x1[2 * i + 1]) + (x2[2 * i] * x2[2 * i] + x2[2 * i + 1] * x2[2 * i + 1]); }
    ss += __shfl_xor(ss, 1); ss += __shfl_xor(ss, 2);
    const float rs = 1.0f / sqrtf(ss * (1.0f / 128.0f) + EPS);
    v4u o1[2], o2[2];
#pragma unroll
    for (int i = 0; i < 8; ++i) {
        const float x1l = x1[2 * i] * rs * w1[i >> 1][(2 * i) & 3], x1h = x1[2 * i + 1] * rs * w1[i >> 1][(2 * i + 1) & 3];
        const float x2l = x2[2 * i] * rs * w2[i >> 1][(2 * i) & 3], x2h = x2[2 * i + 1] * rs * w2[i >> 1][(2 * i + 1) & 3];
        const float cl = cs[i][0], sl = cs[i][1], ch = cs[i][2], sh = cs[i][3];
        o1[i >> 2][i & 3] = pk2(x1l * cl - x2l * sl, x1h * ch - x2h * sh); o2[i >> 2][i & 3] = pk2(x2l * cl + x1l * sl, x2h * ch + x1h * sh);
    }
    bf16* drow = scratch ? scratch + (size_t)(task & 255) * 16384 + r * 128 : row;
    *(v4u*)(drow + d1) = o1[0]; *(v4u*)(drow + d1 + 8) = o1[1]; *(v4u*)(drow + d2) = o2[0]; *(v4u*)(drow + d2 + 8) = o2[1];
}

__device__ __forceinline__ void ret_out_task(const Frame& F, int task, bf16* PROJ, const f32x2* ROPE, const bf16* ST, const float* gnw, const float* gnb, float lgf, float lgb, bf16* scratch = nullptr) {
    int tid = TID_(F.wave); asm volatile("" : "+v"(tid));
    const int b = task >> 9, h = (task >> 6) & 7, c = task & 63;
    const size_t tok0 = (size_t)b * SEQ + (size_t)c * 128;
    LAS unsigned char* B0 = F.lds; LAS unsigned char* B1 = F.lds + TILE_B; LAS unsigned char* B2 = F.lds + 2 * TILE_B; LAS unsigned char* B3 = F.lds + 3 * TILE_B;
    LAS float* red1 = (LAS float*)(F.lds + RED_OFF); LAS float* red2 = red1 + 512;
    const size_t sf = ((size_t)(((b * 8 + h) * 2 + 0) * NCH + c)) * 16384, sb = ((size_t)(((b * 8 + h) * 2 + 1) * NCH + c)) * 16384;
    {
        const int r = tid >> 2, q4 = tid & 3, t = c * 128 + r, pos = (q4 >> 1) ? (t & 63) : (t >> 6);
        const f32x4* rp = (const f32x4*)(ROPE + pos * 32 + (q4 & 1) * 16);
        f32x4 cs[8];
#pragma unroll
        for (int i = 0; i < 8; ++i) cs[i] = rp[i];
        tile_g2l_rope(PROJ + tok0 * INW + C_RQ + h * 128, B0, tid, cs, 1.0f);
        tile_g2l_rope(PROJ + tok0 * INW + C_RK + h * 128, B1, tid, cs, 0.08838834764831845f);
    }
    tile_g2l(PROJ + tok0 * INW + C_RV + h * 128, INW, B2, tid);
    tile_g2l(ST + sf, 128, B3, tid);
    v4u sbr[4];
    { const v4u* p = (const v4u*)(ST + sb + (size_t)(tid >> 2) * 128 + (tid & 3) * 32); sbr[0] = p[0]; sbr[1] = p[1]; sbr[2] = p[2]; sbr[3] = p[3]; }
    const int wid = __builtin_amdgcn_readfirstlane(tid >> 6), lane = tid & 63, wr = wid >> 2, wc = wid & 3, fr = lane & 15, fq = lane >> 4;
    v2u rgv[4][2];
#pragma unroll
    for (int m = 0; m < 4; ++m)
#pragma unroll
        for (int n = 0; n < 2; ++n) rgv[m][n] = *(const v2u*)(PROJ + (tok0 + wr * 64 + m * 16 + fr) * INW + C_RG + h * 128 + wc * 32 + n * 16 + fq * 4);
    __syncthreads();
    f32x4 accS[4][2], accO[4][2];
    zero_acc(accS); zero_acc(accO);
    lds_mma128(accS, B0, B1, wr, wc, fr, fq);
    lds_mma128(accO, B0, B3, wr, wc, fr, fq);
    __syncthreads();
#pragma unroll
    for (int m = 0; m < 4; ++m) { const int nrow = wr * 64 + m * 16 + fr; const float df = __expf(lgf * (float)(nrow + 1));
#pragma unroll
        for (int n = 0; n < 2; ++n) { const int mc0 = wc * 32 + n * 16 + fq * 4; float p[4];
#pragma unroll
            for (int j = 0; j < 4; ++j) { const int d = nrow - (mc0 + j); const float dec = __expf((float)d * (d >= 0 ? lgf : -lgb)); p[j] = accS[m][n][j] * dec; }
            v2u w; w.x = pk2(p[0], p[1]); w.y = pk2(p[2], p[3]);
            *(LAS v2u*)(B1 + (nrow * LDT + mc0) * 2) = w;
            accO[m][n] = accO[m][n] * df; } }
    { LAS v4u* q = (LAS v4u*)(B3 + ((tid >> 2) * LDT + (tid & 3) * 32) * 2); q[0] = sbr[0]; q[1] = sbr[1]; q[2] = sbr[2]; q[3] = sbr[3]; }
    __syncthreads();
    lds_mma128_nt(accO, B1, B2, wr, wc, fr, fq, lane);
    zero_acc(accS);
    lds_mma128(accS, B0, B3, wr, wc, fr, fq);
    float mean[4], rstd[4];
#pragma unroll
    for (int m = 0; m < 4; ++m) { const int nrow = wr * 64 + m * 16 + fr; const float db = __expf(lgb * (float)(128 - nrow)); float s = 0.f;
#pragma unroll
        for (int n = 0; n < 2; ++n) { accO[m][n] = accO[m][n] + accS[m][n] * db; s += (accO[m][n][0] + accO[m][n][1]) + (accO[m][n][2] + accO[m][n][3]); }
        s += __shfl_xor(s, 16); s += __shfl_xor(s, 32);
        if (fq == 0) red1[nrow * 4 + wc] = s; }
    __syncthreads();
#pragma unroll
    for (int m = 0; m < 4; ++m) { const int nrow = wr * 64 + m * 16 + fr; const f32x4 pr = *(const LAS f32x4*)(red1 + nrow * 4);
        mean[m] = ((pr[0] + pr[1]) + (pr[2] + pr[3])) * (1.0f / 128.0f); float s = 0.f;
#pragma unroll
        for (int n = 0; n < 2; ++n) { const f32x4 d = accO[m][n] - mean[m]; s += (d[0] * d[0] + d[1] * d[1]) + (d[2] * d[2] + d[3] * d[3]); }
        s += __shfl_xor(s, 16); s += __shfl_xor(s, 32);
        if (fq == 0) red2[nrow * 4 + wc] = s; }
    __syncthreads();
#pragma unroll
    for (int m = 0; m < 4; ++m) { const int nrow = wr * 64 + m * 16 + fr; const f32x4 pr = *(const LAS f32x4*)(red2 + nrow * 4);
        rstd[m] = 1.0f / sqrtf(((pr[0] + pr[1]) + (pr[2] + pr[3])) * (1.0f / 128.0f) + EPS);
        bf16* grow = PROJ + (tok0 + nrow) * INW + C_RG + h * 128;
#pragma unroll
        for (int n = 0; n < 2; ++n) { const int col = wc * 32 + n * 16 + fq * 4;
            const f32x4 gw = *(const f32x4*)(gnw + h * 128 + col), gb = *(const f32x4*)(gnb + h * 128 + col);
            const v2u gv = rgv[m][n];
            const float g0 = bflo(gv.x), g1 = bfhi(gv.x), g2 = bflo(gv.y), g3 = bfhi(gv.y);
            const f32x4 y = (accO[m][n] - mean[m]) * rstd[m] * gw + gb;
            const float o0 = y[0] * g0 / (1.0f + __expf(-g0)), o1 = y[1] * g1 / (1.0f + __expf(-g1)), o2 = y[2] * g2 / (1.0f + __expf(-g2)), o3 = y[3] * g3 / (1.0f + __expf(-g3));
            v2u w; w.x = pk2(o0, o1); w.y = pk2(o2, o3); bf16* dst = scratch ? scratch + (size_t)(task & 255) * 16384 + nrow * 128 : grow; *(v2u*)(dst + col) = w; } }
    __syncthreads();
}

__device__ __forceinline__ void scan_states(int bid, int tid, int G, const float* dec_f, const float* dec_b, const bf16* L, bf16* ST) {
        for (int e = bid * 512 + tid; e < 32 * 4096; e += G * 512) {
            const int series = e >> 12, off4 = e & 4095, dir = series & 1, h = (series >> 1) & 7;
            const float lg = -expf(dir ? dec_b[h] : dec_f[h]); const float g128 = expf(lg * 128.0f);
            const v2u* Lp = (const v2u*)(L + (size_t)series * NCH * 16384) + off4; v2u* Sp = (v2u*)(ST + (size_t)series * NCH * 16384) + off4;
            f32x4 s = (f32x4){0.f, 0.f, 0.f, 0.f};
            if (dir == 0) {
                for (int c0 = 0; c0 < NCH; c0 += 8) { v2u l[8];
#pragma unroll
                    for (int i = 0; i < 8; ++i) l[i] = Lp[(size_t)(c0 + i) * 4096];
#pragma unroll
                    for (int i = 0; i < 8; ++i) { v2u w; w.x = pk2(s[0], s[1]); w.y = pk2(s[2], s[3]); Sp[(size_t)(c0 + i) * 4096] = w; s = s * g128 + (f32x4){bflo(l[i].x), bfhi(l[i].x), bflo(l[i].y), bfhi(l[i].y)}; } }
            } else {
                for (int c0 = NCH - 8; c0 >= 0; c0 -= 8) { v2u l[8];
#pragma unroll
                    for (int i = 0; i < 8; ++i) l[i] = Lp[(size_t)(c0 + i) * 4096];
#pragma unroll
                    for (int i = 7; i >= 0; --i) { v2u w; w.x = pk2(s[0], s[1]); w.y = pk2(s[2], s[3]); Sp[(size_t)(c0 + i) * 4096] = w; s = s * g128 + (f32x4){bflo(l[i].x), bfhi(l[i].x), bflo(l[i].y), bfhi(l[i].y)}; } }
            }
        }
}

__global__ void __launch_bounds__(NWAVES * 64, 2) mega_fwd(Args args) {
    extern __shared__ __attribute__((aligned(16))) unsigned char lds[];
    cg::grid_group grid = cg::this_grid();
    Frame F;
    F.lds = (LAS unsigned char*)lds; F.ldsg = (char*)lds;
    F.wave = __builtin_amdgcn_readfirstlane((int)threadIdx.x >> 6); F.tid = 0; F.lane = 0;
    F.G = gridDim.x; { const int bx = blockIdx.x; F.vcu = (F.G % 8 == 0) ? (bx % 8) * (F.G / 8) + bx / 8 : bx; }
    unsigned char* ws = args.ws;
    const float* x = args.in[0]; const float* mem = args.in[1]; const float* norm_mix_w = args.in[2]; const float* w_in = args.in[3];
    const float* dec_f = args.in[4]; const float* dec_b = args.in[5]; const float* gnw = args.in[6]; const float* gnb = args.in[7];
    const float* qnw = args.in[8]; const float* knw = args.in[9]; const float* w_out = args.in[10]; const float* norm_cross_w = args.in[11];
    const float* norm_mem_w = args.in[12]; const float* wcq = args.in[13]; const float* wck = args.in[14]; const float* wcv = args.in[15];
    const float* wco = args.in[16]; const float* norm_mlp_w = args.in[17]; const float* w_up = args.in[18]; const float* w_dn = args.in[19];
    const float* norm_final_w = args.in[20];
    float* out = args.out;
    f32x2* ROPE = (f32x2*)(ws + WS_ROPE);
    float* SS1 = (float*)(ws + WS_SS1); float* SS2 = (float*)(ws + WS_SS2); float* SS3 = (float*)(ws + WS_SS3);
    bf16* KVC = (bf16*)(ws + WS_KVC);
    bf16* WIN = (bf16*)(ws + WS_WIN); bf16* WOUT = (bf16*)(ws + WS_WOUT); bf16* WQ = (bf16*)(ws + WS_WQ); bf16* WKV = (bf16*)(ws + WS_WKV);
    bf16* WO = (bf16*)(ws + WS_WO); bf16* WUP = (bf16*)(ws + WS_WUP); bf16* WDN = (bf16*)(ws + WS_WDN);
    bf16* XN = (bf16*)(ws + WS_XN); bf16* MN = (bf16*)(ws + WS_MN); bf16* PROJ = (bf16*)(ws + WS_PROJ); bf16* VT = (bf16*)(ws + WS_VT);
    bf16* ST = (bf16*)(ws + WS_ST); bf16* QC = (bf16*)(ws + WS_QC); bf16* U = (bf16*)(ws + WS_U);
    bf16* L = (bf16*)out;
    if (args.coop == 2) grid.sync();
    const int lo = args.ph_lo, hi = args.ph_hi;
    volatile LAS unsigned* misc = (volatile LAS unsigned*)(F.lds + MISC_OFF);
    if (TID_(F.wave) < 4) misc[TID_(F.wave)] = 0u;
    __syncthreads();
    XcdBarrier xbar; xbar.bar = (unsigned*)(ws + WS_CTL); xbar.x = 0; xbar.st = nullptr;
    if (args.coop == 1) xbar = xcd_barrier_post((unsigned*)(ws + WS_CTL), misc, TID_(F.wave) == 0);
#ifndef PH_MASK
#define PH_MASK 0xfff
#endif
#define IN(k) ((((PH_MASK) >> (k)) & 1) && lo <= (k) && (k) < hi)
#ifndef REPS
#define REPS 1
#endif
#define SEAM(k) do { if (IN(k) && IN((k) + 1)) { if (args.coop == 1) { for (int rs_ = 0; rs_ < REPS; ++rs_) xcd_barrier(xbar, TID_(F.wave) == 0); } } } while (0)
    const int gw = F.vcu * NWAVES + F.wave, NGW = F.G * NWAVES;
    const int bid = blockIdx.x, G = F.G;

#ifndef REP0
#define REP0 1
#endif
    if (IN(0)) for (int rep_ = 0; rep_ < REP0; ++rep_) {
        __syncthreads();
        LAS float* scr = (LAS float*)(F.lds + F.wave * 18432);
        constexpr int I_IN = (DM / 64) * (INW / 64), I_C = (DM / 64) * (CWID / 64);
        constexpr int NITEMS = I_IN + 2 * I_C;
        for (int it = NGW - 1 - gw; it < NITEMS; it += NGW) {
            int r = it;
            if (r < I_IN) { const int n0 = 64 * (r % (INW / 64)); const int roff = n0 < DEF_C0 ? 0 : (n0 < DEF_C0 + DEF_W ? (INW - DEF_W) - DEF_C0 : -DEF_W);
                            p0_transpose_item(w_in, DM, INW, WIN, roff, nullptr, scr, r, lane_id_()); continue; } r -= I_IN;
            if (r < I_C) { p0_transpose_item(wck, DM, CWID, WKV, 0, nullptr, scr, r, lane_id_()); continue; } r -= I_C;
            p0_transpose_item(wcv, DM, CWID, WKV, CWID, nullptr, scr, r, lane_id_());
        }
        if (G != 256) {
            constexpr int I_OUT = (DM / 64) * (DM / 64), I_CO = (CWID / 64) * (DM / 64), I_UP = (DM / 64) * (DFF / 64), I_DN = (DFF / 64) * (DM / 64);
            for (int it = gw; it < I_OUT + I_C + I_CO + I_UP + I_DN; it += NGW) {
                int r = it;
                if (r < I_OUT) { p0_transpose_item(w_out, DM, DM, WOUT, 0, nullptr, scr, r, lane_id_()); continue; } r -= I_OUT;
                if (r < I_C) { p0_transpose_item(wcq, DM, CWID, WQ, 0, norm_cross_w, scr, r, lane_id_()); continue; } r -= I_C;
                if (r < I_CO) { p0_transpose_item(wco, CWID, DM, WO, 0, nullptr, scr, r, lane_id_()); continue; } r -= I_CO;
                if (r < I_UP) { p0_transpose_item(w_up, DM, DFF, WUP, 0, norm_mlp_w, scr, r, lane_id_()); continue; } r -= I_UP;
                p0_transpose_item(w_dn, DFF, DM, WDN, 0, nullptr, scr, r, lane_id_());
            }
        }
        for (int m = gw; m < M + MROWS; m += NGW) {
            if (m < M) rms_row_to_bf16(x + (size_t)m * DM, norm_mix_w, XN + (size_t)m * DM, lane_id_());
            else rms_row_to_bf16(mem + (size_t)(m - M) * DM, norm_mem_w, MN + (size_t)(m - M) * DM, lane_id_());
        }
        for (int e = bid * 16 + TID_(F.wave); TID_(F.wave) < 16 && e < 128 * 32; e += G * 16) {
            const int pos = e >> 5, i = e & 31;
            double f = 1.0; for (int k = 0; k < i; ++k) f *= 0.7498942093324559;
            const float invf = (float)f; const float angf = (float)pos * invf; const double a = (double)angf;
            const double kk = __builtin_rint(a * 0.15915494309189535); const double r = a - kk * 6.283185307179586477;
            const double r2 = r * r; double tc = 1.0, cc = 1.0, ts = r, sn = r;
#pragma unroll
            for (int n = 1; n <= 16; ++n) { tc *= -r2 * (1.0 / (double)((2 * n - 1) * (2 * n))); cc += tc; ts *= -r2 * (1.0 / (double)((2 * n) * (2 * n + 1))); sn += ts; }
            ROPE[e] = (f32x2){(float)cc, (float)sn};
        }
    }
    SEAM(0);

#ifndef REP1
#define REP1 1
#endif
    if (IN(1)) for (int rep_ = 0; rep_ < REP1; ++rep_) {
        __syncthreads();
        { pg8::Gemm g{XN, WIN, M, INW - DEF_W, DM, DM}; pg8::StaticOrder S; S.init(M, INW - DEF_W, G, bid);
          pg8::EpiBf<0> E{PROJ, INW, nullptr, DEF_C0 / 256, DEF_W / 256};
          pg8::gemm_phase<pg8::EpiBf<0>, pg8::StaticOrder, false, true>(F.lds, g, S, E, F.wave);
#ifdef PROBE_P1X2
          __syncthreads(); pg8::gemm_phase<pg8::EpiBf<0>, pg8::StaticOrder, false, true>(F.lds, g, S, E, F.wave);
#endif
        }
    }
    SEAM(1);

    if (IN(2)) {
        const bool split = (G == 256);
        if (!split || bid < 128) {
            pg8::Gemm g{XN, WIN + (size_t)(INW - DEF_W) * DM, M, DEF_W, DM, DM}; pg8::StaticOrder S; S.init(M, DEF_W, split ? 128 : G, bid);
            pg8::EpiBf<0> E{PROJ + DEF_C0, INW, nullptr, 0, 0};
            pg8::gemm_phase<pg8::EpiBf<0>, pg8::StaticOrder, false, true>(F.lds, g, S, E, F.wave);
        }
        if (!split || (bid >= 128 && bid < 136)) {
            pg8::Gemm g{MN, WKV, MROWS, 2 * CWID, DM, DM}; pg8::StaticOrder S; S.init(MROWS, 2 * CWID, split ? 8 : G, split ? bid - 128 : bid);
            pg8::EpiBf<0> E{KVC, 2 * CWID, nullptr, 0, 0};
            pg8::gemm_phase<pg8::EpiBf<0>, pg8::StaticOrder, false, true>(F.lds, g, S, E, F.wave);
        }
        {
            const int tb = split ? bid - 136 : bid, tg = split ? 120 : G;
            if (tb >= 0) {
                __syncthreads();
                LAS float* scr = (LAS float*)(F.lds + F.wave * 18432);
                constexpr int I_OUT = (DM / 64) * (DM / 64), I_C = (DM / 64) * (CWID / 64), I_CO = (CWID / 64) * (DM / 64);
                for (int it = tb * NWAVES + F.wave; it < I_OUT + I_C + I_CO; it += tg * NWAVES) {
                    int r = it;
                    if (r < I_OUT) { p0_transpose_item(w_out, DM, DM, WOUT, 0, nullptr, scr, r, lane_id_()); continue; } r -= I_OUT;
                    if (r < I_C) { p0_transpose_item(wcq, DM, CWID, WQ, 0, norm_cross_w, scr, r, lane_id_()); continue; } r -= I_C;
                    p0_transpose_item(wco, CWID, DM, WO, 0, nullptr, scr, r, lane_id_());
                }
            }
        }
        {
            unsigned* task_ctr = (unsigned*)(ws + WS_CTL) + 3700;
            constexpr int NT_PREP = BATCH * 8 * NCH, NT_ALL = NT_PREP + (M / 128) * 2;
            for (;;) {
                __syncthreads();
                if (TID_(F.wave) == 0) misc[4] = __hip_atomic_fetch_add(task_ctr, 1u, __ATOMIC_RELAXED, __HIP_MEMORY_SCOPE_AGENT);
                __syncthreads();
                const int task = (int)misc[4];
                if (task >= NT_ALL) break;
                if (task < NT_PREP) { const int h = (task >> 6) & 7; const float lgf = -expf(dec_f[h]), lgb = -expf(dec_b[h]); ret_prep_task(F, task, PROJ, ROPE, VT, L, lgf, lgb); }
                else { const int t2 = task - NT_PREP; qknorm_task(F, (t2 >> 1) * 10 + 8 + (t2 & 1), PROJ, ROPE, qnw, knw); }
            }
        }
    }
    SEAM(2);

    if (IN(3) && args.coop != 1) { scan_states(bid, TID_(F.wave), G, dec_f, dec_b, L, ST); }
    if (args.coop != 1) SEAM(3);

    if (IN(4)) {
        unsigned* scan_cnt = (unsigned*)(ws + WS_CTL) + 3600;
        if (args.coop == 1) {
            scan_states(bid, TID_(F.wave), G, dec_f, dec_b, L, ST);
            asm volatile("s_waitcnt vmcnt(0)" ::: "memory");
            __syncthreads();
            if (TID_(F.wave) == 0) { __builtin_amdgcn_fence(__ATOMIC_RELEASE, "agent"); __hip_atomic_fetch_add(scan_cnt, 1u, __ATOMIC_RELAXED, __HIP_MEMORY_SCOPE_AGENT); }
        }
#ifdef PROBE_P4A
        for (int u = bid; u < 512; u += G) {
            const int bk = u >> 7, b = bk >> 1, kvh = bk & 1, g = (u >> 5) & 3, qb = u & 31, h = kvh * 4 + g;
            bf16* Qb = PROJ + ((size_t)b * SEQ + (size_t)qb * 256) * INW + C_AQ + h * 128;
            const bf16* Kh = PROJ + (size_t)b * SEQ * INW + C_AK + kvh * 128;
            bf16* Od = (bf16*)out + ((size_t)b * SEQ + (size_t)qb * 256) * 1024 + h * 128;
            att::attn_dense_body<INW, INW, 1024, C_AV - C_AK>((const att::bf16*)Qb, (const att::bf16*)Kh, (att::bf16*)Od, SEQ, F.ldsg, F.wave);
            __syncthreads();
        }
#endif
#ifdef PROBE_P4B
        for (int task = bid; task < BATCH * 8 * NCH; task += G) {
            const int h = (task >> 6) & 7;
            const float lgf = -expf(dec_f[h]), lgb = -expf(dec_b[h]);
            ret_out_task(F, task, PROJ, ROPE, ST, gnw, gnb, lgf, lgb, QC);
        }
#endif
#ifndef SKIP_ATT
        for (int u = bid; u < 512; u += G) {
            const int bk = u >> 7, b = bk >> 1, kvh = bk & 1, g = (u >> 5) & 3, qb = u & 31, h = kvh * 4 + g;
            bf16* Qb = PROJ + ((size_t)b * SEQ + (size_t)qb * 256) * INW + C_AQ + h * 128;
            const bf16* Kh = PROJ + (size_t)b * SEQ * INW + C_AK + kvh * 128;
            att::attn_dense_body<INW, INW, INW, C_AV - C_AK, true>((const att::bf16*)Qb, (const att::bf16*)Kh, (att::bf16*)Qb, SEQ, F.ldsg, F.wave, (const float*)ROPE, qnw, qb * 256);
            __syncthreads();
        }
#endif
#ifndef SKIP_RET
        if (args.coop == 1) {
            if (TID_(F.wave) == 0) { unsigned sp = 0; while (__hip_atomic_load(scan_cnt, __ATOMIC_RELAXED, __HIP_MEMORY_SCOPE_AGENT) < (unsigned)G && ++sp < (1u << 22)) __builtin_amdgcn_s_sleep(2);
                              __builtin_amdgcn_fence(__ATOMIC_ACQUIRE, "agent"); }
            __syncthreads();
        }
        if (args.coop == 1) {
            unsigned* out_ctr = (unsigned*)(ws + WS_CTL) + 3701;
            for (;;) {
                __syncthreads();
                if (TID_(F.wave) == 0) misc[4] = __hip_atomic_fetch_add(out_ctr, 1u, __ATOMIC_RELAXED, __HIP_MEMORY_SCOPE_AGENT);
                __syncthreads();
                const int task = (int)misc[4];
                if (task >= BATCH * 8 * NCH) break;
                const int h = (task >> 6) & 7;
                const float lgf = -expf(dec_f[h]), lgb = -expf(dec_b[h]);
                ret_out_task(F, task, PROJ, ROPE, ST, gnw, gnb, lgf, lgb);
            }
        } else
        for (int task = bid; task < BATCH * 8 * NCH; task += G) {
            const int h = (task >> 6) & 7;
            const float lgf = -expf(dec_f[h]), lgb = -expf(dec_b[h]);
            ret_out_task(F, task, PROJ, ROPE, ST, gnw, gnb, lgf, lgb);
        }
#endif
    }
    SEAM(4);

#ifndef REP5
#define REP5 1
#endif
    if (IN(5)) for (int rep_ = 0; rep_ < REP5; ++rep_) {
        __syncthreads();
        pg8::Gemm g{PROJ + C_RG, WOUT, M, DM, DM, INW}; pg8::StaticOrder S; S.init(M, DM, G, bid);
        pg8::EpiResid E{x, nullptr, nullptr, XN, SS1};
        pg8::gemm_phase<pg8::EpiResid, pg8::StaticOrder, false, true>(F.lds, g, S, E, F.wave);
    }
    SEAM(5);

#ifndef REP6
#define REP6 1
#endif
    if (IN(6)) {
        {
            pg8::Gemm g{XN, WQ, M, CWID, DM, DM}; pg8::StaticOrder S; S.init(M, CWID, G, bid);
            pg8::EpiBf<1> E{QC, CWID, SS1};
            pg8::gemm_phase<pg8::EpiBf<1>, pg8::StaticOrder, false, true>(F.lds, g, S, E, F.wave);
        }
        const bool hand = (args.coop == 1 && G == 256);
        unsigned* qflag = (unsigned*)(ws + WS_CTL) + 3800;
        if (args.coop == 1 && (!hand || bid < 128)) {
            int bx = bid; asm volatile("" : "+s"(bx));
            pg8::StaticOrder S2; S2.init(M, CWID, G, bx); pg8::Unit uq;
            if (S2.next(0, uq)) {
                asm volatile("s_waitcnt vmcnt(0)" ::: "memory");
                __syncthreads();
                if (hand && TID_(F.wave) == 0) { __builtin_amdgcn_fence(__ATOMIC_RELEASE, "agent"); asm volatile("s_waitcnt vmcnt(0)" ::: "memory"); __hip_atomic_store(qflag + bx, 1u, __ATOMIC_RELAXED, __HIP_MEMORY_SCOPE_AGENT); }
                const int b = uq.pm >> 5, qb = uq.pm & 31;
                bf16* Qb = QC + ((size_t)b * SEQ + (size_t)qb * 256) * CWID + uq.pn * 256;
                const bf16* Kh = KVC + (size_t)b * MEMT * (2 * CWID) + uq.pn * 256;
                att::attn_dense_body<CWID, 2 * CWID, CWID, CWID>((const att::bf16*)Qb, (const att::bf16*)Kh, (att::bf16*)Qb, MEMT, F.ldsg, F.wave);
                __syncthreads();
                if (!hand) {
                att::attn_dense_body<CWID, 2 * CWID, CWID, CWID>((const att::bf16*)(Qb + 128), (const att::bf16*)(Kh + 128), (att::bf16*)(Qb + 128), MEMT, F.ldsg, F.wave);
                __syncthreads();
                }
            }
        }
        if (G == 256 && bid >= 128) {
            LAS float* scr = (LAS float*)(F.lds + F.wave * 18432);
            const int w0 = (bid - 128) * NWAVES + F.wave, nw = 128 * NWAVES;
            constexpr int I_DN = (DFF / 64) * (DM / 64), I_UP = (DM / 64) * (DFF / 64);
            for (int it = w0; it < I_UP + I_DN; it += nw) {
                if (it < I_UP) p0_transpose_item(w_up, DM, DFF, WUP, 0, norm_mlp_w, scr, it, lane_id_());
                else p0_transpose_item(w_dn, DFF, DM, WDN, 0, nullptr, scr, it - I_UP, lane_id_());
            }
            if (hand) {
                int bx = bid - 128; asm volatile("" : "+s"(bx));
                pg8::StaticOrder S2; S2.init(M, CWID, G, bx); pg8::Unit uq;
                if (S2.next(0, uq)) {
                    __syncthreads();
                    if (TID_(F.wave) == 0) { unsigned sp = 0u; while (__hip_atomic_load(qflag + bx, __ATOMIC_RELAXED, __HIP_MEMORY_SCOPE_AGENT) != 1u && ++sp < (1u << 22)) __builtin_amdgcn_s_sleep(2);
                                             __builtin_amdgcn_fence(__ATOMIC_ACQUIRE, "agent"); asm volatile("s_waitcnt vmcnt(0)" ::: "memory"); }
                    __syncthreads();
                    const int b = uq.pm >> 5, qb = uq.pm & 31;
                    bf16* Qb = QC + ((size_t)b * SEQ + (size_t)qb * 256) * CWID + uq.pn * 256 + 128;
                    const bf16* Kh = KVC + (size_t)b * MEMT * (2 * CWID) + uq.pn * 256 + 128;
                    att::attn_dense_body<CWID, 2 * CWID, CWID, CWID>((const att::bf16*)Qb, (const att::bf16*)Kh, (att::bf16*)Qb, MEMT, F.ldsg, F.wave);
                    __syncthreads();
                }
            }
        }
    }
    if (args.coop != 1) SEAM(6);

    if (IN(7) && args.coop != 1) {
        for (int u = bid; u < BATCH * 4 * 32; u += G) {
            const int b = u >> 7, h = (u >> 5) & 3, qb = u & 31;
            bf16* Qb = QC + ((size_t)b * SEQ + (size_t)qb * 256) * CWID + h * 128;
            const bf16* Kh = KVC + (size_t)b * MEMT * (2 * CWID) + h * 128;
            att::attn_dense_body<CWID, 2 * CWID, CWID, CWID>((const att::bf16*)Qb, (const att::bf16*)Kh, (att::bf16*)Qb, MEMT, F.ldsg, F.wave);
            __syncthreads();
        }
    }
    SEAM(7);

    if (IN(8)) {
        pg8::Gemm g{QC, WO, M, DM, CWID, CWID}; pg8::StaticOrder S; S.init(M, DM, G, bid);
        pg8::EpiResid E{nullptr, XN, nullptr, XN, SS2};
        pg8::gemm_phase<pg8::EpiResid, pg8::StaticOrder, false, true>(F.lds, g, S, E, F.wave);
    }
    SEAM(8);

#ifdef PROBE_IDLE
    { if (TID_(F.wave) == 0) { const unsigned long long t0 = __builtin_amdgcn_s_memrealtime(); while (__builtin_amdgcn_s_memrealtime() - t0 < 20000ull) __builtin_amdgcn_s_sleep(64); } __syncthreads(); }
#endif
    if (IN(9)) {
        pg8::Gemm g{XN, WUP, M, DFF, DM, DM}; pg8::StaticOrder S; S.init(M, DFF, G, bid);
        if (G == 256) {
            LAS float* rsl = (LAS float*)(F.lds + 131072);
            pg8::Unit u0; const int t = TID_(F.wave);
            if (S.next(0, u0) && t < 256) { const f32x4* p = (const f32x4*)(SS2 + (size_t)(u0.pm * 256 + t) * 32); float a = 0.f;
#pragma unroll
                for (int i = 0; i < 8; ++i) { const f32x4 v = p[i]; a += (v[0] + v[1]) + (v[2] + v[3]); }
                rsl[t] = 1.0f / sqrtf(a * (1.0f / 2048.0f) + EPS); }
            __syncthreads();
            pg8::EpiBf<3> E{U, DFF, SS2, 0, 0, (const PG8_LAS float*)rsl};
            pg8::gemm_phase<pg8::EpiBf<3>, pg8::StaticOrder, true, true>(F.lds, g, S, E, F.wave);
        } else {
        pg8::EpiBf<2> E{U, DFF, SS2};
        pg8::gemm_phase<pg8::EpiBf<2>, pg8::StaticOrder, false, true>(F.lds, g, S, E, F.wave);
        }
#ifdef PROBE_P9X2
        __syncthreads(); pg8::gemm_phase<pg8::EpiBf<2>, pg8::StaticOrder, false, true>(F.lds, g, S, E, F.wave);
#endif
#ifdef PROBE_P9NULL
        __syncthreads(); { pg8::EpiNull EN{U}; pg8::gemm_phase<pg8::EpiNull, pg8::StaticOrder, false, true>(F.lds, g, S, EN, F.wave); }
#endif
    }
    SEAM(9);

#ifndef REP10
#define REP10 1
#endif
    if (IN(10)) for (int rep_ = 0; rep_ < REP10; ++rep_) {
        __syncthreads();
        pg8::Gemm g{U, WDN, M, DM, DFF, DFF}; pg8::StaticOrder S; S.init(M, DM, G, bid);
        pg8::EpiResid E{nullptr, XN, nullptr, XN, SS3};
        pg8::gemm_phase<pg8::EpiResid, pg8::StaticOrder, false, true>(F.lds, g, S, E, F.wave);
    }
    SEAM(10);

#ifndef REP11
#define REP11 1
#endif
    if (IN(11)) for (int rep_ = 0; rep_ < REP11; ++rep_) {
        __syncthreads();
        const f32x4* wr = (const f32x4*)norm_final_w + lane_id_();
        for (int m = gw; m < M; m += 2 * NGW) {
            const int m2 = (m + NGW < M) ? m + NGW : m;
            const float p0 = (lane_id_() < 32) ? SS3[(size_t)m * 32 + lane_id_()] : 0.f, p1 = (lane_id_() < 32) ? SS3[(size_t)m2 * 32 + lane_id_()] : 0.f;
            const v2u* xr0 = (const v2u*)(XN + (size_t)m * DM) + lane_id_(); const v2u* xr1 = (const v2u*)(XN + (size_t)m2 * DM) + lane_id_();
            v2u v0[8], v1[8];
#pragma unroll
            for (int j = 0; j < 8; ++j) { v0[j] = xr0[64 * j]; v1[j] = xr1[64 * j]; }
            const float rs0 = 1.0f / sqrtf(wave_sum(p0) * (1.0f / 2048.0f) + EPS), rs1 = 1.0f / sqrtf(wave_sum(p1) * (1.0f / 2048.0f) + EPS);
            f32x4* o0 = (f32x4*)(out + (size_t)m * DM) + lane_id_(); f32x4* o1 = (f32x4*)(out + (size_t)m2 * DM) + lane_id_();
#pragma unroll
            for (int j = 0; j < 8; ++j) { const f32x4 g = wr[64 * j];
                const f32x4 r0 = (f32x4){bflo(v0[j].x) * rs0 * g[0], bfhi(v0[j].x) * rs0 * g[1], bflo(v0[j].y) * rs0 * g[2], bfhi(v0[j].y) * rs0 * g[3]};
                const f32x4 r1 = (f32x4){bflo(v1[j].x) * rs1 * g[0], bfhi(v1[j].x) * rs1 * g[1], bflo(v1[j].y) * rs1 * g[2], bfhi(v1[j].y) * rs1 * g[3]};
                __builtin_nontemporal_store(r0, o0 + 64 * j); __builtin_nontemporal_store(r1, o1 + 64 * j); }
        }
    }
#undef IN
#undef SEAM
}

#ifndef MK_PER_PHASE
#define MK_PER_PHASE 0
#endif
constexpr int NPHASE = 12;
extern "C" void kernel_launch(void* const* d_in, const int* in_sizes, int n_in, void* d_out, int out_size, void* d_ws, size_t ws_size, hipStream_t stream) {
    static int grid = 0;
    if (grid == 0) {
        if (n_in != 21 || in_sizes[0] != M * DM || out_size != M * DM || ws_size < WS_END) {
            fprintf(stderr, "kernel_launch: unexpected shapes: n_in %d in0 %d out %d ws %zu (need >= %zu); nothing launched\n", n_in, n_in > 0 ? in_sizes[0] : -1, out_size, ws_size, (size_t)WS_END);
            grid = -1; return; }
        int dev = 0, cus = 0, per_cu = 0;
        if (hipGetDevice(&dev) != hipSuccess || hipDeviceGetAttribute(&cus, hipDeviceAttributeMultiprocessorCount, dev) != hipSuccess) { grid = -1; return; }
        if (hipFuncSetAttribute((const void*)mega_fwd, hipFuncAttributeMaxDynamicSharedMemorySize, LDS_BYTES) != hipSuccess) { fprintf(stderr, "kernel_launch: hipFuncSetAttribute failed\n"); grid = -1; return; }
        if (hipOccupancyMaxActiveBlocksPerMultiprocessor(&per_cu, (const void*)mega_fwd, NWAVES * 64, LDS_BYTES) != hipSuccess || per_cu < 1) {
            fprintf(stderr, "kernel_launch: occupancy query says %d blocks per CU\n", per_cu); per_cu = 1; }
        (void)hipGetLastError();
        grid = cus;
    }
    if (grid < 0) return;
    Args a{};
    for (int i = 0; i < 21; ++i) a.in[i] = (const float*)d_in[i];
    a.out = (float*)d_out; a.ws = (unsigned char*)d_ws;
#if MK_PER_PHASE
    for (int p = 0; p < NPHASE; ++p) { a.ph_lo = p; a.ph_hi = p + 1; a.coop = 0; hipLaunchKernelGGL(mega_fwd, dim3(grid), dim3(NWAVES * 64), LDS_BYTES, stream, a); }
#else
    if (hipMemsetAsync((char*)d_ws + WS_CTL, 0, CTL_ZERO_BYTES, stream) != hipSuccess) { fprintf(stderr, "kernel_launch: memset failed\n"); return; }
    a.ph_lo = 0; a.ph_hi = NPHASE; a.coop = 1;
    void* kargs[] = {&a};
    const hipError_t e = hipLaunchCooperativeKernel((const void*)mega_fwd, dim3(grid), dim3(NWAVES * 64), kargs, LDS_BYTES, stream);
    if (e != hipSuccess) fprintf(stderr, "kernel_launch: cooperative launch failed: %s (grid %d)\n", hipGetErrorString(e), grid);
#endif
}
```

```cpp
#include <hip/hip_runtime.h>
#include <hip/hip_bf16.h>
#include <hip/hip_cooperative_groups.h>
#include <cstdio>
#include <cstdint>
namespace cg = cooperative_groups;

__device__ __forceinline__ int lane_id_() { int l; asm volatile("v_mbcnt_lo_u32_b32 %0, -1, 0\n\tv_mbcnt_hi_u32_b32 %0, -1, %0" : "=v"(l)); return l; }
#define TID_(wave) ((wave) * 64 + lane_id_())
namespace pg8 {
#define PG8_LAS __attribute__((address_space(3)))
typedef unsigned short bf16_t;
typedef short bf16x8 __attribute__((ext_vector_type(8)));
typedef float f32x4 __attribute__((ext_vector_type(4)));
typedef unsigned u32x4 __attribute__((ext_vector_type(4)));
constexpr int BM = 256, BK = 64, HALF = 128, HTB = HALF * BK * 2  , STAGE_BYTES = 8 * HTB, NXCD = 8, WGM = 8;

__host__ __device__ __forceinline__ int lds_byte(int r, int c) { const int st = (r >> 4) * 2 + (c >> 5), rr = r & 15, cc = c & 31, ob = rr * 64 + cc * 2; return st * 1024 + (ob ^ (((ob >> 9) & 1) << 5)); }
__host__ __device__ __forceinline__ void stage_rc(int b, int& R, int& C) { const int st = b / 1024, sb = b % 1024, swz = sb ^ (((sb >> 9) & 1) << 5); R = (st >> 1) * 16 + swz / 64; C = (st & 1) * 32 + (swz % 64) / 2; }
__host__ __device__ __forceinline__ int perm32(int rho) { const int n = rho >> 4, i = rho & 15; return 8 * (i >> 2) + 4 * n + (i & 3); }

struct Unit { int pm, pn; };
struct Gemm { const bf16_t* A; const bf16_t* Bt; int M, N, K, lda; };

struct StaticOrder {
    int nM, nN, nwg, G, c;
    __host__ __device__ void init(int M, int N, int G_, int c_) { nM = M / BM; nN = N / BM; nwg = nM * nN; G = G_; c = c_; }
    __host__ __device__ __forceinline__ bool next(int i, Unit& u) const {
        const long L = (long)i * G + c; if (L >= nwg) return false;
        int wgid = (int)L; { const int q = nwg / NXCD, r = nwg % NXCD, xcd = wgid % NXCD, off = wgid / NXCD; wgid = (xcd < r ? xcd * (q + 1) : r * (q + 1) + (xcd - r) * q) + off; }
        const int nig = WGM * nN, gid = wgid / nig, fm = gid * WGM, gsz = (nM - fm) < WGM ? (nM - fm) : WGM;
        u.pm = fm + ((wgid % nig) % gsz); u.pn = (wgid % nig) / gsz; return true;
    }
    __device__ __forceinline__ void a_ready(const Unit&) const {}
    __device__ __forceinline__ void done(const Unit&) const {}
};

__device__ __forceinline__ unsigned cvt_pk_bf16(float lo, float hi) { unsigned r; asm volatile("v_cvt_pk_bf16_f32 %0, %1, %2" : "=v"(r) : "v"(lo), "v"(hi)); return r; }
__device__ __forceinline__ float row_rs(const float* ss, int row, int fq) {
    const f32x4 a = *(const f32x4*)(ss + (size_t)row * 32 + fq * 8), b = *(const f32x4*)(ss + (size_t)row * 32 + fq * 8 + 4);
    float s = ((a[0] + a[1]) + (a[2] + a[3])) + ((b[0] + b[1]) + (b[2] + b[3]));
    s += __shfl_xor(s, 16); s += __shfl_xor(s, 32);
    return 1.0f / sqrtf(s * (1.0f / 2048.0f) + 1e-6f);
}
template <int MODE> struct EpiBf {
    static constexpr bool PERM = true, AFTER_DRAIN = false;
    bf16_t* O; int ldc; const float* ss; int gap_pn, gap_add;
    const PG8_LAS float* rsl;
    __device__ __forceinline__ void operator()(const f32x4 (&acc)[2][2][4][2], const Unit& u, int wr, int wc, int fr, int fq) const {
        const int pnc = (gap_add != 0 && u.pn >= gap_pn) ? u.pn + gap_add : u.pn;
        const int row0 = u.pm * BM + wr * 64 + fr, col0 = pnc * BM + wc * 32 + 8 * fq;
        float scv[2][4];
#pragma unroll
        for (int ai = 0; ai < 2; ++ai)
#pragma unroll
            for (int m = 0; m < 4; ++m) scv[ai][m] = (MODE == 3) ? rsl[ai * HALF + wr * 64 + m * 16 + fr] : ((MODE != 0) ? row_rs(ss, row0 + ai * HALF + m * 16, fq) : 1.f);
#pragma unroll
        for (int ai = 0; ai < 2; ++ai)
#pragma unroll
            for (int m = 0; m < 4; ++m) { const int row = row0 + ai * HALF + m * 16; bf16_t* rowp = O + (size_t)row * ldc + col0;
                const float sc = scv[ai][m];
#pragma unroll
                for (int bj = 0; bj < 2; ++bj) { f32x4 v0 = acc[ai][bj][m][0] * sc, v1 = acc[ai][bj][m][1] * sc;
                    if (MODE >= 2) {
#pragma unroll
                        for (int j = 0; j < 4; ++j) { const float a = fmaxf(v0[j], 0.f), b = fmaxf(v1[j], 0.f); v0[j] = a * a; v1[j] = b * b; } }
                    u32x4 w; w.x = cvt_pk_bf16(v0[0], v0[1]); w.y = cvt_pk_bf16(v0[2], v0[3]); w.z = cvt_pk_bf16(v1[0], v1[1]); w.w = cvt_pk_bf16(v1[2], v1[3]);
                    if (MODE >= 2 || (MODE == 0 && ldc == 5632)) __builtin_nontemporal_store(w, (u32x4*)(rowp + bj * HALF)); else *(u32x4*)(rowp + bj * HALF) = w; } }
    }
};
struct EpiNull {
    static constexpr bool PERM = true, AFTER_DRAIN = false;
    bf16_t* O;
    __device__ __forceinline__ void operator()(const f32x4 (&acc)[2][2][4][2], const Unit& u, int wr, int wc, int fr, int fq) const {
        float s = 0.f;
#pragma unroll
        for (int ai = 0; ai < 2; ++ai)
#pragma unroll
            for (int bj = 0; bj < 2; ++bj)
#pragma unroll
                for (int m = 0; m < 4; ++m)
#pragma unroll
                    for (int n = 0; n < 2; ++n) s += (acc[ai][bj][m][n][0] + acc[ai][bj][m][n][1]) + (acc[ai][bj][m][n][2] + acc[ai][bj][m][n][3]);
        if (s == 1.2345e30f) O[u.pm + u.pn] = 1;
    }
};
struct EpiResid {
    static constexpr bool PERM = true, AFTER_DRAIN = false;
    const float* basef; const bf16_t* baseb; float* out; bf16_t* xb; float* ss;
    __device__ __forceinline__ void operator()(const f32x4 (&acc)[2][2][4][2], const Unit& u, int wr, int wc, int fr, int fq) const {
        const int col0 = u.pn * BM + wc * 32 + 8 * fq;
#pragma unroll
        for (int ai = 0; ai < 2; ++ai) {
            f32x4 bs[4][2][2];
#pragma unroll
            for (int m = 0; m < 4; ++m) { const size_t off = (size_t)(u.pm * BM + ai * HALF + wr * 64 + m * 16 + fr) * 2048 + col0;
#pragma unroll
                for (int bj = 0; bj < 2; ++bj) {
                    if (baseb) { const u32x4 w = *(const u32x4*)(baseb + off + bj * HALF);
                        bs[m][bj][0] = (f32x4){__uint_as_float(w.x << 16), __uint_as_float(w.x & 0xffff0000u), __uint_as_float(w.y << 16), __uint_as_float(w.y & 0xffff0000u)};
                        bs[m][bj][1] = (f32x4){__uint_as_float(w.z << 16), __uint_as_float(w.z & 0xffff0000u), __uint_as_float(w.w << 16), __uint_as_float(w.w & 0xffff0000u)}; }
                    else { bs[m][bj][0] = __builtin_nontemporal_load((const f32x4*)(basef + off + bj * HALF)); bs[m][bj][1] = __builtin_nontemporal_load((const f32x4*)(basef + off + bj * HALF + 4)); } } }
#pragma unroll
            for (int m = 0; m < 4; ++m) { const int row = u.pm * BM + ai * HALF + wr * 64 + m * 16 + fr; const size_t off = (size_t)row * 2048 + col0; float sq = 0.f;
#pragma unroll
                for (int bj = 0; bj < 2; ++bj) { const f32x4 x0 = bs[m][bj][0] + acc[ai][bj][m][0], x1 = bs[m][bj][1] + acc[ai][bj][m][1];
                    if (out) { *(f32x4*)(out + off + bj * HALF) = x0; *(f32x4*)(out + off + bj * HALF + 4) = x1; }
                    sq += ((x0[0] * x0[0] + x0[1] * x0[1]) + (x0[2] * x0[2] + x0[3] * x0[3])) + ((x1[0] * x1[0] + x1[1] * x1[1]) + (x1[2] * x1[2] + x1[3] * x1[3]));
                    u32x4 w; w.x = cvt_pk_bf16(x0[0], x0[1]); w.y = cvt_pk_bf16(x0[2], x0[3]); w.z = cvt_pk_bf16(x1[0], x1[1]); w.w = cvt_pk_bf16(x1[2], x1[3]);
                    *(u32x4*)(xb + off + bj * HALF) = w; }
                sq += __shfl_xor(sq, 16); sq += __shfl_xor(sq, 32);
                if (fq == 0) ss[(size_t)row * 32 + u.pn * 4 + wc] = sq; }
            asm volatile("" ::: "memory");
        }
    }
};

template <class Epi, class Sched, bool ALIGN_EPI = false, bool SP2 = false>
__device__ __forceinline__ void gemm_phase(PG8_LAS unsigned char* lds, const Gemm g, const Sched& S, const Epi& E, const int wave_) {
    const int wid = wave_, lane = lane_id_(), tid = wid * 64 + lane, wr = wid >> 2, wc = wid & 3, fr = lane & 15, fq = lane >> 4;
    const int K = g.K, nt = K / BK;
    unsigned voffA[2], voffB[2];
#pragma unroll
    for (int i = 0; i < 2; ++i) { int R, C; stage_rc(tid * 16 + i * 8192, R, C); const int Rb = Epi::PERM ? ((R & ~31) + perm32(R & 31)) : R;
        voffA[i] = (unsigned)(R * g.lda + C) * 2u; voffB[i] = (unsigned)(Rb * K + C) * 2u; }
    const size_t kstep = (size_t)(BK * 2);
    const size_t hstep = (size_t)HALF * K * 2;
    const size_t tstep = 2 * hstep; const size_t hstepA = (size_t)HALF * g.lda * 2, tstepA = 2 * hstepA;
    const unsigned ldsw = (unsigned)wid * 1024u;
    const int aoff = lds_byte(wr * 64 + fr, fq * 8), boff = lds_byte(wc * 32 + fr, fq * 8);
#define PG8_SA(b, h) (((b) * 2 + (h)) * HTB)
#define PG8_SB(b, h) ((4 + (b) * 2 + (h)) * HTB)
#define PG8_STAGE(bufoff, gbase, voff) do { _Pragma("unroll") for (int _i = 0; _i < 2; ++_i) \
        __builtin_amdgcn_global_load_lds((const unsigned*)((const char*)(gbase) + (voff)[_i]), (PG8_LAS unsigned*)(lds + (bufoff) + ldsw + _i * 8192), 16, 0, 0); } while (0)
#define PG8_LDA(dst, b, h) do { _Pragma("unroll") for (int m = 0; m < 4; ++m) _Pragma("unroll") for (int k = 0; k < 2; ++k) dst[m][k] = *(const PG8_LAS bf16x8*)(lds + PG8_SA(b, h) + aoff + m * 2048 + k * 1024); } while (0)
#define PG8_LDB(dst, b, h) do { _Pragma("unroll") for (int n = 0; n < 2; ++n) _Pragma("unroll") for (int k = 0; k < 2; ++k) dst[n][k] = *(const PG8_LAS bf16x8*)(lds + PG8_SB(b, h) + boff + n * 2048 + k * 1024); } while (0)
#define PG8_MMA(ai, bj, At, Bt) do { __builtin_amdgcn_s_setprio(1); _Pragma("unroll") for (int m = 0; m < 4; ++m) _Pragma("unroll") for (int n = 0; n < 2; ++n) _Pragma("unroll") for (int k = 0; k < 2; ++k) \
        acc[ai][bj][m][n] = __builtin_amdgcn_mfma_f32_16x16x32_bf16(Bt[n][k], At[m][k], acc[ai][bj][m][n], 0, 0, 0); __builtin_amdgcn_s_setprio(0); } while (0)
#define PG8_WAIT_V(n) asm volatile("s_waitcnt vmcnt(" #n ")" ::: "memory")
#define PG8_WAIT_L(n) asm volatile("s_waitcnt lgkmcnt(" #n ")" ::: "memory")
#define PG8_BAR __builtin_amdgcn_s_barrier()
#define PG8_SCHED __builtin_amdgcn_sched_barrier(0)
    Unit cur, nxt; int ui = 0;
    if (!S.next(0, cur)) return;
    f32x4 acc[2][2][4][2];
#pragma unroll
    for (int a = 0; a < 2; ++a)
#pragma unroll
        for (int b = 0; b < 2; ++b)
#pragma unroll
            for (int m = 0; m < 4; ++m)
#pragma unroll
                for (int n = 0; n < 2; ++n) acc[a][b][m][n] = (f32x4){0.f, 0.f, 0.f, 0.f};
    bf16x8 At[4][2], B0[2][2], B1[2][2];
    const char* cA = (const char*)g.A + (size_t)cur.pm * tstepA; const char* cB = (const char*)g.Bt + (size_t)cur.pn * tstep;
    S.a_ready(cur);
    if constexpr (SP2) {
        PG8_STAGE(PG8_SB(0, 0), cB, voffB); PG8_STAGE(PG8_SB(0, 1), cB + hstep, voffB); PG8_STAGE(PG8_SA(0, 0), cA, voffA); PG8_STAGE(PG8_SA(0, 1), cA + hstepA, voffA);
        if (wr == 1) PG8_BAR;
        PG8_WAIT_V(2); PG8_BAR;
        PG8_STAGE(PG8_SB(1, 0), cB + kstep, voffB); PG8_STAGE(PG8_SA(1, 0), cA + kstep, voffA); PG8_STAGE(PG8_SB(1, 1), cB + hstep + kstep, voffB);
        PG8_WAIT_V(6); PG8_BAR;
    } else {
        PG8_STAGE(PG8_SB(0, 0), cB, voffB); PG8_STAGE(PG8_SA(0, 0), cA, voffA); PG8_STAGE(PG8_SB(0, 1), cB + hstep, voffB); PG8_STAGE(PG8_SA(0, 1), cA + hstepA, voffA);
        if (wr == 1) PG8_BAR;
        PG8_WAIT_V(4); PG8_BAR;
        PG8_STAGE(PG8_SB(1, 0), cB + kstep, voffB); PG8_STAGE(PG8_SA(1, 0), cA + kstep, voffA); PG8_STAGE(PG8_SB(1, 1), cB + hstep + kstep, voffB);
        PG8_WAIT_V(6); PG8_BAR;
    }
    for (;;) {
        const bool has_next = S.next(ui + 1, nxt);
        const char* nA = has_next ? (const char*)g.A + (size_t)nxt.pm * tstepA : cA; const char* nB = has_next ? (const char*)g.Bt + (size_t)nxt.pn * tstep : cB;
        for (int t = 0; t < nt; t += 2) {
            const bool last = (t == nt - 2);
            const char* a1 = cA + (size_t)(t + 1) * kstep;
            const char* a2 = last ? nA : cA + (size_t)(t + 2) * kstep; const char* b2 = last ? nB : cB + (size_t)(t + 2) * kstep;
            const char* a3 = a2 + kstep; const char* b3 = b2 + kstep;
            if (last && has_next) S.a_ready(nxt);
            if constexpr (SP2) {
            PG8_LDB(B0, 0, 0); PG8_LDB(B1, 0, 1); PG8_SCHED; PG8_LDA(At, 0, 0); PG8_STAGE(PG8_SA(1, 1), a1 + hstepA, voffA);
            PG8_WAIT_V(8); PG8_WAIT_L(0); PG8_BAR; PG8_MMA(0, 0, At, B0); PG8_MMA(0, 1, At, B1); PG8_BAR; PG8_SCHED;
            PG8_LDA(At, 0, 1); PG8_STAGE(PG8_SB(0, 0), b2, voffB); PG8_STAGE(PG8_SB(0, 1), b2 + hstep, voffB); PG8_STAGE(PG8_SA(0, 0), a2, voffA);
            PG8_WAIT_V(8); PG8_WAIT_L(0); PG8_BAR; PG8_MMA(1, 0, At, B0); PG8_MMA(1, 1, At, B1); PG8_BAR; PG8_SCHED;
            PG8_LDB(B0, 1, 0); PG8_LDB(B1, 1, 1); PG8_SCHED; PG8_LDA(At, 1, 0); PG8_STAGE(PG8_SA(0, 1), a2 + hstepA, voffA);
            PG8_WAIT_V(8); PG8_WAIT_L(0); PG8_BAR; PG8_MMA(0, 0, At, B0); PG8_MMA(0, 1, At, B1); PG8_BAR; PG8_SCHED;
            PG8_LDA(At, 1, 1); PG8_STAGE(PG8_SB(1, 0), b3, voffB); PG8_STAGE(PG8_SB(1, 1), b3 + hstep, voffB); PG8_STAGE(PG8_SA(1, 0), a3, voffA);
            PG8_WAIT_V(8); PG8_WAIT_L(0); PG8_BAR; PG8_MMA(1, 0, At, B0); PG8_MMA(1, 1, At, B1); PG8_BAR; PG8_SCHED;
            } else {
            PG8_LDB(B0, 0, 0); PG8_SCHED; PG8_LDA(At, 0, 0); PG8_STAGE(PG8_SA(1, 1), a1 + hstepA, voffA);
            PG8_WAIT_L(8); PG8_BAR; PG8_WAIT_L(0); PG8_MMA(0, 0, At, B0); PG8_BAR; PG8_SCHED;
            PG8_LDB(B1, 0, 1); PG8_STAGE(PG8_SB(0, 0), b2, voffB);
            PG8_BAR; PG8_WAIT_L(0); PG8_MMA(0, 1, At, B1); PG8_BAR;
            PG8_LDA(At, 0, 1); PG8_STAGE(PG8_SA(0, 0), a2, voffA);
            PG8_BAR; PG8_WAIT_L(0); PG8_MMA(1, 0, At, B0); PG8_BAR; PG8_SCHED;
            PG8_STAGE(PG8_SB(0, 1), b2 + hstep, voffB);
            PG8_WAIT_V(6); PG8_BAR; PG8_MMA(1, 1, At, B1); PG8_BAR;
            PG8_LDB(B0, 1, 0); PG8_SCHED; PG8_LDA(At, 1, 0); PG8_STAGE(PG8_SA(0, 1), a2 + hstepA, voffA);
            PG8_WAIT_L(8); PG8_BAR; PG8_WAIT_L(0); PG8_MMA(0, 0, At, B0); PG8_BAR; PG8_SCHED;
            PG8_LDB(B1, 1, 1); PG8_STAGE(PG8_SB(1, 0), b3, voffB);
            PG8_BAR; PG8_WAIT_L(0); PG8_MMA(0, 1, At, B1); PG8_BAR;
            PG8_LDA(At, 1, 1); PG8_STAGE(PG8_SA(1, 0), a3, voffA);
            PG8_BAR; PG8_WAIT_L(0); PG8_MMA(1, 0, At, B0); PG8_BAR; PG8_SCHED;
            PG8_STAGE(PG8_SB(1, 1), b3 + hstep, voffB);
            PG8_WAIT_V(6); PG8_BAR; PG8_MMA(1, 1, At, B1); PG8_BAR;
            }
        }
        if constexpr (ALIGN_EPI) { if (wr == 0) PG8_BAR; }
        if constexpr (!Epi::AFTER_DRAIN) { E(acc, cur, wr, wc, fr, fq); S.done(cur); }
        if (!has_next) break;
#pragma unroll
        for (int a = 0; a < 2; ++a)
#pragma unroll
            for (int b = 0; b < 2; ++b)
#pragma unroll
                for (int m = 0; m < 4; ++m)
#pragma unroll
                    for (int n = 0; n < 2; ++n) acc[a][b][m][n] = (f32x4){0.f, 0.f, 0.f, 0.f};
        cur = nxt; cA = nA; cB = nB; ++ui;
        if constexpr (ALIGN_EPI) { if (wr == 1) PG8_BAR; }
    }
    PG8_WAIT_V(0);
    if constexpr (!ALIGN_EPI) { if (wr == 0) PG8_BAR; }
    PG8_BAR;
    if constexpr (Epi::AFTER_DRAIN) { E.fused(acc, cur, wr, wc, fr, fq, lds, wid, lane); S.done(cur); }
#undef PG8_SA
#undef PG8_SB
#undef PG8_STAGE
#undef PG8_LDA
#undef PG8_LDB
#undef PG8_MMA
#undef PG8_WAIT_V
#undef PG8_WAIT_L
#undef PG8_BAR
#undef PG8_SCHED
}
}
namespace att {
using bf16 = __hip_bfloat16;
constexpr int   D = 128, NW = 8, QBLK = 32, KVBLK = 64;
constexpr float SCALE = 0.088388347648318440f;
constexpr float THR = 8.f;
constexpr int SDEPTH = 2;
constexpr size_t SHM_V = KVBLK * D * 2, SHM_K = KVBLK * D * 2, SHM_ATTN = 3 * SHM_V + 3 * SHM_K + NW * 64 * 4;
using bf16x8 = __attribute__((ext_vector_type(8))) short;
using s16x4  = __attribute__((ext_vector_type(4))) short;
using f32x16 = __attribute__((ext_vector_type(16))) float;
using f32x8  = __attribute__((ext_vector_type(8))) float;
using u32x4  = __attribute__((ext_vector_type(4))) unsigned;
#define KSWZ(row, colB) ((row) * 256 + ((colB) ^ (((row) & 7) << 4)))
#define SBAR() __builtin_amdgcn_sched_barrier(0)
__device__ __forceinline__ int crow(int r, int hi) { return (r & 3) + 8 * (r >> 2) + 4 * hi; }
__device__ __forceinline__ unsigned cvtpk(float lo, float hi) {
  unsigned r; asm volatile("v_cvt_pk_bf16_f32 %0, %1, %2" : "=v"(r) : "v"(lo), "v"(hi)); return r;
}
struct StageB { using T = bf16x8;
  __device__ static __forceinline__ T ld8(const bf16* p) { return *reinterpret_cast<const bf16x8*>(p); }
  __device__ static __forceinline__ bf16x8 tobf(T x) { return x; } };

__device__ __forceinline__ void partialSM(f32x16& p0, f32x16& p1, float& m_reg, float& mn, float& alpha) {
  constexpr float C = SCALE * 1.4426950408889634f;
  float pmax = p0[0]; for (int r = 1; r < 16; ++r) pmax = fmaxf(pmax, p0[r]); for (int r = 0; r < 16; ++r) pmax = fmaxf(pmax, p1[r]);
  { auto rr = __builtin_amdgcn_permlane32_swap(__float_as_uint(pmax), __float_as_uint(pmax), false, false);
    pmax = fmaxf(__uint_as_float(rr[0]), __uint_as_float(rr[1])); }
  if (__builtin_expect(__all(pmax - m_reg <= THR / SCALE), 1)) { mn = m_reg; alpha = 1.f; }
  else { mn = fmaxf(m_reg, pmax); alpha = __builtin_amdgcn_exp2f((m_reg - mn) * C); m_reg = mn; }
  float mnC = -mn * C;
  for (int r = 0; r < 16; ++r) p0[r] = fmaf(p0[r], C, mnC); for (int r = 0; r < 16; ++r) p1[r] = fmaf(p1[r], C, mnC);
  for (int r = 0; r < 16; ++r) p0[r] = __builtin_amdgcn_exp2f(p0[r]);
}
__device__ __forceinline__ void finishSM(f32x16& p0, f32x16& p1, float alpha, float& l_reg, bf16x8& pa0, bf16x8& pa1, bf16x8& pa2, bf16x8& pa3) {
  for (int r = 0; r < 16; ++r) p1[r] = __builtin_amdgcn_exp2f(p1[r]);
  float ps = 0; for (int r = 0; r < 16; ++r) ps += p0[r]; for (int r = 0; r < 16; ++r) ps += p1[r];
  { auto rr = __builtin_amdgcn_permlane32_swap(__float_as_uint(ps), __float_as_uint(ps), false, false);
    ps = __uint_as_float(rr[0]) + __uint_as_float(rr[1]); }
  l_reg = l_reg * alpha + ps;
#define PK4(P, BASE, OUT) do { unsigned a0 = cvtpk(P[BASE + 0], P[BASE + 1]), a1 = cvtpk(P[BASE + 2], P[BASE + 3]);   \
    unsigned b0 = cvtpk(P[BASE + 4], P[BASE + 5]), b1 = cvtpk(P[BASE + 6], P[BASE + 7]);                              \
    auto r0 = __builtin_amdgcn_permlane32_swap(a0, b0, false, false); auto r1 = __builtin_amdgcn_permlane32_swap(a1, b1, false, false); \
    u32x4 w = {r0[0], r1[0], r0[1], r1[1]}; OUT = *reinterpret_cast<bf16x8*>(&w); } while (0)
  PK4(p0, 0, pa0); PK4(p0, 8, pa1); PK4(p1, 0, pa2); PK4(p1, 8, pa3);
#undef PK4
}
__device__ __forceinline__ void qkt(f32x16& p0, f32x16& p1, const bf16* Ks, const bf16x8* qr, int r32, int hi) {
  p0 = f32x16{}; p1 = f32x16{};
  for (int d0 = 0; d0 < 8; ++d0) { int cb = (d0 * 16 + hi * 8) * 2;
    bf16x8 b0 = *reinterpret_cast<const bf16x8*>((const char*)Ks + KSWZ(r32, cb));
    bf16x8 b1 = *reinterpret_cast<const bf16x8*>((const char*)Ks + KSWZ(32 + r32, cb));
    p0 = __builtin_amdgcn_mfma_f32_32x32x16_bf16(b0, qr[d0], p0, 0, 0, 0);
    p1 = __builtin_amdgcn_mfma_f32_32x32x16_bf16(b1, qr[d0], p1, 0, 0, 0); }
}
__device__ __forceinline__ int v_st(int k, int c) { const int kk = (k & ~0xC) | ((k & 4) << 1) | ((k & 8) >> 1); return ((kk >> 3) * 4 + (c >> 5)) * 512 + ((kk & 7) * 32 + (c & 31)) * 2; }
__device__ __forceinline__ int v_rd_base(int lane) { return ((lane & 3) << 3) | (((lane >> 2) & 3) << 6) | (((lane >> 4) & 1) << 5) | (((lane >> 5) & 1) << 8); }
constexpr int v_rd_off(int d0, int ks, int half) { return d0 * 512 + ks * 4096 + half * 2048; }
template <int OFF> __device__ __forceinline__ s16x4 tr_read(int vb) {
  s16x4 r; asm volatile("ds_read_b64_tr_b16 %0, %1 offset:%2" : "=&v"(r) : "v"(vb), "i"(OFF) : "memory"); return r;
}
template <int D0> __device__ __forceinline__ void pv_one(f32x16& od, int vb, bf16x8 pa0, bf16x8 pa1, bf16x8 pa2, bf16x8 pa3) {
  const s16x4 l0 = tr_read<v_rd_off(D0, 0, 0)>(vb), h0 = tr_read<v_rd_off(D0, 0, 1)>(vb), l1 = tr_read<v_rd_off(D0, 1, 0)>(vb), h1 = tr_read<v_rd_off(D0, 1, 1)>(vb);
  const s16x4 l2 = tr_read<v_rd_off(D0, 2, 0)>(vb), h2 = tr_read<v_rd_off(D0, 2, 1)>(vb), l3 = tr_read<v_rd_off(D0, 3, 0)>(vb), h3 = tr_read<v_rd_off(D0, 3, 1)>(vb);
  asm volatile("s_waitcnt lgkmcnt(0)" ::: "memory"); SBAR();
#define PK(L, H) (bf16x8){L[0], L[1], L[2], L[3], H[0], H[1], H[2], H[3]}
  od = __builtin_amdgcn_mfma_f32_32x32x16_bf16(pa0, PK(l0, h0), od, 0, 0, 0);
  od = __builtin_amdgcn_mfma_f32_32x32x16_bf16(pa1, PK(l1, h1), od, 0, 0, 0);
  od = __builtin_amdgcn_mfma_f32_32x32x16_bf16(pa2, PK(l2, h2), od, 0, 0, 0);
  od = __builtin_amdgcn_mfma_f32_32x32x16_bf16(pa3, PK(l3, h3), od, 0, 0, 0);
#undef PK
}
__device__ __forceinline__ void pv_d0(f32x16* o, int vb, bf16x8 pa0, bf16x8 pa1, bf16x8 pa2, bf16x8 pa3) {
  pv_one<0>(o[0], vb, pa0, pa1, pa2, pa3); pv_one<1>(o[1], vb, pa0, pa1, pa2, pa3); pv_one<2>(o[2], vb, pa0, pa1, pa2, pa3); pv_one<3>(o[3], vb, pa0, pa1, pa2, pa3);
}

using f32x4a = __attribute__((ext_vector_type(4))) float;
template <int LDQ, int LDK, int LDO, int VOFF, bool QNORM = false>
__device__ __forceinline__ void attn_dense_body(const bf16* Qb, const bf16* __restrict__ Kh,
                                                bf16* Ob, int seq, char* lds, const int wave_, const float* rope = nullptr, const float* qw = nullptr, int t0 = 0) {
  using St = StageB; using SQ = StageB;
  const int wid = wave_, lane = lane_id_(), tid = wid * 64 + lane, r32 = lane & 31, hi = lane >> 5;
  bf16* V_lds = (bf16*)lds; bf16* K_lds = (bf16*)(lds + 3 * SHM_V);
  float* ws = (float*)(lds + 3 * SHM_V + 3 * SHM_K) + wid * 64; float* li_l = ws; float* al_l = ws + 32;
  float m_reg = -1e30f, l_reg = 0; f32x16 o[4] = {}; bf16x8 qr[8];
  const bf16* Qw = Qb + (long)(wid * QBLK + r32) * LDQ + hi * 8;
#pragma unroll
  for (int d0 = 0; d0 < 8; ++d0) qr[d0] = SQ::tobf(SQ::ld8(Qw + d0 * 16));
  if constexpr (QNORM) {
    float x[8][8]; float ss = 0.f;
#pragma unroll
    for (int d0 = 0; d0 < 8; ++d0)
#pragma unroll
      for (int j = 0; j < 8; ++j) { x[d0][j] = __uint_as_float((unsigned)(unsigned short)qr[d0][j] << 16); ss += x[d0][j] * x[d0][j]; }
    { auto rr = __builtin_amdgcn_permlane32_swap(__float_as_uint(ss), __float_as_uint(ss), false, false); ss = __uint_as_float(rr[0]) + __uint_as_float(rr[1]); }
    const float rs = 1.0f / sqrtf(ss * (1.0f / 128.0f) + 1e-6f);
#pragma unroll
    for (int d0 = 0; d0 < 8; ++d0) { const f32x4a w0 = *(const f32x4a*)(qw + d0 * 16 + hi * 8), w1 = *(const f32x4a*)(qw + d0 * 16 + hi * 8 + 4);
#pragma unroll
      for (int j = 0; j < 4; ++j) { x[d0][j] = x[d0][j] * rs * w0[j]; x[d0][4 + j] = x[d0][4 + j] * rs * w1[j]; } }
    const int t = t0 + wid * QBLK + r32;
#pragma unroll
    for (int hf = 0; hf < 2; ++hf) { const int pos = hf ? (t & 63) : (t >> 6);
#pragma unroll
      for (int db = 0; db < 2; ++db) { const int a = hf * 4 + db, b = a + 2; const float* tp = rope + (size_t)(pos * 32 + db * 16 + hi * 8) * 2;
#pragma unroll
        for (int j2 = 0; j2 < 4; ++j2) { const f32x4a cs = *(const f32x4a*)(tp + 4 * j2);
          const float xa0 = x[a][2 * j2], xb0 = x[b][2 * j2], xa1 = x[a][2 * j2 + 1], xb1 = x[b][2 * j2 + 1];
          x[a][2 * j2] = xa0 * cs[0] - xb0 * cs[1]; x[b][2 * j2] = xb0 * cs[0] + xa0 * cs[1];
          x[a][2 * j2 + 1] = xa1 * cs[2] - xb1 * cs[3]; x[b][2 * j2 + 1] = xb1 * cs[2] + xa1 * cs[3]; } } }
#pragma unroll
    for (int d0 = 0; d0 < 8; ++d0) { u32x4 w = {cvtpk(x[d0][0], x[d0][1]), cvtpk(x[d0][2], x[d0][3]), cvtpk(x[d0][4], x[d0][5]), cvtpk(x[d0][6], x[d0][7])}; qr[d0] = *reinterpret_cast<bf16x8*>(&w); }
  }
  const int sr = tid >> 4, sc = (tid & 15) * 8, vst0 = v_st(sr, sc), vst1 = v_st(32 + sr, sc);
  const int vb0 = (int)(uintptr_t)V_lds + v_rd_base(lane);
  struct { typename St::T vs0, vs1, ks0, ks1; } sr_[SDEPTH];
  const unsigned kvo0 = (unsigned)(sr * LDK + sc) * 2u, kvo1 = kvo0 + 32u * LDK * 2u;
#define SLOAD(i, k0) do { const char* kb_ = (const char*)Kh + (size_t)(k0) * (LDK * 2); \
    sr_[i].vs0 = *(const bf16x8*)(kb_ + kvo0 + VOFF * 2); sr_[i].vs1 = *(const bf16x8*)(kb_ + kvo1 + VOFF * 2); \
    sr_[i].ks0 = *(const bf16x8*)(kb_ + kvo0); sr_[i].ks1 = *(const bf16x8*)(kb_ + kvo1); } while (0)
#define SWRITE(b, i) do { *(bf16x8*)((char*)V_lds + (b) * SHM_V + vst0) = St::tobf(sr_[i].vs0);          \
    *(bf16x8*)((char*)V_lds + (b) * SHM_V + vst1) = St::tobf(sr_[i].vs1); int kc = sc * 2;               \
    *(bf16x8*)((char*)K_lds + (b) * SHM_K + KSWZ(sr, kc)) = St::tobf(sr_[i].ks0);                       \
    *(bf16x8*)((char*)K_lds + (b) * SHM_K + KSWZ(32 + sr, kc)) = St::tobf(sr_[i].ks1); } while (0)
#define SWAIT() do { if constexpr (SDEPTH == 2) asm volatile("s_waitcnt vmcnt(4)" ::: "memory"); else asm volatile("s_waitcnt vmcnt(0)" ::: "memory"); } while (0)
#define RESC(a) do { if (__any((a) < 1.f)) { if (hi == 0) al_l[r32] = (a); asm volatile("s_waitcnt lgkmcnt(0)" ::: "memory"); \
    for (int d = 0; d < 4; ++d) for (int r = 0; r < 16; ++r) o[d][r] *= al_l[crow(r, hi)]; } } while (0)
  f32x16 pA0, pA1, pB0, pB1; float mnA, mnB, alA, alB; bf16x8 pa0, pa1, pa2, pa3; const int NT = seq / KVBLK;
  constexpr int SE = 0, SO = SDEPTH - 1;
  SLOAD(SE, 0); asm volatile("s_waitcnt vmcnt(0)" ::: "memory"); SWRITE(0, SE); __syncthreads();
  qkt(pA0, pA1, K_lds, qr, r32, hi); partialSM(pA0, pA1, m_reg, mnA, alA);
  SLOAD(SO, KVBLK); if constexpr (SDEPTH == 2) { if (2 < NT) SLOAD(SE, 2 * KVBLK); }
  SWAIT(); SWRITE(1, SO);
  int sp = 0, scu = 1, sn = 2;
#define ROT3() do { const int t_ = sp; sp = scu; scu = sn; sn = t_; } while (0)
  for (int j = 1; j + 1 < NT; j += 2) {
    __syncthreads();
    SBAR(); qkt(pB0, pB1, (bf16*)((char*)K_lds + scu * SHM_K), qr, r32, hi);
    finishSM(pA0, pA1, alA, l_reg, pa0, pa1, pa2, pa3); SBAR();
    SLOAD(SO, (j + SDEPTH) * KVBLK); SBAR();
    pv_d0(o, vb0 + sp * (int)SHM_V, pa0, pa1, pa2, pa3); partialSM(pB0, pB1, m_reg, mnB, alB);
    SWAIT(); SWRITE(sn, SE);
    RESC(alB); ROT3();
    __syncthreads();
    SBAR(); qkt(pA0, pA1, (bf16*)((char*)K_lds + scu * SHM_K), qr, r32, hi);
    finishSM(pB0, pB1, alB, l_reg, pa0, pa1, pa2, pa3); SBAR();
    if (SDEPTH == 1 || j + 3 < NT) SLOAD(SE, (j + 1 + SDEPTH) * KVBLK); SBAR();
    pv_d0(o, vb0 + sp * (int)SHM_V, pa0, pa1, pa2, pa3); partialSM(pA0, pA1, m_reg, mnA, alA);
    SWAIT(); SWRITE(sn, SO);
    RESC(alA); ROT3();
  }
  __syncthreads();
  SBAR(); qkt(pB0, pB1, (bf16*)((char*)K_lds + scu * SHM_K), qr, r32, hi);
  finishSM(pA0, pA1, alA, l_reg, pa0, pa1, pa2, pa3); SBAR();
  pv_d0(o, vb0 + sp * (int)SHM_V, pa0, pa1, pa2, pa3); partialSM(pB0, pB1, m_reg, mnB, alB);
  RESC(alB);
  finishSM(pB0, pB1, alB, l_reg, pa0, pa1, pa2, pa3); SBAR();
  pv_d0(o, vb0 + scu * (int)SHM_V, pa0, pa1, pa2, pa3);
#undef ROT3
  if (hi == 0) li_l[r32] = l_reg; asm volatile("s_waitcnt lgkmcnt(0)" ::: "memory");
  float rli[16];
#pragma unroll
  for (int r = 0; r < 16; ++r) rli[r] = __builtin_amdgcn_rcpf(li_l[crow(r, hi)]);
  unsigned short* Ow = (unsigned short*)Ob + (long)(wid * QBLK) * LDO;
  int hi_o = hi, r32_o = r32; asm volatile("" : "+v"(hi_o), "+v"(r32_o));
  const unsigned lane_off = (unsigned)(4 * hi_o * LDO + r32_o);
#pragma unroll
  for (int r = 0; r < 16; ++r) {
#pragma unroll
    for (int d0 = 0; d0 < 4; ++d0) Ow[lane_off + (unsigned)(((r & 3) + 8 * (r >> 2)) * LDO + d0 * 32)] = (unsigned short)(cvtpk(o[d0][r] * rli[r], 0.f) & 0xffffu); }
#undef SLOAD
#undef SWRITE
#undef SWAIT
#undef RESC
}

}
constexpr int BATCH = 2, SEQ = 8192, DM = 2048, M = BATCH * SEQ, INW = 5632, DFF = 8192, CWID = 512, MEMT = 256, MROWS = BATCH * MEMT;
constexpr int C_RQ = 0, C_RK = 1024, C_RV = 2048, C_RG = 3072, C_AQ = 4096, C_AK = 5120, C_AV = 5376;
constexpr int NCH = 64;
constexpr int DEF_C0 = 3584, DEF_W = 512;
constexpr float EPS = 1e-6f;
constexpr int NWAVES = 8;
constexpr size_t MiB = 1u << 20;
constexpr size_t WS_ROPE = 0;
constexpr size_t WS_CTL = 512 * 1024, CTL_ZERO_BYTES = 16384;
constexpr size_t WS_SS1 = 1 * MiB, WS_SS2 = 3 * MiB, WS_SS3 = 5 * MiB;
constexpr size_t WS_KVC = 7 * MiB;
constexpr size_t WS_WIN = 8 * MiB, WS_WOUT = 30 * MiB, WS_WQ = 38 * MiB, WS_WKV = 40 * MiB, WS_WO = 44 * MiB, WS_WUP = 46 * MiB, WS_WDN = 78 * MiB;
constexpr size_t WS_XN = 110 * MiB;
constexpr size_t WS_MN = 174 * MiB;
constexpr size_t WS_PROJ = 176 * MiB;
constexpr size_t WS_VT = 352 * MiB;
constexpr size_t WS_ST = 384 * MiB;
constexpr size_t WS_QC = 448 * MiB;
constexpr size_t WS_U = 176 * MiB;
constexpr size_t WS_END = 464 * MiB;
static_assert(WS_U + (size_t)M * DFF * 2 <= WS_QC, "U overlay");
constexpr int LDS_BYTES = 147456;
constexpr int LDT = 136, TILE_B = 128 * LDT * 2;
constexpr int RED_OFF = 4 * TILE_B;
constexpr int MISC_OFF = LDS_BYTES - 64;
static_assert(MISC_OFF + 16 <= LDS_BYTES && RED_OFF + 4096 <= MISC_OFF && 7 * 18432 + 64 * 65 * 4 <= MISC_OFF, "LDS map");

#define LAS __attribute__((address_space(3)))
typedef unsigned short bf16;
typedef unsigned v4u __attribute__((ext_vector_type(4)));
typedef unsigned v2u __attribute__((ext_vector_type(2)));
typedef float f32x4 __attribute__((ext_vector_type(4)));
typedef float f32x2 __attribute__((ext_vector_type(2)));
typedef short bf16x8 __attribute__((ext_vector_type(8)));
#define LDS_WAIT() asm volatile("s_waitcnt lgkmcnt(0)" ::: "memory")
__device__ __forceinline__ unsigned f2bf(float f) { unsigned u = __builtin_bit_cast(unsigned, f); return (u + 0x7fffu + ((u >> 16) & 1u)) >> 16; }
__device__ __forceinline__ unsigned pk2(float lo, float hi) { return f2bf(lo) | (f2bf(hi) << 16); }
__device__ __forceinline__ float bflo(unsigned w) { return __uint_as_float(w << 16); }
__device__ __forceinline__ float bfhi(unsigned w) { return __uint_as_float(w & 0xffff0000u); }
__device__ __forceinline__ float bf1(unsigned short h) { return __uint_as_float((unsigned)h << 16); }
__device__ __forceinline__ float wave_sum(float v) {
#pragma unroll
    for (int o = 1; o < 64; o <<= 1) v += __shfl_xor(v, o);
    return v;
}

#define XB_TMO      128
#define XB_XCNT(j)  (256  + 64 * (j))
#define XB_XSUB(j)  (1280 + 64 * (j))
#define XB_XGEN(j)  (2304 + 64 * (j))
#define XB_TOP      3328
#define XB_TOPGEN   3392
#define XCD_BAR_WORDS 3456
#define XB_SPIN_CAP (1u << 18)

__device__ __forceinline__ unsigned xb_ld(unsigned* p)              { return __hip_atomic_load(p, __ATOMIC_RELAXED, __HIP_MEMORY_SCOPE_AGENT); }
__device__ __forceinline__ unsigned xb_add(unsigned* p, unsigned v) { return __hip_atomic_fetch_add(p, v, __ATOMIC_RELAXED, __HIP_MEMORY_SCOPE_AGENT); }
__device__ __forceinline__ unsigned xb_xcc_id() { return (unsigned)__builtin_amdgcn_s_getreg((3 << 11) | 20) & 0xFu; }
#define XB_SPIN(cond, bar) do { unsigned _sp = 0; while (cond) { __builtin_amdgcn_s_sleep(1); \
    if ((++_sp & 255u) == 0u) { if (xb_ld(&(bar)[XB_TMO])) break; if (_sp > XB_SPIN_CAP) { atomicAdd(&(bar)[XB_TMO], 1u); break; } } } } while (0)

struct XcdBarrier {
    unsigned* bar; unsigned x;
    volatile LAS unsigned* st;
};

__device__ __forceinline__ XcdBarrier xcd_barrier_post(unsigned* bar, volatile LAS unsigned* st, const bool t0_) {
    XcdBarrier b; b.bar = bar; b.x = xb_xcc_id(); b.st = st;
    if (t0_) (void)xb_add(&bar[XB_XCNT(b.x)], 1u);
    return b;
}
__device__ __forceinline__ void xcd_barrier_complete(unsigned* bar, unsigned x, unsigned& nloc, unsigned& nx) {
    const unsigned G = gridDim.x * gridDim.y * gridDim.z;
    unsigned sum, cnt, mine, sp = 0u;
    for (;;) {
        sum = 0u; cnt = 0u; mine = 0u;
#pragma unroll
        for (unsigned j = 0; j < 16; ++j) { const unsigned c = xb_ld(&bar[XB_XCNT(j)]); sum += c; cnt += (c > 0u) ? 1u : 0u; mine = (j == x) ? c : mine; }
        if (sum == G) break;
        __builtin_amdgcn_s_sleep(1);
        if ((++sp & 255u) == 0u) { if (xb_ld(&bar[XB_TMO])) break; if (sp > XB_SPIN_CAP) { atomicAdd(&bar[XB_TMO], 1u); break; } }
    }
    nloc = mine > 0u ? mine : 1u; nx = cnt > 0u ? cnt : 1u;
}

__device__ __forceinline__ void xcd_barrier(const XcdBarrier& b, const bool t0_) {
    asm volatile("s_waitcnt vmcnt(0)" ::: "memory");
    __syncthreads();
    if (t0_) {
        unsigned* bar = b.bar;
        __builtin_amdgcn_s_waitcnt(0);
        unsigned nloc = b.st[0], nx = b.st[1];
        if (nloc == 0u) { xcd_barrier_complete(bar, b.x, nloc, nx); b.st[0] = nloc; b.st[1] = nx; }
        const unsigned old = xb_add(&bar[XB_XSUB(b.x)], 1u);
        const unsigned gen = old / nloc;
        if (old + 1u == (gen + 1u) * nloc) {
            __builtin_amdgcn_fence(__ATOMIC_RELEASE, "agent");
            asm volatile("s_waitcnt vmcnt(0)" ::: "memory");
            const unsigned og = xb_add(&bar[XB_TOP], 1u);
            const unsigned tg = og / nx;
            if (og + 1u == (tg + 1u) * nx) xb_add(&bar[XB_TOPGEN], 1u);
            else XB_SPIN(xb_ld(&bar[XB_TOPGEN]) == tg, bar);
            __builtin_amdgcn_fence(__ATOMIC_ACQUIRE, "agent");
            xb_add(&bar[XB_XGEN(b.x)], 1u);
            asm volatile("s_waitcnt vmcnt(0)" ::: "memory");
        } else {
            XB_SPIN(xb_ld(&bar[XB_XGEN(b.x)]) == gen, bar);
            __builtin_amdgcn_fence(__ATOMIC_ACQUIRE, "agent");
            asm volatile("s_waitcnt vmcnt(0)" ::: "memory");
        }
    }
    __syncthreads();
}

struct Args { const float* in[21]; float* out; unsigned char* ws; int ph_lo, ph_hi, coop, pad; };

struct Frame {
    LAS unsigned char* lds; char* ldsg;
    int tid, lane, wave, vcu, G;
};

__device__ __forceinline__ void p0_transpose_item(const float* W, int K, int N, bf16* WT, int row_off, const float* gain, LAS float* scr, int item, int lane) {
    const int nblk = N / 64, kb = item / nblk, nb = item - kb * nblk, k0 = 64 * kb, n0 = 64 * nb;
    const int r4 = lane >> 4, c4 = (lane & 15) * 4;
    f32x4 v[16];
#pragma unroll
    for (int i = 0; i < 16; ++i) v[i] = __builtin_nontemporal_load((const f32x4*)(W + (size_t)(k0 + 4 * i + r4) * N + n0 + c4));
    if (gain) {
#pragma unroll
        for (int i = 0; i < 16; ++i) v[i] = v[i] * gain[k0 + 4 * i + r4]; }
#pragma unroll
    for (int i = 0; i < 16; ++i) { LAS float* d = scr + (4 * i + r4) * 65 + c4; d[0] = v[i][0]; d[1] = v[i][1]; d[2] = v[i][2]; d[3] = v[i][3]; }
    LDS_WAIT(); asm volatile("" ::: "memory");
    const int c = lane & 7, nl = lane >> 3;
#pragma unroll
    for (int j = 0; j < 8; ++j) { const int n = nl + 8 * j; const LAS float* s = scr + (8 * c) * 65 + n;
        v4u o; o.x = pk2(s[0 * 65], s[1 * 65]); o.y = pk2(s[2 * 65], s[3 * 65]); o.z = pk2(s[4 * 65], s[5 * 65]); o.w = pk2(s[6 * 65], s[7 * 65]);
        *(v4u*)(WT + (size_t)(row_off + n0 + n) * K + k0 + 8 * c) = o; }
    LDS_WAIT(); asm volatile("" ::: "memory");
}
__device__ __forceinline__ void rms_row_to_bf16(const float* xrow, const float* w, bf16* orow, int lane) {
    const f32x4* xr = (const f32x4*)xrow + lane; const f32x4* wr = (const f32x4*)w + lane;
    f32x4 v[8]; float s = 0.f;
#pragma unroll
    for (int j = 0; j < 8; ++j) { v[j] = __builtin_nontemporal_load(xr + 64 * j); s += (v[j].x * v[j].x + v[j].y * v[j].y) + (v[j].z * v[j].z + v[j].w * v[j].w); }
    const float rs = 1.0f / sqrtf(wave_sum(s) * (1.0f / 2048.0f) + EPS);
    v2u* o8 = (v2u*)orow + lane;
#pragma unroll
    for (int j = 0; j < 8; ++j) { const f32x4 g = wr[64 * j]; v2u o; o.x = pk2(v[j].x * rs * g.x, v[j].y * rs * g.y); o.y = pk2(v[j].z * rs * g.z, v[j].w * rs * g.w); o8[64 * j] = o; }
}

__device__ __forceinline__ void lds_mma128(f32x4 (&acc)[4][2], const LAS unsigned char* A, const LAS unsigned char* Bt, int wr, int wc, int fr, int fq) {
#pragma unroll
    for (int k0 = 0; k0 < 4; ++k0) {
        bf16x8 a[4], b[2];
#pragma unroll
        for (int m = 0; m < 4; ++m) a[m] = *(const LAS bf16x8*)(A + ((wr * 64 + m * 16 + fr) * LDT + k0 * 32 + fq * 8) * 2);
#pragma unroll
        for (int n = 0; n < 2; ++n) b[n] = *(const LAS bf16x8*)(Bt + ((wc * 32 + n * 16 + fr) * LDT + k0 * 32 + fq * 8) * 2);
#pragma unroll
        for (int m = 0; m < 4; ++m)
#pragma unroll
            for (int n = 0; n < 2; ++n) acc[m][n] = __builtin_amdgcn_mfma_f32_16x16x32_bf16(b[n], a[m], acc[m][n], 0, 0, 0);
    }
}
__device__ __forceinline__ void zero_acc(f32x4 (&acc)[4][2]) {
#pragma unroll
    for (int m = 0; m < 4; ++m)
#pragma unroll
        for (int n = 0; n < 2; ++n) acc[m][n] = (f32x4){0.f, 0.f, 0.f, 0.f};
}
typedef short s16x4 __attribute__((ext_vector_type(4)));
__device__ __forceinline__ unsigned tr_lane_off(int lane) { return (unsigned)((8 * (lane >> 4) + ((lane & 15) >> 2)) * (LDT * 2) + 8 * (lane & 3)); }
__device__ __forceinline__ void tr_issue(s16x4& lo, s16x4& hi, unsigned tb, int ks, int c) {
    const unsigned a = tb + (unsigned)(ks * 32 * LDT * 2 + c * 32);
    asm volatile("ds_read_b64_tr_b16 %0, %1" : "=&v"(lo) : "v"(a) : "memory");
    asm volatile("ds_read_b64_tr_b16 %0, %1 offset:1088" : "=&v"(hi) : "v"(a) : "memory");
}
#define TRPK(L, H) (bf16x8){L[0], L[1], L[2], L[3], H[0], H[1], H[2], H[3]}
__device__ __forceinline__ void lds_mma128_tt(f32x4 (&acc)[4][2], const LAS unsigned char* TA, const LAS unsigned char* TB, int wr, int wc, int lane) {
    const unsigned ta = (unsigned)(size_t)TA + tr_lane_off(lane), tb = (unsigned)(size_t)TB + tr_lane_off(lane);
#pragma unroll
    for (int k0 = 0; k0 < 4; ++k0) {
        s16x4 al[4], ah[4], bl[2], bh[2];
#pragma unroll
        for (int m = 0; m < 4; ++m) tr_issue(al[m], ah[m], ta, k0, wr * 4 + m);
#pragma unroll
        for (int n = 0; n < 2; ++n) tr_issue(bl[n], bh[n], tb, k0, wc * 2 + n);
        asm volatile("s_waitcnt lgkmcnt(0)" ::: "memory"); __builtin_amdgcn_sched_barrier(0);
#pragma unroll
        for (int m = 0; m < 4; ++m)
#pragma unroll
            for (int n = 0; n < 2; ++n) acc[m][n] = __builtin_amdgcn_mfma_f32_16x16x32_bf16(TRPK(bl[n], bh[n]), TRPK(al[m], ah[m]), acc[m][n], 0, 0, 0);
    }
}
__device__ __forceinline__ void lds_mma128_nt(f32x4 (&acc)[4][2], const LAS unsigned char* A, const LAS unsigned char* TB, int wr, int wc, int fr, int fq, int lane) {
    const unsigned tb = (unsigned)(size_t)TB + tr_lane_off(lane);
#pragma unroll
    for (int k0 = 0; k0 < 4; ++k0) {
        bf16x8 a[4]; s16x4 bl[2], bh[2];
#pragma unroll
        for (int n = 0; n < 2; ++n) tr_issue(bl[n], bh[n], tb, k0, wc * 2 + n);
#pragma unroll
        for (int m = 0; m < 4; ++m) a[m] = *(const LAS bf16x8*)(A + ((wr * 64 + m * 16 + fr) * LDT + k0 * 32 + fq * 8) * 2);
        asm volatile("s_waitcnt lgkmcnt(0)" ::: "memory"); __builtin_amdgcn_sched_barrier(0);
#pragma unroll
        for (int m = 0; m < 4; ++m)
#pragma unroll
            for (int n = 0; n < 2; ++n) acc[m][n] = __builtin_amdgcn_mfma_f32_16x16x32_bf16(TRPK(bl[n], bh[n]), a[m], acc[m][n], 0, 0, 0);
    }
}
__device__ __forceinline__ void tile_g2l(const bf16* g, size_t ld, LAS unsigned char* dst, int tid) {
    const int row = tid >> 2, seg = (tid & 3) * 32; const v4u* p = (const v4u*)(g + (size_t)row * ld + seg);
    v4u a = p[0], b = p[1], c = p[2], d = p[3];
    LAS v4u* q = (LAS v4u*)(dst + (row * LDT + seg) * 2);
    q[0] = a; q[1] = b; q[2] = c; q[3] = d;
}

__device__ __forceinline__ void tile_g2l_rope(const bf16* g, LAS unsigned char* dst, int tid, const f32x4 (&cs)[8], float sc) {
    const int r = tid >> 2, q = tid & 3, d1 = (q >> 1) * 64 + (q & 1) * 16, d2 = d1 + 32;
    const bf16* row = g + (size_t)r * INW;
    const v4u a0 = *(const v4u*)(row + d1), a1 = *(const v4u*)(row + d1 + 8), b0 = *(const v4u*)(row + d2), b1 = *(const v4u*)(row + d2 + 8);
    v4u o1[2], o2[2];
#pragma unroll
    for (int i = 0; i < 8; ++i) {
        const unsigned wa = (i < 4) ? a0[i & 3] : a1[i & 3], wb = (i < 4) ? b0[i & 3] : b1[i & 3];
        const float x1l = bflo(wa), x1h = bfhi(wa), x2l = bflo(wb), x2h = bfhi(wb);
        const float cl = cs[i][0], sl = cs[i][1], ch = cs[i][2], sh = cs[i][3];
        o1[i >> 2][i & 3] = pk2((x1l * cl - x2l * sl) * sc, (x1h * ch - x2h * sh) * sc); o2[i >> 2][i & 3] = pk2((x2l * cl + x1l * sl) * sc, (x2h * ch + x1h * sh) * sc);
    }
    LAS v4u* p = (LAS v4u*)(dst + (r * LDT + d1) * 2); p[0] = o1[0]; p[1] = o1[1];
    p = (LAS v4u*)(dst + (r * LDT + d2) * 2); p[0] = o2[0]; p[1] = o2[1];
}

__device__ __forceinline__ void ret_prep_task(const Frame& F, int task, bf16* PROJ, const f32x2* ROPE, bf16* VT, bf16* L, float lgf, float lgb, bool wb = true) {
    int tid = TID_(F.wave); asm volatile("" : "+v"(tid));
    const int b = task >> 9, h = (task >> 6) & 7, c = task & 63;
    const int r = tid >> 2, q = tid & 3, half = q >> 1, sub = q & 1;
    const int t = c * 128 + r, pos = half ? (t & 63) : (t >> 6);
    const f32x4* rp = (const f32x4*)(ROPE + pos * 32 + sub * 16);
    const int d1 = half * 64 + sub * 16, d2 = d1 + 32;
    const size_t tok = (size_t)b * SEQ + t;
    LAS unsigned char* B0 = F.lds; LAS unsigned char* B1 = F.lds + TILE_B; LAS unsigned char* B2 = F.lds + 2 * TILE_B;
    f32x4 cs[8];
#pragma unroll
    for (int i = 0; i < 8; ++i) cs[i] = rp[i];
    {
        bf16* row = PROJ + tok * INW + C_RK + h * 128;
        v4u a0 = *(const v4u*)(row + d1), a1 = *(const v4u*)(row + d1 + 8), b0 = *(const v4u*)(row + d2), b1 = *(const v4u*)(row + d2 + 8);
        const float wf = __expf(lgf * (float)(127 - r)), wb_ = __expf(lgb * (float)r);
        v4u o1[2], o2[2], f1[2], f2[2], g1[2], g2[2];
#pragma unroll
        for (int i = 0; i < 8; ++i) {
            const unsigned wa = (i < 4) ? a0[i & 3] : a1[i & 3], wb = (i < 4) ? b0[i & 3] : b1[i & 3];
            const float x1l = bflo(wa), x1h = bfhi(wa), x2l = bflo(wb), x2h = bfhi(wb);
            const float cl = cs[i][0], sl = cs[i][1], ch = cs[i][2], sh = cs[i][3];
            const float sc = 0.08838834764831845f;
            const float y1l = (x1l * cl - x2l * sl) * sc, y2l = (x2l * cl + x1l * sl) * sc, y1h = (x1h * ch - x2h * sh) * sc, y2h = (x2h * ch + x1h * sh) * sc;
            o1[i >> 2][i & 3] = pk2(y1l, y1h); o2[i >> 2][i & 3] = pk2(y2l, y2h);
            f1[i >> 2][i & 3] = pk2(y1l * wf, y1h * wf); f2[i >> 2][i & 3] = pk2(y2l * wf, y2h * wf);
            g1[i >> 2][i & 3] = pk2(y1l * wb_, y1h * wb_); g2[i >> 2][i & 3] = pk2(y2l * wb_, y2h * wb_);
        }
        { LAS v4u* p = (LAS v4u*)(B0 + (r * LDT + d1) * 2); p[0] = f1[0]; p[1] = f1[1]; p = (LAS v4u*)(B0 + (r * LDT + d2) * 2); p[0] = f2[0]; p[1] = f2[1];
          p = (LAS v4u*)(B1 + (r * LDT + d1) * 2); p[0] = g1[0]; p[1] = g1[1]; p = (LAS v4u*)(B1 + (r * LDT + d2) * 2); p[0] = g2[0]; p[1] = g2[1]; }
        (void)o1; (void)o2; (void)wb;
    }
    {
        const bf16* row = PROJ + tok * INW + C_RV + h * 128 + q * 32;
        v4u vv[4];
#pragma unroll
        for (int i = 0; i < 4; ++i) vv[i] = *(const v4u*)(row + 8 * i);
        LAS v4u* p = (LAS v4u*)(B2 + (r * LDT + q * 32) * 2);
#pragma unroll
        for (int i = 0; i < 4; ++i) p[i] = vv[i];
    }
    __syncthreads();
    const int wid = __builtin_amdgcn_readfirstlane(tid >> 6), lane = tid & 63, wr = wid >> 2, wc = wid & 3, fr = lane & 15, fq = lane >> 4;
#pragma unroll
    for (int dir = 0; dir < 2; ++dir) {
        f32x4 acc[4][2]; zero_acc(acc);
        lds_mma128_tt(acc, B2, dir ? B1 : B0, wr, wc, lane);
        bf16* Lp = L + ((size_t)(((b * 8 + h) * 2 + dir) * NCH + c)) * 16384;
#pragma unroll
        for (int m = 0; m < 4; ++m)
#pragma unroll
            for (int n = 0; n < 2; ++n) { v2u w; w.x = pk2(acc[m][n][0], acc[m][n][1]); w.y = pk2(acc[m][n][2], acc[m][n][3]);
                *(v2u*)(Lp + (wr * 64 + m * 16 + fr) * 128 + wc * 32 + n * 16 + fq * 4) = w; }
    }
    __syncthreads();
}


__device__ __forceinline__ void qknorm_task(const Frame& F, int task, bf16* PROJ, const f32x2* ROPE, const float* qnw, const float* knw, bf16* scratch = nullptr) {
    int tid = TID_(F.wave); asm volatile("" : "+v"(tid));
    const int tile = task / 10, hh = task - tile * 10;
    const int r = tid >> 2, q = tid & 3, half = q >> 1, sub = q & 1;
    const int tokg = tile * 128 + r, t = tokg & (SEQ - 1), pos = half ? (t & 63) : (t >> 6);
    const int col0 = hh < 8 ? C_AQ + hh * 128 : C_AK + (hh - 8) * 128; const float* w = hh < 8 ? qnw : knw;
    const int d1 = half * 64 + sub * 16, d2 = d1 + 32;
    bf16* row = PROJ + (size_t)tokg * INW + col0;
    const v4u a0 = *(const v4u*)(row + d1), a1 = *(const v4u*)(row + d1 + 8), b0 = *(const v4u*)(row + d2), b1 = *(const v4u*)(row + d2 + 8);
    const f32x4* rp = (const f32x4*)(ROPE + pos * 32 + sub * 16);
    f32x4 cs[8], w1[4], w2[4];
#pragma unroll
    for (int i = 0; i < 8; ++i) cs[i] = rp[i];
#pragma unroll
    for (int i = 0; i < 4; ++i) { w1[i] = *(const f32x4*)(w + d1 + 4 * i); w2[i] = *(const f32x4*)(w + d2 + 4 * i); }
    float x1[16], x2[16]; float ss = 0.f;
#pragma unroll
    for (int i = 0; i < 8; ++i) { const unsigned wa = (i < 4) ? a0[i & 3] : a1[i & 3], wb = (i < 4) ? b0[i & 3] : b1[i & 3];
        x1[2 * i] = bflo(wa); x1[2 * i + 1] = bfhi(wa); x2[2 * i] = bflo(wb); x2[2 * i + 1] = bfhi(wb);
        ss += (x1[2 * i] * x1[2 * i] + x1[2 * i + 1] * x1[2 * i + 1]) + (x2[2 * i] * x2[2 * i] + x2[2 * i + 1] * x2[2 * i + 1]); }
    ss += __shfl_xor(ss, 1); ss += __shfl_xor(ss, 2);
    const float rs = 1.0f / sqrtf(ss * (1.0f / 128.0f) + EPS);
    v4u o1[2], o2[2];
#pragma unroll
    for (int i = 0; i < 8; ++i) {
        const float x1l = x1[2 * i] * rs * w1[i >> 1][(2 * i) & 3], x1h = x1[2 * i + 1] * rs * w1[i >> 1][(2 * i + 1) & 3];
        const float x2l = x2[2 * i] * rs * w2[i >> 1][(2 * i) & 3], x2h = x2[2 * i + 1] * rs * w2[i >> 1][(2 * i + 1) & 3];
        const float cl = cs[i][0], sl = cs[i][1], ch = cs[i][2], sh = cs[i][3];
        o1[i >> 2][i & 3] = pk2(x1l * cl - x2l * sl, x1h * ch - x2h * sh); o2[i >> 2][i & 3] = pk2(x2l * cl + x1l * sl, x2h * ch + x1h * sh);
    }
    bf16* drow = scratch ? scratch + (size_t)(task & 255) * 16384 + r * 128 : row;
    *(v4u*)(drow + d1) = o1[0]; *(v4u*)(drow + d1 + 8) = o1[1]; *(v4u*)(drow + d2) = o2[0]; *(v4u*)(drow + d2 + 8) = o2[1];
}

__device__ __forceinline__ void ret_out_task(const Frame& F, int task, bf16* PROJ, const f32x2* ROPE, const bf16* ST, const float* gnw, const float* gnb, float lgf, float lgb, bf16* scratch = nullptr) {
    int tid = TID_(F.wave); asm volatile("" : "+v"(tid));
    const int b = task >> 9, h = (task >> 6) & 7, c = task & 63;
    const size_t tok0 = (size_t)b * SEQ + (size_t)c * 128;
    LAS unsigned char* B0 = F.lds; LAS unsigned char* B1 = F.lds + TILE_B; LAS unsigned char* B2 = F.lds + 2 * TILE_B; LAS unsigned char* B3 = F.lds + 3 * TILE_B;
    LAS float* red1 = (LAS float*)(F.lds + RED_OFF); LAS float* red2 = red1 + 512;
    const size_t sf = ((size_t)(((b * 8 + h) * 2 + 0) * NCH + c)) * 16384, sb = ((size_t)(((b * 8 + h) * 2 + 1) * NCH + c)) * 16384;
    {
        const int r = tid >> 2, q4 = tid & 3, t = c * 128 + r, pos = (q4 >> 1) ? (t & 63) : (t >> 6);
        const f32x4* rp = (const f32x4*)(ROPE + pos * 32 + (q4 & 1) * 16);
        f32x4 cs[8];
#pragma unroll
        for (int i = 0; i < 8; ++i) cs[i] = rp[i];
        tile_g2l_rope(PROJ + tok0 * INW + C_RQ + h * 128, B0, tid, cs, 1.0f);
        tile_g2l_rope(PROJ + tok0 * INW + C_RK + h * 128, B1, tid, cs, 0.08838834764831845f);
    }
    tile_g2l(PROJ + tok0 * INW + C_RV + h * 128, INW, B2, tid);
    tile_g2l(ST + sf, 128, B3, tid);
    v4u sbr[4];
    { const v4u* p = (const v4u*)(ST + sb + (size_t)(tid >> 2) * 128 + (tid & 3) * 32); sbr[0] = p[0]; sbr[1] = p[1]; sbr[2] = p[2]; sbr[3] = p[3]; }
    const int wid = __builtin_amdgcn_readfirstlane(tid >> 6), lane = tid & 63, wr = wid >> 2, wc = wid & 3, fr = lane & 15, fq = lane >> 4;
    v2u rgv[4][2];
#pragma unroll
    for (int m = 0; m < 4; ++m)
#pragma unroll
        for (int n = 0; n < 2; ++n) rgv[m][n] = *(const v2u*)(PROJ + (tok0 + wr * 64 + m * 16 + fr) * INW + C_RG + h * 128 + wc * 32 + n * 16 + fq * 4);
    __syncthreads();
    f32x4 accS[4][2], accO[4][2];
    zero_acc(accS); zero_acc(accO);
    lds_mma128(accS, B0, B1, wr, wc, fr, fq);
    lds_mma128(accO, B0, B3, wr, wc, fr, fq);
    __syncthreads();
#pragma unroll
    for (int m = 0; m < 4; ++m) { const int nrow = wr * 64 + m * 16 + fr; const float df = __expf(lgf * (float)(nrow + 1));
#pragma unroll
        for (int n = 0; n < 2; ++n) { const int mc0 = wc * 32 + n * 16 + fq * 4; float p[4];
#pragma unroll
            for (int j = 0; j < 4; ++j) { const int d = nrow - (mc0 + j); const float dec = __expf((float)d * (d >= 0 ? lgf : -lgb)); p[j] = accS[m][n][j] * dec; }
            v2u w; w.x = pk2(p[0], p[1]); w.y = pk2(p[2], p[3]);
            *(LAS v2u*)(B1 + (nrow * LDT + mc0) * 2) = w;
            accO[m][n] = accO[m][n] * df; } }
    { LAS v4u* q = (LAS v4u*)(B3 + ((tid >> 2) * LDT + (tid & 3) * 32) * 2); q[0] = sbr[0]; q[1] = sbr[1]; q[2] = sbr[2]; q[3] = sbr[3]; }
    __syncthreads();
    lds_mma128_nt(accO, B1, B2, wr, wc, fr, fq, lane);
    zero_acc(accS);
    lds_mma128(accS, B0, B3, wr, wc, fr, fq);
    float mean[4], rstd[4];
#pragma unroll
    for (int m = 0; m < 4; ++m) { const int nrow = wr * 64 + m * 16 + fr; const float db = __expf(lgb * (float)(128 - nrow)); float s = 0.f;
#pragma unroll
        for (int n = 0; n < 2; ++n) { accO[m][n] = accO[m][n] + accS[m][n] * db; s += (accO[m][n][0] + accO[m][n][1]) + (accO[m][n][2] + accO[m][n][3]); }
        s += __shfl_xor(s, 16); s += __shfl_xor(s, 32);
        if (fq == 0) red1[nrow * 4 + wc] = s; }
    __syncthreads();
#pragma unroll
    for (int m = 0; m < 4; ++m) { const int nrow = wr * 64 + m * 16 + fr; const f32x4 pr = *(const LAS f32x4*)(red1 + nrow * 4);
        mean[m] = ((pr[0] + pr[1]) + (pr[2] + pr[3])) * (1.0f / 128.0f); float s = 0.f;
#pragma unroll
        for (int n = 0; n < 2; ++n) { const f32x4 d = accO[m][n] - mean[m]; s += (d[0] * d[0] + d[1] * d[1]) + (d[2] * d[2] + d[3] * d[3]); }
        s += __shfl_xor(s, 16); s += __shfl_xor(s, 32);
        if (fq == 0) red2[nrow * 4 + wc] = s; }
    __syncthreads();
#pragma unroll
    for (int m = 0; m < 4; ++m) { const int nrow = wr * 64 + m * 16 + fr; const f32x4 pr = *(const LAS f32x4*)(red2 + nrow * 4);
        rstd[m] = 1.0f / sqrtf(((pr[0] + pr[1]) + (pr[2] + pr[3])) * (1.0f / 128.0f) + EPS);
        bf16* grow = PROJ + (tok0 + nrow) * INW + C_RG + h * 128;
#pragma unroll
        for (int n = 0; n < 2; ++n) { const int col = wc * 32 + n * 16 + fq * 4;
            const f32x4 gw = *(const f32x4*)(gnw + h * 128 + col), gb = *(const f32x4*)(gnb + h * 128 + col);
            const v2u gv = rgv[m][n];
            const float g0 = bflo(gv.x), g1 = bfhi(gv.x), g2 = bflo(gv.y), g3 = bfhi(gv.y);
            const f32x4 y = (accO[m][n] - mean[m]) * rstd[m] * gw + gb;
            const float o0 = y[0] * g0 / (1.0f + __expf(-g0)), o1 = y[1] * g1 / (1.0f + __expf(-g1)), o2 = y[2] * g2 / (1.0f + __expf(-g2)), o3 = y[3] * g3 / (1.0f + __expf(-g3));
            v2u w; w.x = pk2(o0, o1); w.y = pk2(o2, o3); bf16* dst = scratch ? scratch + (size_t)(task & 255) * 16384 + nrow * 128 : grow; *(v2u*)(dst + col) = w; } }
    __syncthreads();
}

__device__ __forceinline__ void scan_states(int bid, int tid, int G, const float* dec_f, const float* dec_b, const bf16* L, bf16* ST) {
        for (int e = bid * 512 + tid; e < 32 * 4096; e += G * 512) {
            const int series = e >> 12, off4 = e & 4095, dir = series & 1, h = (series >> 1) & 7;
            const float lg = -expf(dir ? dec_b[h] : dec_f[h]); const float g128 = expf(lg * 128.0f);
            const v2u* Lp = (const v2u*)(L + (size_t)series * NCH * 16384) + off4; v2u* Sp = (v2u*)(ST + (size_t)series * NCH * 16384) + off4;
            f32x4 s = (f32x4){0.f, 0.f, 0.f, 0.f};
            if (dir == 0) {
                for (int c0 = 0; c0 < NCH; c0 += 8) { v2u l[8];
#pragma unroll
                    for (int i = 0; i < 8; ++i) l[i] = Lp[(size_t)(c0 + i) * 4096];
#pragma unroll
                    for (int i = 0; i < 8; ++i) { v2u w; w.x = pk2(s[0], s[1]); w.y = pk2(s[2], s[3]); Sp[(size_t)(c0 + i) * 4096] = w; s = s * g128 + (f32x4){bflo(l[i].x), bfhi(l[i].x), bflo(l[i].y), bfhi(l[i].y)}; } }
            } else {
                for (int c0 = NCH - 8; c0 >= 0; c0 -= 8) { v2u l[8];
#pragma unroll
                    for (int i = 0; i < 8; ++i) l[i] = Lp[(size_t)(c0 + i) * 4096];
#pragma unroll
                    for (int i = 7; i >= 0; --i) { v2u w; w.x = pk2(s[0], s[1]); w.y = pk2(s[2], s[3]); Sp[(size_t)(c0 + i) * 4096] = w; s = s * g128 + (f32x4){bflo(l[i].x), bfhi(l[i].x), bflo(l[i].y), bfhi(l[i].y)}; } }
            }
        }
}

__global__ void __launch_bounds__(NWAVES * 64, 2) mega_fwd(Args args) {
    extern __shared__ __attribute__((aligned(16))) unsigned char lds[];
    cg::grid_group grid = cg::this_grid();
    Frame F;
    F.lds = (LAS unsigned char*)lds; F.ldsg = (char*)lds;
    F.wave = __builtin_amdgcn_readfirstlane((int)threadIdx.x >> 6); F.tid = 0; F.lane = 0;
    F.G = gridDim.x; { const int bx = blockIdx.x; F.vcu = (F.G % 8 == 0) ? (bx % 8) * (F.G / 8) + bx / 8 : bx; }
    unsigned char* ws = args.ws;
    const float* x = args.in[0]; const float* mem = args.in[1]; const float* norm_mix_w = args.in[2]; const float* w_in = args.in[3];
    const float* dec_f = args.in[4]; const float* dec_b = args.in[5]; const float* gnw = args.in[6]; const float* gnb = args.in[7];
    const float* qnw = args.in[8]; const float* knw = args.in[9]; const float* w_out = args.in[10]; const float* norm_cross_w = args.in[11];
    const float* norm_mem_w = args.in[12]; const float* wcq = args.in[13]; const float* wck = args.in[14]; const float* wcv = args.in[15];
    const float* wco = args.in[16]; const float* norm_mlp_w = args.in[17]; const float* w_up = args.in[18]; const float* w_dn = args.in[19];
    const float* norm_final_w = args.in[20];
    float* out = args.out;
    f32x2* ROPE = (f32x2*)(ws + WS_ROPE);
    float* SS1 = (float*)(ws + WS_SS1); float* SS2 = (float*)(ws + WS_SS2); float* SS3 = (float*)(ws + WS_SS3);
    bf16* KVC = (bf16*)(ws + WS_KVC);
    bf16* WIN = (bf16*)(ws + WS_WIN); bf16* WOUT = (bf16*)(ws + WS_WOUT); bf16* WQ = (bf16*)(ws + WS_WQ); bf16* WKV = (bf16*)(ws + WS_WKV);
    bf16* WO = (bf16*)(ws + WS_WO); bf16* WUP = (bf16*)(ws + WS_WUP); bf16* WDN = (bf16*)(ws + WS_WDN);
    bf16* XN = (bf16*)(ws + WS_XN); bf16* MN = (bf16*)(ws + WS_MN); bf16* PROJ = (bf16*)(ws + WS_PROJ); bf16* VT = (bf16*)(ws + WS_VT);
    bf16* ST = (bf16*)(ws + WS_ST); bf16* QC = (bf16*)(ws + WS_QC); bf16* U = (bf16*)(ws + WS_U);
    bf16* L = (bf16*)out;
    if (args.coop == 2) grid.sync();
    const int lo = args.ph_lo, hi = args.ph_hi;
    volatile LAS unsigned* misc = (volatile LAS unsigned*)(F.lds + MISC_OFF);
    if (TID_(F.wave) < 4) misc[TID_(F.wave)] = 0u;
    __syncthreads();
    XcdBarrier xbar; xbar.bar = (unsigned*)(ws + WS_CTL); xbar.x = 0; xbar.st = nullptr;
    if (args.coop == 1) xbar = xcd_barrier_post((unsigned*)(ws + WS_CTL), misc, TID_(F.wave) == 0);
#ifndef PH_MASK
#define PH_MASK 0xfff
#endif
#define IN(k) ((((PH_MASK) >> (k)) & 1) && lo <= (k) && (k) < hi)
#ifndef REPS
#define REPS 1
#endif
#define SEAM(k) do { if (IN(k) && IN((k) + 1)) { if (args.coop == 1) { for (int rs_ = 0; rs_ < REPS; ++rs_) xcd_barrier(xbar, TID_(F.wave) == 0); } } } while (0)
    const int gw = F.vcu * NWAVES + F.wave, NGW = F.G * NWAVES;
    const int bid = blockIdx.x, G = F.G;

#ifndef REP0
#define REP0 1
#endif
    if (IN(0)) for (int rep_ = 0; rep_ < REP0; ++rep_) {
        __syncthreads();
        LAS float* scr = (LAS float*)(F.lds + F.wave * 18432);
        constexpr int I_IN = (DM / 64) * (INW / 64), I_C = (DM / 64) * (CWID / 64);
        constexpr int NITEMS = I_IN + 2 * I_C;
        for (int it = NGW - 1 - gw; it < NITEMS; it += NGW) {
            int r = it;
            if (r < I_IN) { const int n0 = 64 * (r % (INW / 64)); const int roff = n0 < DEF_C0 ? 0 : (n0 < DEF_C0 + DEF_W ? (INW - DEF_W) - DEF_C0 : -DEF_W);
                            p0_transpose_item(w_in, DM, INW, WIN, roff, nullptr, scr, r, lane_id_()); continue; } r -= I_IN;
            if (r < I_C) { p0_transpose_item(wck, DM, CWID, WKV, 0, nullptr, scr, r, lane_id_()); continue; } r -= I_C;
            p0_transpose_item(wcv, DM, CWID, WKV, CWID, nullptr, scr, r, lane_id_());
        }
        if (G != 256) {
            constexpr int I_OUT = (DM / 64) * (DM / 64), I_CO = (CWID / 64) * (DM / 64), I_UP = (DM / 64) * (DFF / 64), I_DN = (DFF / 64) * (DM / 64);
            for (int it = gw; it < I_OUT + I_C + I_CO + I_UP + I_DN; it += NGW) {
                int r = it;
                if (r < I_OUT) { p0_transpose_item(w_out, DM, DM, WOUT, 0, nullptr, scr, r, lane_id_()); continue; } r -= I_OUT;
                if (r < I_C) { p0_transpose_item(wcq, DM, CWID, WQ, 0, norm_cross_w, scr, r, lane_id_()); continue; } r -= I_C;
                if (r < I_CO) { p0_transpose_item(wco, CWID, DM, WO, 0, nullptr, scr, r, lane_id_()); continue; } r -= I_CO;
                if (r < I_UP) { p0_transpose_item(w_up, DM, DFF, WUP, 0, norm_mlp_w, scr, r, lane_id_()); continue; } r -= I_UP;
                p0_transpose_item(w_dn, DFF, DM, WDN, 0, nullptr, scr, r, lane_id_());
            }
        }
        for (int m = gw; m < M + MROWS; m += NGW) {
            if (m < M) rms_row_to_bf16(x + (size_t)m * DM, norm_mix_w, XN + (size_t)m * DM, lane_id_());
            else rms_row_to_bf16(mem + (size_t)(m - M) * DM, norm_mem_w, MN + (size_t)(m - M) * DM, lane_id_());
        }
        for (int e = bid * 16 + TID_(F.wave); TID_(F.wave) < 16 && e < 128 * 32; e += G * 16) {
            const int pos = e >> 5, i = e & 31;
            double f = 1.0; for (int k = 0; k < i; ++k) f *= 0.7498942093324559;
            const float invf = (float)f; const float angf = (float)pos * invf; const double a = (double)angf;
            const double kk = __builtin_rint(a * 0.15915494309189535); const double r = a - kk * 6.283185307179586477;
            const double r2 = r * r; double tc = 1.0, cc = 1.0, ts = r, sn = r;
#pragma unroll
            for (int n = 1; n <= 16; ++n) { tc *= -r2 * (1.0 / (double)((2 * n - 1) * (2 * n))); cc += tc; ts *= -r2 * (1.0 / (double)((2 * n) * (2 * n + 1))); sn += ts; }
            ROPE[e] = (f32x2){(float)cc, (float)sn};
        }
    }
    SEAM(0);

#ifndef REP1
#define REP1 1
#endif
    if (IN(1)) for (int rep_ = 0; rep_ < REP1; ++rep_) {
        __syncthreads();
        { pg8::Gemm g{XN, WIN, M, INW - DEF_W, DM, DM}; pg8::StaticOrder S; S.init(M, INW - DEF_W, G, bid);
          pg8::EpiBf<0> E{PROJ, INW, nullptr, DEF_C0 / 256, DEF_W / 256};
          pg8::gemm_phase<pg8::EpiBf<0>, pg8::StaticOrder, false, true>(F.lds, g, S, E, F.wave);
#ifdef PROBE_P1X2
          __syncthreads(); pg8::gemm_phase<pg8::EpiBf<0>, pg8::StaticOrder, false, true>(F.lds, g, S, E, F.wave);
#endif
        }
    }
    SEAM(1);

    if (IN(2)) {
        const bool split = (G == 256);
        if (!split || bid < 128) {
            pg8::Gemm g{XN, WIN + (size_t)(INW - DEF_W) * DM, M, DEF_W, DM, DM}; pg8::StaticOrder S; S.init(M, DEF_W, split ? 128 : G, bid);
            pg8::EpiBf<0> E{PROJ + DEF_C0, INW, nullptr, 0, 0};
            pg8::gemm_phase<pg8::EpiBf<0>, pg8::StaticOrder, false, true>(F.lds, g, S, E, F.wave);
        }
        if (!split || (bid >= 128 && bid < 136)) {
            pg8::Gemm g{MN, WKV, MROWS, 2 * CWID, DM, DM}; pg8::StaticOrder S; S.init(MROWS, 2 * CWID, split ? 8 : G, split ? bid - 128 : bid);
            pg8::EpiBf<0> E{KVC, 2 * CWID, nullptr, 0, 0};
            pg8::gemm_phase<pg8::EpiBf<0>, pg8::StaticOrder, false, true>(F.lds, g, S, E, F.wave);
        }
        {
            const int tb = split ? bid - 136 : bid, tg = split ? 120 : G;
            if (tb >= 0) {
                __syncthreads();
                LAS float* scr = (LAS float*)(F.lds + F.wave * 18432);
                constexpr int I_OUT = (DM / 64) * (DM / 64), I_C = (DM / 64) * (CWID / 64), I_CO = (CWID / 64) * (DM / 64);
                for (int it = tb * NWAVES + F.wave; it < I_OUT + I_C + I_CO; it += tg * NWAVES) {
                    int r = it;
                    if (r < I_OUT) { p0_transpose_item(w_out, DM, DM, WOUT, 0, nullptr, scr, r, lane_id_()); continue; } r -= I_OUT;
                    if (r < I_C) { p0_transpose_item(wcq, DM, CWID, WQ, 0, norm_cross_w, scr, r, lane_id_()); continue; } r -= I_C;
                    p0_transpose_item(wco, CWID, DM, WO, 0, nullptr, scr, r, lane_id_());
                }
            }
        }
        {
            unsigned* task_ctr = (unsigned*)(ws + WS_CTL) + 3700;
            constexpr int NT_PREP = BATCH * 8 * NCH, NT_ALL = NT_PREP + (M / 128) * 2;
            for (;;) {
                __syncthreads();
                if (TID_(F.wave) == 0) misc[4] = __hip_atomic_fetch_add(task_ctr, 1u, __ATOMIC_RELAXED, __HIP_MEMORY_SCOPE_AGENT);
                __syncthreads();
                const int task = (int)misc[4];
                if (task >= NT_ALL) break;
                if (task < NT_PREP) { const int h = (task >> 6) & 7; const float lgf = -expf(dec_f[h]), lgb = -expf(dec_b[h]); ret_prep_task(F, task, PROJ, ROPE, VT, L, lgf, lgb); }
                else { const int t2 = task - NT_PREP; qknorm_task(F, (t2 >> 1) * 10 + 8 + (t2 & 1), PROJ, ROPE, qnw, knw); }
            }
        }
    }
    SEAM(2);

    if (IN(3) && args.coop != 1) { scan_states(bid, TID_(F.wave), G, dec_f, dec_b, L, ST); }
    if (args.coop != 1) SEAM(3);

    if (IN(4)) {
        unsigned* scan_cnt = (unsigned*)(ws + WS_CTL) + 3600;
        if (args.coop == 1) {
            scan_states(bid, TID_(F.wave), G, dec_f, dec_b, L, ST);
            asm volatile("s_waitcnt vmcnt(0)" ::: "memory");
            __syncthreads();
            if (TID_(F.wave) == 0) { __builtin_amdgcn_fence(__ATOMIC_RELEASE, "agent"); __hip_atomic_fetch_add(scan_cnt, 1u, __ATOMIC_RELAXED, __HIP_MEMORY_SCOPE_AGENT); }
        }
#ifdef PROBE_P4A
        for (int u = bid; u < 512; u += G) {
            const int bk = u >> 7, b = bk >> 1, kvh = bk & 1, g = (u >> 5) & 3, qb = u & 31, h = kvh * 4 + g;
            bf16* Qb = PROJ + ((size_t)b * SEQ + (size_t)qb * 256) * INW + C_AQ + h * 128;
            const bf16* Kh = PROJ + (size_t)b * SEQ * INW + C_AK + kvh * 128;
            bf16* Od = (bf16*)out + ((size_t)b * SEQ + (size_t)qb * 256) * 1024 + h * 128;
            att::attn_dense_body<INW, INW, 1024, C_AV - C_AK>((const att::bf16*)Qb, (const att::bf16*)Kh, (att::bf16*)Od, SEQ, F.ldsg, F.wave);
            __syncthreads();
        }
#endif
#ifdef PROBE_P4B
        for (int task = bid; task < BATCH * 8 * NCH; task += G) {
            const int h = (task >> 6) & 7;
            const float lgf = -expf(dec_f[h]), lgb = -expf(dec_b[h]);
            ret_out_task(F, task, PROJ, ROPE, ST, gnw, gnb, lgf, lgb, QC);
        }
#endif
#ifndef SKIP_ATT
        for (int u = bid; u < 512; u += G) {
            const int bk = u >> 7, b = bk >> 1, kvh = bk & 1, g = (u >> 5) & 3, qb = u & 31, h = kvh * 4 + g;
            bf16* Qb = PROJ + ((size_t)b * SEQ + (size_t)qb * 256) * INW + C_AQ + h * 128;
            const bf16* Kh = PROJ + (size_t)b * SEQ * INW + C_AK + kvh * 128;
            att::attn_dense_body<INW, INW, INW, C_AV - C_AK, true>((const att::bf16*)Qb, (const att::bf16*)Kh, (att::bf16*)Qb, SEQ, F.ldsg, F.wave, (const float*)ROPE, qnw, qb * 256);
            __syncthreads();
        }
#endif
#ifndef SKIP_RET
        if (args.coop == 1) {
            if (TID_(F.wave) == 0) { unsigned sp = 0; while (__hip_atomic_load(scan_cnt, __ATOMIC_RELAXED, __HIP_MEMORY_SCOPE_AGENT) < (unsigned)G && ++sp < (1u << 22)) __builtin_amdgcn_s_sleep(2);
                              __builtin_amdgcn_fence(__ATOMIC_ACQUIRE, "agent"); }
            __syncthreads();
        }
        if (args.coop == 1) {
            unsigned* out_ctr = (unsigned*)(ws + WS_CTL) + 3701;
            for (;;) {
                __syncthreads();
                if (TID_(F.wave) == 0) misc[4] = __hip_atomic_fetch_add(out_ctr, 1u, __ATOMIC_RELAXED, __HIP_MEMORY_SCOPE_AGENT);
                __syncthreads();
                const int task = (int)misc[4];
                if (task >= BATCH * 8 * NCH) break;
                const int h = (task >> 6) & 7;
                const float lgf = -expf(dec_f[h]), lgb = -expf(dec_b[h]);
                ret_out_task(F, task, PROJ, ROPE, ST, gnw, gnb, lgf, lgb);
            }
        } else
        for (int task = bid; task < BATCH * 8 * NCH; task += G) {
            const int h = (task >> 6) & 7;
            const float lgf = -expf(dec_f[h]), lgb = -expf(dec_b[h]);
            ret_out_task(F, task, PROJ, ROPE, ST, gnw, gnb, lgf, lgb);
        }
#endif
    }
    SEAM(4);

#ifndef REP5
#define REP5 1
#endif
    if (IN(5)) for (int rep_ = 0; rep_ < REP5; ++rep_) {
        __syncthreads();
        pg8::Gemm g{PROJ + C_RG, WOUT, M, DM, DM, INW}; pg8::StaticOrder S; S.init(M, DM, G, bid);
        pg8::EpiResid E{x, nullptr, nullptr, XN, SS1};
        pg8::gemm_phase<pg8::EpiResid, pg8::StaticOrder, false, true>(F.lds, g, S, E, F.wave);
    }
    SEAM(5);

#ifndef REP6
#define REP6 1
#endif
    if (IN(6)) {
        {
            pg8::Gemm g{XN, WQ, M, CWID, DM, DM}; pg8::StaticOrder S; S.init(M, CWID, G, bid);
            pg8::EpiBf<1> E{QC, CWID, SS1};
            pg8::gemm_phase<pg8::EpiBf<1>, pg8::StaticOrder, false, true>(F.lds, g, S, E, F.wave);
        }
        const bool hand = (args.coop == 1 && G == 256);
        unsigned* qflag = (unsigned*)(ws + WS_CTL) + 3800;
        if (args.coop == 1 && (!hand || bid < 128)) {
            int bx = bid; asm volatile("" : "+s"(bx));
            pg8::StaticOrder S2; S2.init(M, CWID, G, bx); pg8::Unit uq;
            if (S2.next(0, uq)) {
                asm volatile("s_waitcnt vmcnt(0)" ::: "memory");
                __syncthreads();
                if (hand && TID_(F.wave) == 0) { __builtin_amdgcn_fence(__ATOMIC_RELEASE, "agent"); asm volatile("s_waitcnt vmcnt(0)" ::: "memory"); __hip_atomic_store(qflag + bx, 1u, __ATOMIC_RELAXED, __HIP_MEMORY_SCOPE_AGENT); }
                const int b = uq.pm >> 5, qb = uq.pm & 31;
                bf16* Qb = QC + ((size_t)b * SEQ + (size_t)qb * 256) * CWID + uq.pn * 256;
                const bf16* Kh = KVC + (size_t)b * MEMT * (2 * CWID) + uq.pn * 256;
                att::attn_dense_body<CWID, 2 * CWID, CWID, CWID>((const att::bf16*)Qb, (const att::bf16*)Kh, (att::bf16*)Qb, MEMT, F.ldsg, F.wave);
                __syncthreads();
                if (!hand) {
                att::attn_dense_body<CWID, 2 * CWID, CWID, CWID>((const att::bf16*)(Qb + 128), (const att::bf16*)(Kh + 128), (att::bf16*)(Qb + 128), MEMT, F.ldsg, F.wave);
                __syncthreads();
                }
            }
        }
        if (G == 256 && bid >= 128) {
            LAS float* scr = (LAS float*)(F.lds + F.wave * 18432);
            const int w0 = (bid - 128) * NWAVES + F.wave, nw = 128 * NWAVES;
            constexpr int I_DN = (DFF / 64) * (DM / 64), I_UP = (DM / 64) * (DFF / 64);
            for (int it = w0; it < I_UP + I_DN; it += nw) {
                if (it < I_UP) p0_transpose_item(w_up, DM, DFF, WUP, 0, norm_mlp_w, scr, it, lane_id_());
                else p0_transpose_item(w_dn, DFF, DM, WDN, 0, nullptr, scr, it - I_UP, lane_id_());
            }
            if (hand) {
                int bx = bid - 128; asm volatile("" : "+s"(bx));
                pg8::StaticOrder S2; S2.init(M, CWID, G, bx); pg8::Unit uq;
                if (S2.next(0, uq)) {
                    __syncthreads();
                    if (TID_(F.wave) == 0) { unsigned sp = 0u; while (__hip_atomic_load(qflag + bx, __ATOMIC_RELAXED, __HIP_MEMORY_SCOPE_AGENT) != 1u && ++sp < (1u << 22)) __builtin_amdgcn_s_sleep(2);
                                             __builtin_amdgcn_fence(__ATOMIC_ACQUIRE, "agent"); asm volatile("s_waitcnt vmcnt(0)" ::: "memory"); }
                    __syncthreads();
                    const int b = uq.pm >> 5, qb = uq.pm & 31;
                    bf16* Qb = QC + ((size_t)b * SEQ + (size_t)qb * 256) * CWID + uq.pn * 256 + 128;
                    const bf16* Kh = KVC + (size_t)b * MEMT * (2 * CWID) + uq.pn * 256 + 128;
                    att::attn_dense_body<CWID, 2 * CWID, CWID, CWID>((const att::bf16*)Qb, (const att::bf16*)Kh, (att::bf16*)Qb, MEMT, F.ldsg, F.wave);
                    __syncthreads();
                }
            }
        }
    }
    if (args.coop != 1) SEAM(6);

    if (IN(7) && args.coop != 1) {
        for (int u = bid; u < BATCH * 4 * 32; u += G) {
            const int b = u >> 7, h = (u >> 5) & 3, qb = u & 31;
            bf16* Qb = QC + ((size_t)b * SEQ + (size_t)qb * 256) * CWID + h * 128;
            const bf16* Kh = KVC + (size_t)b * MEMT * (2 * CWID) + h * 128;
            att::attn_dense_body<CWID, 2 * CWID, CWID, CWID>((const att::bf16*)Qb, (const att::bf16*)Kh, (att::bf16*)Qb, MEMT, F.ldsg, F.wave);
            __syncthreads();
        }
    }
    SEAM(7);

    if (IN(8)) {
        pg8::Gemm g{QC, WO, M, DM, CWID, CWID}; pg8::StaticOrder S; S.init(M, DM, G, bid);
        pg8::EpiResid E{nullptr, XN, nullptr, XN, SS2};
        pg8::gemm_phase<pg8::EpiResid, pg8::StaticOrder, false, true>(F.lds, g, S, E, F.wave);
    }
    SEAM(8);

#ifdef PROBE_IDLE
    { if (TID_(F.wave) == 0) { const unsigned long long t0 = __builtin_amdgcn_s_memrealtime(); while (__builtin_amdgcn_s_memrealtime() - t0 < 20000ull) __builtin_amdgcn_s_sleep(64); } __syncthreads(); }
#endif
    if (IN(9)) {
        pg8::Gemm g{XN, WUP, M, DFF, DM, DM}; pg8::StaticOrder S; S.init(M, DFF, G, bid);
        if (G == 256) {
            LAS float* rsl = (LAS float*)(F.lds + 131072);
            pg8::Unit u0; const int t = TID_(F.wave);
            if (S.next(0, u0) && t < 256) { const f32x4* p = (const f32x4*)(SS2 + (size_t)(u0.pm * 256 + t) * 32); float a = 0.f;
#pragma unroll
                for (int i = 0; i < 8; ++i) { const f32x4 v = p[i]; a += (v[0] + v[1]) + (v[2] + v[3]); }
                rsl[t] = 1.0f / sqrtf(a * (1.0f / 2048.0f) + EPS); }
            __syncthreads();
            pg8::EpiBf<3> E{U, DFF, SS2, 0, 0, (const PG8_LAS float*)rsl};
            pg8::gemm_phase<pg8::EpiBf<3>, pg8::StaticOrder, false, true>(F.lds, g, S, E, F.wave);
        } else {
        pg8::EpiBf<2> E{U, DFF, SS2};
        pg8::gemm_phase<pg8::EpiBf<2>, pg8::StaticOrder, false, true>(F.lds, g, S, E, F.wave);
        }
#ifdef PROBE_P9X2
        __syncthreads(); pg8::gemm_phase<pg8::EpiBf<2>, pg8::StaticOrder, false, true>(F.lds, g, S, E, F.wave);
#endif
#ifdef PROBE_P9NULL
        __syncthreads(); { pg8::EpiNull EN{U}; pg8::gemm_phase<pg8::EpiNull, pg8::StaticOrder, false, true>(F.lds, g, S, EN, F.wave); }
#endif
    }
    SEAM(9);

#ifndef REP10
#define REP10 1
#endif
    if (IN(10)) for (int rep_ = 0; rep_ < REP10; ++rep_) {
        __syncthreads();
        pg8::Gemm g{U, WDN, M, DM, DFF, DFF}; pg8::StaticOrder S; S.init(M, DM, G, bid);
        pg8::EpiResid E{nullptr, XN, nullptr, XN, SS3};
        pg8::gemm_phase<pg8::EpiResid, pg8::StaticOrder, false, true>(F.lds, g, S, E, F.wave);
    }
    SEAM(10);

#ifndef REP11
#define REP11 1
#endif
    if (IN(11)) for (int rep_ = 0; rep_ < REP11; ++rep_) {
        __syncthreads();
        const f32x4* wr = (const f32x4*)norm_final_w + lane_id_();
        for (int m = gw; m < M; m += 2 * NGW) {
            const int m2 = (m + NGW < M) ? m + NGW : m;
            const float p0 = (lane_id_() < 32) ? SS3[(size_t)m * 32 + lane_id_()] : 0.f, p1 = (lane_id_() < 32) ? SS3[(size_t)m2 * 32 + lane_id_()] : 0.f;
            const v2u* xr0 = (const v2u*)(XN + (size_t)m * DM) + lane_id_(); const v2u* xr1 = (const v2u*)(XN + (size_t)m2 * DM) + lane_id_();
            v2u v0[8], v1[8];
#pragma unroll
            for (int j = 0; j < 8; ++j) { v0[j] = xr0[64 * j]; v1[j] = xr1[64 * j]; }
            const float rs0 = 1.0f / sqrtf(wave_sum(p0) * (1.0f / 2048.0f) + EPS), rs1 = 1.0f / sqrtf(wave_sum(p1) * (1.0f / 2048.0f) + EPS);
            f32x4* o0 = (f32x4*)(out + (size_t)m * DM) + lane_id_(); f32x4* o1 = (f32x4*)(out + (size_t)m2 * DM) + lane_id_();
#pragma unroll
            for (int j = 0; j < 8; ++j) { const f32x4 g = wr[64 * j];
                const f32x4 r0 = (f32x4){bflo(v0[j].x) * rs0 * g[0], bfhi(v0[j].x) * rs0 * g[1], bflo(v0[j].y) * rs0 * g[2], bfhi(v0[j].y) * rs0 * g[3]};
                const f32x4 r1 = (f32x4){bflo(v1[j].x) * rs1 * g[0], bfhi(v1[j].x) * rs1 * g[1], bflo(v1[j].y) * rs1 * g[2], bfhi(v1[j].y) * rs1 * g[3]};
                __builtin_nontemporal_store(r0, o0 + 64 * j); __builtin_nontemporal_store(r1, o1 + 64 * j); }
        }
    }
#undef IN
#undef SEAM
}

#ifndef MK_PER_PHASE
#define MK_PER_PHASE 0
#endif
constexpr int NPHASE = 12;
extern "C" void kernel_launch(void* const* d_in, const int* in_sizes, int n_in, void* d_out, int out_size, void* d_ws, size_t ws_size, hipStream_t stream) {
    static int grid = 0;
    if (grid == 0) {
        if (n_in != 21 || in_sizes[0] != M * DM || out_size != M * DM || ws_size < WS_END) {
            fprintf(stderr, "kernel_launch: unexpected shapes: n_in %d in0 %d out %d ws %zu (need >= %zu); nothing launched\n", n_in, n_in > 0 ? in_sizes[0] : -1, out_size, ws_size, (size_t)WS_END);
            grid = -1; return; }
        int dev = 0, cus = 0, per_cu = 0;
        if (hipGetDevice(&dev) != hipSuccess || hipDeviceGetAttribute(&cus, hipDeviceAttributeMultiprocessorCount, dev) != hipSuccess) { grid = -1; return; }
        if (hipFuncSetAttribute((const void*)mega_fwd, hipFuncAttributeMaxDynamicSharedMemorySize, LDS_BYTES) != hipSuccess) { fprintf(stderr, "kernel_launch: hipFuncSetAttribute failed\n"); grid = -1; return; }
        if (hipOccupancyMaxActiveBlocksPerMultiprocessor(&per_cu, (const void*)mega_fwd, NWAVES * 64, LDS_BYTES) != hipSuccess || per_cu < 1) {
            fprintf(stderr, "kernel_launch: occupancy query says %d blocks per CU\n", per_cu); per_cu = 1; }
        (void)hipGetLastError();
        grid = cus;
    }
    if (grid < 0) return;
    Args a{};
    for (int i = 0; i < 21; ++i) a.in[i] = (const float*)d_in[i];
    a.out = (float*)d_out; a.ws = (unsigned char*)d_ws;
#if MK_PER_PHASE
    for (int p = 0; p < NPHASE; ++p) { a.ph_lo = p; a.ph_hi = p + 1; a.coop = 0; hipLaunchKernelGGL(mega_fwd, dim3(grid), dim3(NWAVES * 64), LDS_BYTES, stream, a); }
#else
    if (hipMemsetAsync((char*)d_ws + WS_CTL, 0, CTL_ZERO_BYTES, stream) != hipSuccess) { fprintf(stderr, "kernel_launch: memset failed\n"); return; }
    a.ph_lo = 0; a.ph_hi = NPHASE; a.coop = 1;
    void* kargs[] = {&a};
    const hipError_t e = hipLaunchCooperativeKernel((const void*)mega_fwd, dim3(grid), dim3(NWAVES * 64), kargs, LDS_BYTES, stream);
    if (e != hipSuccess) fprintf(stderr, "kernel_launch: cooperative launch failed: %s (grid %d)\n", hipGetErrorString(e), grid);
#endif
}
```
